# Optimizing an MI355X kernel written in HIP

```python
import jax, jax.numpy as jnp
from jax import lax
import numpy as np

D_MODEL = 1024
BATCH = 2
SEQ = 8192
DEPTH = 4
DEC_BATCH = 128
DEC_SEQ = 8
PAST_LEN = 8192
PAGE_SIZE = 128

HEAD_DIM = 64
A_HEADS = 16
A_KV_HEADS = 4
A_GROUP = A_HEADS // A_KV_HEADS
A_WINDOW = 128
A_Q_W = A_HEADS * HEAD_DIM
A_KV_W = A_KV_HEADS * HEAD_DIM
A_QKV_WIDTH = A_Q_W + 2 * A_KV_W
B_SLOTS = 8
B_PATTERNS = ((128, 1), (512, 4), (2048, 16))
B_N_GROUPS = len(B_PATTERNS)
B_HEADS = B_N_GROUPS * B_SLOTS
B_MAX_WINDOW = max(w for w, _ in B_PATTERNS)
D_FF = -(-8 * D_MODEL // (3 * 256)) * 256
N_A_LAYERS = DEPTH // 2
N_B_LAYERS = DEPTH - N_A_LAYERS
BLOCK = 128
EPS = 1e-6
NEG = -1e30

kernel_name = 'yoco_swa_sink_dilated_decode_step'


def rms_norm(x, g):
    xf = x.astype(jnp.float32)
    y = xf * lax.rsqrt(jnp.mean(xf * xf, axis=-1, keepdims=True) + EPS)
    return y.astype(x.dtype) * g


def alibi_slopes(n):
    return jnp.asarray(2.0 ** (-8.0 * (np.arange(n) + 1) / n), dtype=jnp.float32)


def swiglu(x, w_gu, w_dn):
    gate, up = jnp.split(x @ w_gu, 2, axis=-1)
    return (jax.nn.silu(gate) * up) @ w_dn


def qkv_a(h, w_qkv):
    n, t = h.shape[:2]
    q, k, v = jnp.split(h @ w_qkv, [A_Q_W, A_Q_W + A_KV_W], axis=-1)
    return (q.reshape(n, t, A_KV_HEADS, A_GROUP, HEAD_DIM),
            k.reshape(n, t, A_KV_HEADS, HEAD_DIM),
            v.reshape(n, t, A_KV_HEADS, HEAD_DIM))


def shared_kv(x, g_kv, w_kv_s):
    n, t = x.shape[:2]
    k, v = jnp.split(rms_norm(x, g_kv) @ w_kv_s, 2, axis=-1)
    return k.reshape(n, t, B_SLOTS, HEAD_DIM), v.reshape(n, t, B_SLOTS, HEAD_DIM)


def banded_attention(q, k, v, slopes, dist_unit, max_dist, sinks=None):
    n, L, kh, g, d = q.shape
    nb = -(-L // BLOCK)
    pad = nb * BLOCK - L
    q = jnp.pad(q, ((0, 0), (0, pad), (0, 0), (0, 0), (0, 0)))
    k = jnp.pad(k, ((0, 0), (BLOCK, pad), (0, 0), (0, 0)))
    v = jnp.pad(v, ((0, 0), (BLOCK, pad), (0, 0), (0, 0)))
    qb = q.reshape(n, nb, BLOCK, kh, g, d)
    kb = k.reshape(n, nb + 1, BLOCK, kh, d)
    vb = v.reshape(n, nb + 1, BLOCK, kh, d)
    kc = jnp.concatenate([kb[:, :-1], kb[:, 1:]], axis=2)
    vc = jnp.concatenate([vb[:, :-1], vb[:, 1:]], axis=2)
    s = jnp.einsum('nbqhgd,nbkhd->nbhgqk', qb, kc).astype(jnp.float32) * HEAD_DIM ** -0.5
    qi = jnp.arange(BLOCK)[:, None]
    kj = jnp.arange(2 * BLOCK)[None, :]
    dist = BLOCK + qi - kj
    kpos = jnp.arange(nb)[:, None, None] * BLOCK + kj[None] - BLOCK
    valid = (dist >= 0) & (dist <= max_dist) & (kpos >= 0)
    s = s - slopes[None, None, :, :, None, None] * (dist_unit * dist).astype(jnp.float32)
    s = jnp.where(valid[None, :, None, None], s, NEG)
    lse = jax.nn.logsumexp(s, axis=-1)
    if sinks is not None:
        lse = jnp.logaddexp(lse, sinks.astype(jnp.float32)[None, None, :, :, None])
    p = jnp.exp(s - lse[..., None])
    o = jnp.einsum('nbhgqk,nbkhd->nbqhgd', p.astype(v.dtype), vc)
    o = o.reshape(n, nb * BLOCK, kh, g, d)[:, :L]
    lse = jnp.moveaxis(lse, -1, 2).reshape(n, nb * BLOCK, kh, g)[:, :L]
    return o, lse


def window_attention_sample(q, kc, vc, slopes, sinks):
    S = q.shape[1]
    W = kc.shape[1] - S
    s = jnp.einsum('bqhgd,bkhd->bhgqk', q, kc).astype(jnp.float32) * HEAD_DIM ** -0.5
    dist = (W + jnp.arange(S))[:, None] - jnp.arange(W + S)[None, :]
    valid = (dist >= 0) & (dist < A_WINDOW)
    s = s - slopes[None, :, :, None, None] * dist.astype(jnp.float32)
    s = jnp.where(valid, s, NEG)
    lse = jnp.logaddexp(jax.nn.logsumexp(s, axis=-1), sinks.astype(jnp.float32)[None, :, :, None])
    p = jnp.exp(s - lse[..., None])
    return jnp.einsum('bhgqk,bkhd->bqhgd', p.astype(vc.dtype), vc)


def to_sub(x, r):
    n, t = x.shape[:2]
    rest = x.shape[2:]
    x = jnp.swapaxes(x.reshape((n, t // r, r) + rest), 1, 2)
    return x.reshape((n * r, t // r) + rest)


def from_sub(x, n, r):
    L = x.shape[1]
    rest = x.shape[2:]
    x = jnp.swapaxes(x.reshape((n, r, L) + rest), 1, 2)
    return x.reshape((n, L * r) + rest)


def combine_groups(outs, lses):
    wts = jax.nn.softmax(jnp.stack(lses, axis=0), axis=0)
    return jnp.einsum('gnts,gntsd->ntsd', wts.astype(outs[0].dtype), jnp.stack(outs, axis=0))


def dilated_prompt(q, k, v, slopes):
    n = q.shape[0]
    outs, lses = [], []
    for gi, (w, r) in enumerate(B_PATTERNS):
        qs = to_sub(q[:, :, gi], r)[:, :, :, None]
        o, lse = banded_attention(qs, to_sub(k, r), to_sub(v, r), slopes[gi][:, None], r, w // r)
        outs.append(from_sub(o[:, :, :, 0], n, r))
        lses.append(from_sub(lse[..., 0], n, r))
    return combine_groups(outs, lses)


def dilated_sample(q, kc, vc, slopes):
    S = q.shape[1]
    W = kc.shape[1] - S
    outs, lses = [], []
    for gi, (w, r) in enumerate(B_PATTERNS):
        steps = jnp.arange(w // r + 1)
        idx = W + jnp.arange(S)[:, None] - r * steps[None, :]
        valid = idx >= 0
        idx = jnp.maximum(idx, 0)
        kg = kc[:, idx]
        vg = vc[:, idx]
        s = jnp.einsum('bshd,bskhd->bhsk', q[:, :, gi], kg).astype(jnp.float32) * HEAD_DIM ** -0.5
        s = s - slopes[gi][None, :, None, None] * (r * steps).astype(jnp.float32)
        s = jnp.where(valid[None, None], s, NEG)
        lse = jax.nn.logsumexp(s, axis=-1)
        p = jnp.exp(s - lse[..., None])
        outs.append(jnp.einsum('bhsk,bskhd->bshd', p.astype(vc.dtype), vg))
        lses.append(jnp.swapaxes(lse, 1, 2))
    return combine_groups(outs, lses)


def setup_inputs(seed: int = 0) -> dict:
    key = jax.random.key(seed)
    ks = jax.random.split(key, 18)
    wa = min(A_WINDOW, PAST_LEN)
    wb = min(B_MAX_WINDOW, PAST_LEN)

    def nrm(k, shape, scale=1.0):
        return scale * jax.random.normal(k, shape, jnp.float32)

    return {
        'x_prompt': nrm(ks[0], (BATCH, SEQ, D_MODEL)),
        'x_sample': nrm(ks[1], (DEC_BATCH, DEC_SEQ, D_MODEL)),
        'cache_a_k': nrm(ks[2], (N_A_LAYERS, DEC_BATCH, wa, A_KV_HEADS, HEAD_DIM)),
        'cache_a_v': nrm(ks[3], (N_A_LAYERS, DEC_BATCH, wa, A_KV_HEADS, HEAD_DIM)),
        'cache_b_k': nrm(ks[4], (DEC_BATCH, wb, B_SLOTS, HEAD_DIM)),
        'cache_b_v': nrm(ks[5], (DEC_BATCH, wb, B_SLOTS, HEAD_DIM)),
        'g_attn': 1.0 + nrm(ks[6], (DEPTH, D_MODEL), 0.05),
        'g_ffn': 1.0 + nrm(ks[7], (DEPTH, D_MODEL), 0.05),
        'w_qkv_a': nrm(ks[8], (N_A_LAYERS, D_MODEL, A_QKV_WIDTH), D_MODEL ** -0.5),
        'sinks_a': nrm(ks[9], (N_A_LAYERS, A_HEADS), 0.5),
        'w_o_a': nrm(ks[10], (N_A_LAYERS, A_Q_W, D_MODEL), A_Q_W ** -0.5),
        'g_kv': 1.0 + nrm(ks[11], (D_MODEL,), 0.05),
        'w_kv_s': nrm(ks[12], (D_MODEL, 2 * B_SLOTS * HEAD_DIM), D_MODEL ** -0.5),
        'w_q_b': nrm(ks[13], (N_B_LAYERS, D_MODEL, B_HEADS * HEAD_DIM), D_MODEL ** -0.5),
        'w_o_b': nrm(ks[14], (N_B_LAYERS, B_SLOTS * HEAD_DIM, D_MODEL), (B_SLOTS * HEAD_DIM) ** -0.5),
        'w_gate_up': nrm(ks[15], (DEPTH, D_MODEL, 2 * D_FF), D_MODEL ** -0.5),
        'w_down': nrm(ks[16], (DEPTH, D_FF, D_MODEL), D_FF ** -0.5),
        'g_final': 1.0 + nrm(ks[17], (D_MODEL,), 0.05),
    }


def reference(x_prompt, x_sample, cache_a_k, cache_a_v, cache_b_k, cache_b_v,
              g_attn, g_ffn, w_qkv_a, sinks_a, w_o_a, g_kv, w_kv_s, w_q_b, w_o_b,
              w_gate_up, w_down, g_final):
    slopes_a = alibi_slopes(A_HEADS).reshape(A_KV_HEADS, A_GROUP)
    slopes_b = alibi_slopes(B_HEADS).reshape(B_N_GROUPS, B_SLOTS)
    wa_p = min(A_WINDOW, x_prompt.shape[1])
    wb_p = min(B_MAX_WINDOW, x_prompt.shape[1])
    wa = cache_a_k.shape[2]
    wb = cache_b_k.shape[1]
    xp, xs = x_prompt, x_sample
    bp, tp = xp.shape[:2]
    bs, ts = xs.shape[:2]
    a_k_p, a_v_p, a_k_s, a_v_s = [], [], [], []
    for l in range(DEPTH):
        if l < N_A_LAYERS:
            hp = rms_norm(xp, g_attn[l])
            hs = rms_norm(xs, g_attn[l])
            qp, kp, vp = qkv_a(hp, w_qkv_a[l])
            qs, ks_, vs_ = qkv_a(hs, w_qkv_a[l])
            sink = sinks_a[l].reshape(A_KV_HEADS, A_GROUP)
            op, _ = banded_attention(qp, kp, vp, slopes_a, 1, A_WINDOW - 1, sink)
            kcs = jnp.concatenate([cache_a_k[l], ks_], axis=1)
            vcs = jnp.concatenate([cache_a_v[l], vs_], axis=1)
            osm = window_attention_sample(qs, kcs, vcs, slopes_a, sink)
            xp = xp + op.reshape(bp, tp, A_Q_W) @ w_o_a[l]
            xs = xs + osm.reshape(bs, ts, A_Q_W) @ w_o_a[l]
            a_k_p.append(kp[:, -wa_p:])
            a_v_p.append(vp[:, -wa_p:])
            a_k_s.append(kcs[:, -wa:])
            a_v_s.append(vcs[:, -wa:])
        else:
            if l == N_A_LAYERS:
                kbp, vbp = shared_kv(xp, g_kv, w_kv_s)
                kbs, vbs = shared_kv(xs, g_kv, w_kv_s)
                kcb = jnp.concatenate([cache_b_k, kbs], axis=1)
                vcb = jnp.concatenate([cache_b_v, vbs], axis=1)
            b = l - N_A_LAYERS
            hp = rms_norm(xp, g_attn[l])
            hs = rms_norm(xs, g_attn[l])
            qp = (hp @ w_q_b[b]).reshape(bp, tp, B_N_GROUPS, B_SLOTS, HEAD_DIM)
            qs = (hs @ w_q_b[b]).reshape(bs, ts, B_N_GROUPS, B_SLOTS, HEAD_DIM)
            op = dilated_prompt(qp, kbp, vbp, slopes_b)
            osm = dilated_sample(qs, kcb, vcb, slopes_b)
            xp = xp + op.reshape(bp, tp, B_SLOTS * HEAD_DIM) @ w_o_b[b]
            xs = xs + osm.reshape(bs, ts, B_SLOTS * HEAD_DIM) @ w_o_b[b]
        xp = xp + swiglu(rms_norm(xp, g_ffn[l]), w_gate_up[l], w_down[l])
        xs = xs + swiglu(rms_norm(xs, g_ffn[l]), w_gate_up[l], w_down[l])
    y_prompt = rms_norm(xp, g_final)
    y_sample = rms_norm(xs, g_final)
    return (y_prompt, y_sample,
            jnp.stack(a_k_p, axis=0), jnp.stack(a_v_p, axis=0), kbp[:, -wb_p:], vbp[:, -wb_p:],
            jnp.stack(a_k_s, axis=0), jnp.stack(a_v_s, axis=0), kcb[:, -wb:], vcb[:, -wb:])
```

```cpp
#include <hip/hip_runtime.h>
#include <cstdint>
#include <cstdio>
#include <cmath>
namespace fk {
constexpr int D = 1024, TP = 8192, NBP = 2, MP = NBP * TP, NBS = 128, SS_ = 8, MS = NBS * SS_, M = MP + MS;
constexpr int DFF = 2816, NGU = 2 * DFF, HD = 64;
constexpr int NWAVES = 8, NTHREADS = 512;
constexpr float LOG2E = 1.4426950408889634f, C2 = 0.125f * LOG2E, EPS = 1e-6f;
constexpr size_t MiB = 1u << 20;
constexpr size_t WS_CTL = 0, CTL_ZERO_BYTES = 1 * MiB;
constexpr size_t WS_WQKVA = 1 * MiB;
constexpr size_t WS_WOA = WS_WQKVA + 6 * MiB;
constexpr size_t WS_WB2 = WS_WOA + 4 * MiB;
constexpr size_t WS_WB3 = WS_WB2 + 5 * MiB;
constexpr size_t WS_WOB = WS_WB3 + 3 * MiB;
constexpr size_t WS_WGU = WS_WOB + 2 * MiB;
constexpr size_t WS_WD = WS_WGU + 44 * MiB;
constexpr size_t WS_X = WS_WD + 22 * MiB;
constexpr size_t WS_XB = WS_X + 68 * MiB;
constexpr size_t WS_SS = WS_XB + 34 * MiB;
constexpr size_t WS_Q = WS_SS + 2 * MiB;
constexpr size_t WS_KA = WS_Q + 51 * MiB;
constexpr size_t WS_VA = WS_KA + 9 * MiB;
constexpr size_t WS_KB = WS_VA + 9 * MiB;
constexpr size_t WS_VB = WS_KB + 17 * MiB;
constexpr size_t WS_ATT = WS_VB + 17 * MiB;
constexpr size_t WS_OG = WS_ATT + 34 * MiB;
constexpr size_t WS_LSE = WS_OG + 51 * MiB;
constexpr size_t WS_H = WS_LSE + 2 * MiB;
constexpr size_t WS_CBK = WS_H + 94 * MiB;
constexpr size_t WS_CBV = WS_CBK + 256 * MiB;
constexpr size_t WS_END = WS_CBV + 256 * MiB;
static_assert(WS_END <= 1024 * MiB, "fast workspace must fit below 1 GiB");
constexpr size_t O0 = 0, O1 = 16777216ull, O2 = O1 + 1048576ull, O3 = O2 + 131072ull, O4 = O3 + 131072ull, O5 = O4 + 2097152ull,
                 O6 = O5 + 2097152ull, O7 = O6 + 8388608ull, O8 = O7 + 8388608ull, O9 = O8 + 134217728ull;
constexpr int CW_BAR = 4096;
constexpr int RING_BYTES = 131072, MISC_OFF = RING_BYTES + 320, LDS_BYTES = 147456;

#define GAS __attribute__((address_space(1)))
#define LAS __attribute__((address_space(3)))
typedef unsigned short bf16;
typedef unsigned v4u __attribute__((ext_vector_type(4)));
typedef unsigned v2u __attribute__((ext_vector_type(2)));
typedef float f32x4 __attribute__((ext_vector_type(4)));
typedef float f32x16 __attribute__((ext_vector_type(16)));
typedef short bf16x8 __attribute__((ext_vector_type(8)));
typedef short s16x4 __attribute__((ext_vector_type(4)));
typedef float f32x2_t __attribute__((ext_vector_type(2)));
typedef __bf16 bf16x2_t __attribute__((ext_vector_type(2)));
__device__ __forceinline__ unsigned pkbf(float lo, float hi) { f32x2_t v = {lo, hi}; bf16x2_t b = __builtin_convertvector(v, bf16x2_t); return __builtin_bit_cast(unsigned, b); }
__device__ __forceinline__ float bflo(unsigned u) { return __uint_as_float(u << 16); }
__device__ __forceinline__ float bfhi(unsigned u) { return __uint_as_float(u & 0xffff0000u); }
__device__ __forceinline__ float wave_sum(float v) {
#pragma unroll
    for (int o = 1; o < 64; o <<= 1) v += __shfl_xor(v, o);
    return v;
}
__device__ __forceinline__ float rstd_row(const float* ss, int row) {
    const f32x4* p = (const f32x4*)(ss + (size_t)row * 16); const f32x4 a = p[0], b = p[1], c = p[2], d = p[3];
    const float s = ((a.x + a.y) + (a.z + a.w)) + ((b.x + b.y) + (b.z + b.w)) + ((c.x + c.y) + (c.z + c.w)) + ((d.x + d.y) + (d.z + d.w));
    return 1.0f / sqrtf(s * (1.0f / 1024.0f) + EPS);
}
__device__ __forceinline__ float slope_of(int idx, int n) { return exp2f(-8.0f * (float)(idx + 1) / (float)n); }
}
namespace pg8 {
#define PG8_LAS __attribute__((address_space(3)))
typedef unsigned short bf16_t;
typedef short bf16x8 __attribute__((ext_vector_type(8)));
typedef float f32x4 __attribute__((ext_vector_type(4)));
typedef unsigned u32x4 __attribute__((ext_vector_type(4)));
constexpr int BM = 256, BK = 64, HALF = 128, HTB = HALF * BK * 2  , STAGE_BYTES = 8 * HTB, NXCD = 8, WGM = 8;

__host__ __device__ __forceinline__ int lds_byte(int r, int c) { const int st = (r >> 4) * 2 + (c >> 5), rr = r & 15, cc = c & 31, ob = rr * 64 + cc * 2; return st * 1024 + (ob ^ (((ob >> 9) & 1) << 5)); }
__host__ __device__ __forceinline__ void stage_rc(int b, int& R, int& C) { const int st = b / 1024, sb = b % 1024, swz = sb ^ (((sb >> 9) & 1) << 5); R = (st >> 1) * 16 + swz / 64; C = (st & 1) * 32 + (swz % 64) / 2; }
__host__ __device__ __forceinline__ int perm32(int rho) { const int n = rho >> 4, i = rho & 15; return 8 * (i >> 2) + 4 * n + (i & 3); }

struct Unit { int pm, pn; };
struct Gemm { const bf16_t* A; const bf16_t* Bt; int M, N, K; };

struct StaticOrder {
    int nM, nN, nwg, G, c;
    __host__ __device__ void init(int M, int N, int G_, int c_) { nM = M / BM; nN = N / BM; nwg = nM * nN; G = G_; c = c_; }
    __host__ __device__ bool next(int i, Unit& u) const {
        const long L = (long)i * G + c; if (L >= nwg) return false;
        int wgid = (int)L; { const int q = nwg / NXCD, r = nwg % NXCD, xcd = wgid % NXCD, off = wgid / NXCD; wgid = (xcd < r ? xcd * (q + 1) : r * (q + 1) + (xcd - r) * q) + off; }
        const int nig = WGM * nN, gid = wgid / nig, fm = gid * WGM, gsz = (nM - fm) < WGM ? (nM - fm) : WGM;
        u.pm = fm + ((wgid % nig) % gsz); u.pn = (wgid % nig) / gsz; return true;
    }
    __device__ __forceinline__ void a_ready(const Unit&) const {}
    __device__ __forceinline__ void done(const Unit&) const {}
};

__device__ __forceinline__ unsigned cvt_pk_bf16(float lo, float hi) { unsigned r; asm volatile("v_cvt_pk_bf16_f32 %0, %1, %2" : "=v"(r) : "v"(lo), "v"(hi)); return r; }
typedef float f32x2 __attribute__((ext_vector_type(2)));
template <int KIND> struct EpiProj {
    static constexpr bool PERM = true, AFTER_DRAIN = false;
    const float* ss; bf16_t* Q; bf16_t* K; bf16_t* V; float* outKp; float* outVp; float* outKs; float* outVs;
    __device__ __forceinline__ void operator()(const f32x4 (&acc)[2][2][4][2], const Unit& u, int wr, int wc, int fr, int fq) const {
        const int row0 = u.pm * BM + wr * 64 + fr; const int pn = u.pn;
        bf16_t* dst; int ld, col; float sc = 1.0f; float* o32p = nullptr; float* o32s = nullptr; int kvw = 0;
        if (KIND == 0) { if (pn < 4) { dst = Q; ld = 1024; col = pn * 256; sc = fk::C2; } else if (pn == 4) { dst = K; ld = 256; col = 0; o32p = outKp; o32s = outKs; kvw = 256; } else { dst = V; ld = 256; col = 0; o32p = outVp; o32s = outVs; kvw = 256; } }
        else if (KIND == 1) { if (pn < 6) { dst = Q; ld = 1536; col = pn * 256; sc = fk::C2; } else if (pn < 8) { dst = K; ld = 512; col = (pn - 6) * 256; o32p = outKp; o32s = outKs; kvw = 512; } else { dst = V; ld = 512; col = (pn - 8) * 256; o32p = outVp; o32s = outVs; kvw = 512; } }
        else { dst = Q; ld = 1536; col = pn * 256; sc = fk::C2; }
        const int cl = col + wc * 32 + 8 * fq;
#pragma unroll
        for (int ai = 0; ai < 2; ++ai)
#pragma unroll
            for (int m = 0; m < 4; ++m) {
                const int r = row0 + ai * HALF + m * 16; const float rs = fk::rstd_row(ss, r) * sc;
                float* o32 = nullptr;
                if (KIND != 2 && kvw) {
                    if (r < fk::MP) { const int b = r >> 13, t = r & 8191; const int W = (KIND == 0) ? 128 : 2048; if (t >= 8192 - W) o32 = o32p + ((size_t)b * W + (t - (8192 - W))) * kvw; }
                    else { const int rsx = r - fk::MP, b = rsx >> 3, s = rsx & 7; const int W = (KIND == 0) ? 128 : 2048; o32 = o32s + ((size_t)b * W + (W - 8) + s) * kvw; }
                }
#pragma unroll
                for (int bj = 0; bj < 2; ++bj) {
                    const f32x4 v0 = acc[ai][bj][m][0] * rs, v1 = acc[ai][bj][m][1] * rs;
                    u32x4 w; w.x = fk::pkbf(v0[0], v0[1]); w.y = fk::pkbf(v0[2], v0[3]); w.z = fk::pkbf(v1[0], v1[1]); w.w = fk::pkbf(v1[2], v1[3]);
                    *(u32x4*)(dst + (size_t)r * ld + cl + bj * HALF) = w;
                    if (KIND != 2) { if (o32) { *(f32x4*)(o32 + cl + bj * HALF) = v0; *(f32x4*)(o32 + cl + bj * HALF + 4) = v1; } }
                }
            }
    }
};
struct EpiRes {
    static constexpr bool PERM = true, AFTER_DRAIN = false;
    float* X; bf16_t* XB; float* SS;
    __device__ __forceinline__ void operator()(const f32x4 (&acc)[2][2][4][2], const Unit& u, int wr, int wc, int fr, int fq) const {
        const int row0 = u.pm * BM + wr * 64 + fr; const int cl = u.pn * BM + wc * 32 + 8 * fq;
#pragma unroll
        for (int ai = 0; ai < 2; ++ai)
#pragma unroll
            for (int m = 0; m < 4; ++m) {
                const int r = row0 + ai * HALF + m * 16; float q = 0.f;
#pragma unroll
                for (int bj = 0; bj < 2; ++bj) {
                    float* xp = X + (size_t)r * 1024 + cl + bj * HALF;
                    f32x4 x0 = *(const f32x4*)xp, x1 = *(const f32x4*)(xp + 4);
                    x0 = x0 + acc[ai][bj][m][0]; x1 = x1 + acc[ai][bj][m][1];
                    *(f32x4*)xp = x0; *(f32x4*)(xp + 4) = x1;
                    q += (x0[0] * x0[0] + x0[1] * x0[1]) + (x0[2] * x0[2] + x0[3] * x0[3]) + (x1[0] * x1[0] + x1[1] * x1[1]) + (x1[2] * x1[2] + x1[3] * x1[3]);
                    u32x4 w; w.x = fk::pkbf(x0[0], x0[1]); w.y = fk::pkbf(x0[2], x0[3]); w.z = fk::pkbf(x1[0], x1[1]); w.w = fk::pkbf(x1[2], x1[3]);
                    *(u32x4*)(XB + (size_t)r * 1024 + cl + bj * HALF) = w;
                }
                q += __shfl_xor(q, 16); q += __shfl_xor(q, 32);
                if (fq == 0) SS[(size_t)r * 16 + u.pn * 4 + wc] = q;
            }
    }
};
struct EpiGlu {
    static constexpr bool PERM = true, AFTER_DRAIN = false;
    const float* ss; bf16_t* H;
    __device__ __forceinline__ void operator()(const f32x4 (&acc)[2][2][4][2], const Unit& u, int wr, int wc, int fr, int fq) const {
        const int row0 = u.pm * BM + wr * 64 + fr; const int cl = u.pn * HALF + wc * 32 + 8 * fq;
#pragma unroll
        for (int ai = 0; ai < 2; ++ai)
#pragma unroll
            for (int m = 0; m < 4; ++m) {
                const int r = row0 + ai * HALF + m * 16; const float rs = fk::rstd_row(ss, r);
                float h[8];
#pragma unroll
                for (int n = 0; n < 2; ++n)
#pragma unroll
                    for (int e = 0; e < 4; ++e) { const float g = acc[ai][0][m][n][e] * rs, up = acc[ai][1][m][n][e] * rs;
                        const float sg = __builtin_amdgcn_rcpf(1.0f + __builtin_amdgcn_exp2f(-g * fk::LOG2E)); h[n * 4 + e] = g * sg * up; }
                u32x4 w; w.x = fk::pkbf(h[0], h[1]); w.y = fk::pkbf(h[2], h[3]); w.z = fk::pkbf(h[4], h[5]); w.w = fk::pkbf(h[6], h[7]);
                *(u32x4*)(H + (size_t)r * fk::DFF + cl) = w;
            }
    }
};
template <class Epi, class Sched, bool ALIGN_EPI = false, bool SP2 = false>
__device__ __forceinline__ void gemm_phase(PG8_LAS unsigned char* lds, const Gemm g, const Sched& S, const Epi& E) {
    const int tid = threadIdx.x, wid = __builtin_amdgcn_readfirstlane(tid >> 6), lane = tid & 63, wr = wid >> 2, wc = wid & 3, fr = lane & 15, fq = lane >> 4;
    const int K = g.K, nt = K / BK;
    unsigned voffA[2], voffB[2];
#pragma unroll
    for (int i = 0; i < 2; ++i) { int R, C; stage_rc(tid * 16 + i * 8192, R, C); const int Rb = Epi::PERM ? ((R & ~31) + perm32(R & 31)) : R;
        voffA[i] = (unsigned)(R * K + C) * 2u; voffB[i] = (unsigned)(Rb * K + C) * 2u; }
    const size_t kstep = (size_t)(BK * 2);
    const size_t hstep = (size_t)HALF * K * 2;
    const size_t tstep = 2 * hstep;
    const unsigned ldsw = (unsigned)wid * 1024u;
    const int aoff = lds_byte(wr * 64 + fr, fq * 8), boff = lds_byte(wc * 32 + fr, fq * 8);
#define PG8_SA(b, h) (((b) * 2 + (h)) * HTB)
#define PG8_SB(b, h) ((4 + (b) * 2 + (h)) * HTB)
#define PG8_STAGE(bufoff, gbase, voff) do { _Pragma("unroll") for (int _i = 0; _i < 2; ++_i) \
        __builtin_amdgcn_global_load_lds((const unsigned*)((const char*)(gbase) + (voff)[_i]), (PG8_LAS unsigned*)(lds + (bufoff) + ldsw + _i * 8192), 16, 0, 0); } while (0)
#define PG8_LDA(dst, b, h) do { _Pragma("unroll") for (int m = 0; m < 4; ++m) _Pragma("unroll") for (int k = 0; k < 2; ++k) dst[m][k] = *(const PG8_LAS bf16x8*)(lds + PG8_SA(b, h) + aoff + m * 2048 + k * 1024); } while (0)
#define PG8_LDB(dst, b, h) do { _Pragma("unroll") for (int n = 0; n < 2; ++n) _Pragma("unroll") for (int k = 0; k < 2; ++k) dst[n][k] = *(const PG8_LAS bf16x8*)(lds + PG8_SB(b, h) + boff + n * 2048 + k * 1024); } while (0)
#define PG8_MMA(ai, bj, At, Bt) do { __builtin_amdgcn_s_setprio(1); _Pragma("unroll") for (int m = 0; m < 4; ++m) _Pragma("unroll") for (int n = 0; n < 2; ++n) _Pragma("unroll") for (int k = 0; k < 2; ++k) \
        acc[ai][bj][m][n] = __builtin_amdgcn_mfma_f32_16x16x32_bf16(Bt[n][k], At[m][k], acc[ai][bj][m][n], 0, 0, 0); __builtin_amdgcn_s_setprio(0); } while (0)
#define PG8_WAIT_V(n) asm volatile("s_waitcnt vmcnt(" #n ")" ::: "memory")
#define PG8_WAIT_L(n) asm volatile("s_waitcnt lgkmcnt(" #n ")" ::: "memory")
#define PG8_BAR __builtin_amdgcn_s_barrier()
#define PG8_SCHED __builtin_amdgcn_sched_barrier(0)
    Unit cur, nxt; int ui = 0;
    if (!S.next(0, cur)) return;
    f32x4 acc[2][2][4][2];
#pragma unroll
    for (int a = 0; a < 2; ++a)
#pragma unroll
        for (int b = 0; b < 2; ++b)
#pragma unroll
            for (int m = 0; m < 4; ++m)
#pragma unroll
                for (int n = 0; n < 2; ++n) acc[a][b][m][n] = (f32x4){0.f, 0.f, 0.f, 0.f};
    bf16x8 At[4][2], B0[2][2], B1[2][2];
    const char* cA = (const char*)g.A + (size_t)cur.pm * tstep; const char* cB = (const char*)g.Bt + (size_t)cur.pn * tstep;
    S.a_ready(cur);
    if constexpr (SP2) {
        PG8_STAGE(PG8_SB(0, 0), cB, voffB); PG8_STAGE(PG8_SB(0, 1), cB + hstep, voffB); PG8_STAGE(PG8_SA(0, 0), cA, voffA); PG8_STAGE(PG8_SA(0, 1), cA + hstep, voffA);
        if (wr == 1) PG8_BAR;
        PG8_WAIT_V(2); PG8_BAR;
        PG8_STAGE(PG8_SB(1, 0), cB + kstep, voffB); PG8_STAGE(PG8_SA(1, 0), cA + kstep, voffA); PG8_STAGE(PG8_SB(1, 1), cB + hstep + kstep, voffB);
        PG8_WAIT_V(6); PG8_BAR;
    } else {
        PG8_STAGE(PG8_SB(0, 0), cB, voffB); PG8_STAGE(PG8_SA(0, 0), cA, voffA); PG8_STAGE(PG8_SB(0, 1), cB + hstep, voffB); PG8_STAGE(PG8_SA(0, 1), cA + hstep, voffA);
        if (wr == 1) PG8_BAR;
        PG8_WAIT_V(4); PG8_BAR;
        PG8_STAGE(PG8_SB(1, 0), cB + kstep, voffB); PG8_STAGE(PG8_SA(1, 0), cA + kstep, voffA); PG8_STAGE(PG8_SB(1, 1), cB + hstep + kstep, voffB);
        PG8_WAIT_V(6); PG8_BAR;
    }
    for (;;) {
        const bool has_next = S.next(ui + 1, nxt);
        const char* nA = has_next ? (const char*)g.A + (size_t)nxt.pm * tstep : cA; const char* nB = has_next ? (const char*)g.Bt + (size_t)nxt.pn * tstep : cB;
        for (int t = 0; t < nt; t += 2) {
            const bool last = (t == nt - 2);
            const char* a1 = cA + (size_t)(t + 1) * kstep;
            const char* a2 = last ? nA : cA + (size_t)(t + 2) * kstep; const char* b2 = last ? nB : cB + (size_t)(t + 2) * kstep;
            const char* a3 = a2 + kstep; const char* b3 = b2 + kstep;
            if (last && has_next) S.a_ready(nxt);
            if constexpr (SP2) {
            PG8_LDB(B0, 0, 0); PG8_LDB(B1, 0, 1); PG8_SCHED; PG8_LDA(At, 0, 0); PG8_STAGE(PG8_SA(1, 1), a1 + hstep, voffA);
            PG8_WAIT_V(8); PG8_WAIT_L(0); PG8_BAR; PG8_MMA(0, 0, At, B0); PG8_MMA(0, 1, At, B1); PG8_BAR; PG8_SCHED;
            PG8_LDA(At, 0, 1); PG8_STAGE(PG8_SB(0, 0), b2, voffB); PG8_STAGE(PG8_SB(0, 1), b2 + hstep, voffB); PG8_STAGE(PG8_SA(0, 0), a2, voffA);
            PG8_WAIT_V(8); PG8_WAIT_L(0); PG8_BAR; PG8_MMA(1, 0, At, B0); PG8_MMA(1, 1, At, B1); PG8_BAR; PG8_SCHED;
            PG8_LDB(B0, 1, 0); PG8_LDB(B1, 1, 1); PG8_SCHED; PG8_LDA(At, 1, 0); PG8_STAGE(PG8_SA(0, 1), a2 + hstep, voffA);
            PG8_WAIT_V(8); PG8_WAIT_L(0); PG8_BAR; PG8_MMA(0, 0, At, B0); PG8_MMA(0, 1, At, B1); PG8_BAR; PG8_SCHED;
            PG8_LDA(At, 1, 1); PG8_STAGE(PG8_SB(1, 0), b3, voffB); PG8_STAGE(PG8_SB(1, 1), b3 + hstep, voffB); PG8_STAGE(PG8_SA(1, 0), a3, voffA);
            PG8_WAIT_V(8); PG8_WAIT_L(0); PG8_BAR; PG8_MMA(1, 0, At, B0); PG8_MMA(1, 1, At, B1); PG8_BAR; PG8_SCHED;
            } else {
            PG8_LDB(B0, 0, 0); PG8_SCHED; PG8_LDA(At, 0, 0); PG8_STAGE(PG8_SA(1, 1), a1 + hstep, voffA);
            PG8_WAIT_L(8); PG8_BAR; PG8_WAIT_L(0); PG8_MMA(0, 0, At, B0); PG8_BAR; PG8_SCHED;
            PG8_LDB(B1, 0, 1); PG8_STAGE(PG8_SB(0, 0), b2, voffB);
            PG8_BAR; PG8_WAIT_L(0); PG8_MMA(0, 1, At, B1); PG8_BAR;
            PG8_LDA(At, 0, 1); PG8_STAGE(PG8_SA(0, 0), a2, voffA);
            PG8_BAR; PG8_WAIT_L(0); PG8_MMA(1, 0, At, B0); PG8_BAR; PG8_SCHED;
            PG8_STAGE(PG8_SB(0, 1), b2 + hstep, voffB);
            PG8_WAIT_V(6); PG8_BAR; PG8_MMA(1, 1, At, B1); PG8_BAR;
            PG8_LDB(B0, 1, 0); PG8_SCHED; PG8_LDA(At, 1, 0); PG8_STAGE(PG8_SA(0, 1), a2 + hstep, voffA);
            PG8_WAIT_L(8); PG8_BAR; PG8_WAIT_L(0); PG8_MMA(0, 0, At, B0); PG8_BAR; PG8_SCHED;
            PG8_LDB(B1, 1, 1); PG8_STAGE(PG8_SB(1, 0), b3, voffB);
            PG8_BAR; PG8_WAIT_L(0); PG8_MMA(0, 1, At, B1); PG8_BAR;
            PG8_LDA(At, 1, 1); PG8_STAGE(PG8_SA(1, 0), a3, voffA);
            PG8_BAR; PG8_WAIT_L(0); PG8_MMA(1, 0, At, B0); PG8_BAR; PG8_SCHED;
            PG8_STAGE(PG8_SB(1, 1), b3 + hstep, voffB);
            PG8_WAIT_V(6); PG8_BAR; PG8_MMA(1, 1, At, B1); PG8_BAR;
            }
        }
        if constexpr (ALIGN_EPI) { if (wr == 0) PG8_BAR; }
        if constexpr (!Epi::AFTER_DRAIN) { E(acc, cur, wr, wc, fr, fq); S.done(cur); }
        if (!has_next) break;
#pragma unroll
        for (int a = 0; a < 2; ++a)
#pragma unroll
            for (int b = 0; b < 2; ++b)
#pragma unroll
                for (int m = 0; m < 4; ++m)
#pragma unroll
                    for (int n = 0; n < 2; ++n) acc[a][b][m][n] = (f32x4){0.f, 0.f, 0.f, 0.f};
        cur = nxt; cA = nA; cB = nB; ++ui;
        if constexpr (ALIGN_EPI) { if (wr == 1) PG8_BAR; }
    }
    PG8_WAIT_V(0);
    if constexpr (!ALIGN_EPI) { if (wr == 0) PG8_BAR; }
    PG8_BAR;
    if constexpr (Epi::AFTER_DRAIN) { E.fused(acc, cur, wr, wc, fr, fq, lds, wid, lane); S.done(cur); }
#undef PG8_SA
#undef PG8_SB
#undef PG8_STAGE
#undef PG8_LDA
#undef PG8_LDB
#undef PG8_MMA
#undef PG8_WAIT_V
#undef PG8_WAIT_L
#undef PG8_BAR
#undef PG8_SCHED
}
}
#define XB_TMO      128
#define XB_XCNT(j)  (256  + 64 * (j))
#define XB_XSUB(j)  (1280 + 64 * (j))
#define XB_XGEN(j)  (2304 + 64 * (j))
#define XB_TOP      3328
#define XB_TOPGEN   3392
#define XCD_BAR_WORDS 3456
#define XB_SPIN_CAP (1u << 18)

__device__ __forceinline__ unsigned xb_ld(unsigned* p)              { return __hip_atomic_load(p, __ATOMIC_RELAXED, __HIP_MEMORY_SCOPE_AGENT); }
__device__ __forceinline__ unsigned xb_add(unsigned* p, unsigned v) { return __hip_atomic_fetch_add(p, v, __ATOMIC_RELAXED, __HIP_MEMORY_SCOPE_AGENT); }
__device__ __forceinline__ unsigned xb_xcc_id() { return (unsigned)__builtin_amdgcn_s_getreg((3 << 11) | 20) & 0xFu; }
#define XB_SPIN(cond, bar) do { unsigned _sp = 0; while (cond) { __builtin_amdgcn_s_sleep(1); \
    if ((++_sp & 255u) == 0u) { if (xb_ld(&(bar)[XB_TMO])) break; if (_sp > XB_SPIN_CAP) { atomicAdd(&(bar)[XB_TMO], 1u); break; } } } } while (0)

struct XcdBarrier {
    unsigned* bar; unsigned x;
    volatile LAS unsigned* st;
};

__device__ __forceinline__ XcdBarrier xcd_barrier_post(unsigned* bar, volatile LAS unsigned* st) {
    XcdBarrier b; b.bar = bar; b.x = xb_xcc_id(); b.st = st;
    if (threadIdx.x == 0) (void)xb_add(&bar[XB_XCNT(b.x)], 1u);
    return b;
}
__device__ __forceinline__ void xcd_barrier_complete(unsigned* bar, unsigned x, unsigned& nloc, unsigned& nx) {
    const unsigned G = gridDim.x * gridDim.y * gridDim.z;
    unsigned sum, cnt, mine, sp = 0u;
    for (;;) {
        sum = 0u; cnt = 0u; mine = 0u;
#pragma unroll
        for (unsigned j = 0; j < 16; ++j) { const unsigned c = xb_ld(&bar[XB_XCNT(j)]); sum += c; cnt += (c > 0u) ? 1u : 0u; mine = (j == x) ? c : mine; }
        if (sum == G) break;
        __builtin_amdgcn_s_sleep(1);
        if ((++sp & 255u) == 0u) { if (xb_ld(&bar[XB_TMO])) break; if (sp > XB_SPIN_CAP) { atomicAdd(&bar[XB_TMO], 1u); break; } }
    }
    nloc = mine > 0u ? mine : 1u; nx = cnt > 0u ? cnt : 1u;
}

__device__ __forceinline__ void xcd_barrier(const XcdBarrier& b) {
    asm volatile("s_waitcnt vmcnt(0)" ::: "memory");
    __syncthreads();
    if (threadIdx.x == 0) {
        unsigned* bar = b.bar;
        __builtin_amdgcn_s_waitcnt(0);
        unsigned nloc = b.st[0], nx = b.st[1];
        if (nloc == 0u) { xcd_barrier_complete(bar, b.x, nloc, nx); b.st[0] = nloc; b.st[1] = nx; }
        const unsigned old = xb_add(&bar[XB_XSUB(b.x)], 1u);
        const unsigned gen = old / nloc;
        if (old + 1u == (gen + 1u) * nloc) {
            __builtin_amdgcn_fence(__ATOMIC_RELEASE, "agent");
            asm volatile("s_waitcnt vmcnt(0)" ::: "memory");
            const unsigned og = xb_add(&bar[XB_TOP], 1u);
            const unsigned tg = og / nx;
            if (og + 1u == (tg + 1u) * nx) xb_add(&bar[XB_TOPGEN], 1u);
            else XB_SPIN(xb_ld(&bar[XB_TOPGEN]) == tg, bar);
            __builtin_amdgcn_fence(__ATOMIC_ACQUIRE, "agent");
            xb_add(&bar[XB_XGEN(b.x)], 1u);
            asm volatile("s_waitcnt vmcnt(0)" ::: "memory");
        } else {
            XB_SPIN(xb_ld(&bar[XB_XGEN(b.x)]) == gen, bar);
            __builtin_amdgcn_fence(__ATOMIC_ACQUIRE, "agent");
            asm volatile("s_waitcnt vmcnt(0)" ::: "memory");
        }
    }
    __syncthreads();
}
namespace fk {
struct Frame {
    LAS unsigned char* lds; volatile LAS unsigned* MISC; unsigned* ctl;
    int wave, vcu, G;
    __device__ __forceinline__ int lane() const { int l; asm volatile("v_mbcnt_lo_u32_b32 %0, -1, 0\n\tv_mbcnt_hi_u32_b32 %0, -1, %0" : "=v"(l)); return l; }
    __device__ __forceinline__ int tid() const { return wave * 64 + lane(); }
    const float *xp, *xs, *cak, *cav, *cbk, *cbv, *g_attn, *g_ffn, *w_qkv_a, *sinks_a, *w_o_a, *g_kv, *w_kv_s, *w_q_b, *w_o_b, *w_gu, *w_dn, *g_final;
    float* out;
    bf16 *WqkvA, *WoA, *Wb2, *Wb3, *WoB, *Wgu, *Wd;
    float* X; bf16* XB; float* SS;
    bf16 *Q, *KA, *VA, *KB, *VB, *ATT, *OG, *H, *CBK, *CBV; float* LSE;
};
__device__ __forceinline__ void transpose_item(const float* W, int ldw, int K, const float* gain, bf16* WT, int n0dst, int csrc, int k0, LAS float* scr, int lane) {
#pragma unroll 8
    for (int i = 0; i < 32; ++i) { const int kk = 2 * i + (lane >> 5); float v = W[(size_t)(k0 + kk) * ldw + csrc + (lane & 31)]; if (gain) v *= gain[k0 + kk]; scr[kk * 33 + (lane & 31)] = v; }
    asm volatile("s_waitcnt lgkmcnt(0)" ::: "memory");
    const int c = lane & 7;
#pragma unroll
    for (int j = 0; j < 4; ++j) { const int n = (lane >> 3) + 8 * j; const LAS float* s = scr + (8 * c) * 33 + n;
        v4u o; o.x = pkbf(s[0 * 33], s[1 * 33]); o.y = pkbf(s[2 * 33], s[3 * 33]); o.z = pkbf(s[4 * 33], s[5 * 33]); o.w = pkbf(s[6 * 33], s[7 * 33]);
        *(v4u*)(WT + (size_t)(n0dst + n) * K + k0 + 8 * c) = o; }
    asm volatile("s_waitcnt lgkmcnt(0)" ::: "memory");
}
template <bool GU> __device__ __forceinline__ void transpose_matrix(const float* W, int K, int N, const float* gain, bf16* WT, int rowoff, LAS float* scr, int lane, int item) {
    const int nblk = N / 32, kb = item / nblk, nb = item % nblk; const int n0 = nb * 32; int csrc = n0;
    if (GU) { const int pn = n0 >> 8, j = n0 & 255; csrc = (j < 128) ? (128 * pn + j) : (DFF + 128 * pn + (j - 128)); }
    transpose_item(W, N, K, gain, WT, rowoff + n0, csrc, kb * 64, scr, lane);
}
__device__ __forceinline__ void p0_weights(Frame& F) {
    LAS float* scr = (LAS float*)(F.lds + F.wave * 16384); const int lane = F.lane();
    const int gw = F.vcu * NWAVES + F.wave, NGW = F.G * NWAVES;
    constexpr int I_QKV = (1024 / 64) * (1536 / 32), I_SQ = (1024 / 64) * (1024 / 32), I_OB = (512 / 64) * (1024 / 32), I_GU = (1024 / 64) * (NGU / 32), I_DN = (DFF / 64) * (1024 / 32);
    constexpr int NIT = 2 * I_QKV + 2 * I_SQ + (I_QKV + I_SQ) + I_QKV + 2 * I_OB + 4 * I_GU + 4 * I_DN;
    for (int it = gw; it < NIT; it += NGW) {
        int r = it;
        if (r < 2 * I_QKV) { const int l = r / I_QKV; transpose_matrix<false>(F.w_qkv_a + (size_t)l * 1024 * 1536, 1024, 1536, F.g_attn + l * 1024, F.WqkvA + (size_t)l * 1536 * 1024, 0, scr, lane, r % I_QKV); continue; } r -= 2 * I_QKV;
        if (r < 2 * I_SQ) { const int l = r / I_SQ; transpose_matrix<false>(F.w_o_a + (size_t)l * 1024 * 1024, 1024, 1024, nullptr, F.WoA + (size_t)l * 1024 * 1024, 0, scr, lane, r % I_SQ); continue; } r -= 2 * I_SQ;
        if (r < I_QKV) { transpose_matrix<false>(F.w_q_b, 1024, 1536, F.g_attn + 2 * 1024, F.Wb2, 0, scr, lane, r); continue; } r -= I_QKV;
        if (r < I_SQ) { transpose_matrix<false>(F.w_kv_s, 1024, 1024, F.g_kv, F.Wb2, 1536, scr, lane, r); continue; } r -= I_SQ;
        if (r < I_QKV) { transpose_matrix<false>(F.w_q_b + (size_t)1024 * 1536, 1024, 1536, F.g_attn + 3 * 1024, F.Wb3, 0, scr, lane, r); continue; } r -= I_QKV;
        if (r < 2 * I_OB) { const int l = r / I_OB; transpose_matrix<false>(F.w_o_b + (size_t)l * 512 * 1024, 512, 1024, nullptr, F.WoB + (size_t)l * 1024 * 512, 0, scr, lane, r % I_OB); continue; } r -= 2 * I_OB;
        if (r < 4 * I_GU) { const int l = r / I_GU; transpose_matrix<true>(F.w_gu + (size_t)l * 1024 * NGU, 1024, NGU, F.g_ffn + l * 1024, F.Wgu + (size_t)l * NGU * 1024, 0, scr, lane, r % I_GU); continue; } r -= 4 * I_GU;
        { const int l = r / I_DN; transpose_matrix<false>(F.w_dn + (size_t)l * DFF * 1024, DFF, 1024, nullptr, F.Wd + (size_t)l * 1024 * DFF, 0, scr, lane, r % I_DN); }
    }
}
__device__ __forceinline__ void p0_x(Frame& F) {
    const int lane = F.lane(); const int gw = F.vcu * NWAVES + F.wave, NGW = F.G * NWAVES;
    for (int m = gw; m < M; m += NGW) {
        const float* src = (m < MP) ? F.xp + (size_t)m * D : F.xs + (size_t)(m - MP) * D;
        const f32x4* xr = (const f32x4*)src + lane; f32x4 v[4]; float s = 0.f;
#pragma unroll
        for (int j = 0; j < 4; ++j) { v[j] = xr[64 * j]; s += (v[j].x * v[j].x + v[j].y * v[j].y) + (v[j].z * v[j].z + v[j].w * v[j].w); }
        s = wave_sum(s);
        f32x4* xo = (f32x4*)(F.X + (size_t)m * D) + lane; v2u* bo = (v2u*)(F.XB + (size_t)m * D) + lane;
#pragma unroll
        for (int j = 0; j < 4; ++j) { xo[64 * j] = v[j]; v2u w; w.x = pkbf(v[j].x, v[j].y); w.y = pkbf(v[j].z, v[j].w); bo[64 * j] = w; }
        if (lane < 16) F.SS[(size_t)m * 16 + lane] = (lane == 0) ? s : 0.f;
    }
}
__device__ __forceinline__ void p0_cache_b(Frame& F) {
    const int lane = F.lane(); const int gw = F.vcu * NWAVES + F.wave, NGW = F.G * NWAVES;
    for (int it = gw; it < 2 * NBS * 2048; it += NGW) {
        const int kv = it / (NBS * 2048), rr = it % (NBS * 2048), b = rr >> 11, i = rr & 2047;
        const float* src = (kv ? F.cbv : F.cbk) + (size_t)rr * 512; bf16* cb = (kv ? F.CBV : F.CBK) + (size_t)rr * 512;
        const f32x4 a = ((const f32x4*)src)[lane], c = ((const f32x4*)src)[lane + 64];
        v2u w0, w1; w0.x = pkbf(a.x, a.y); w0.y = pkbf(a.z, a.w); w1.x = pkbf(c.x, c.y); w1.y = pkbf(c.z, c.w);
        ((v2u*)cb)[lane] = w0; ((v2u*)cb)[lane + 64] = w1;
        if (i >= 8) { float* o = F.out + (kv ? O9 : O8) + ((size_t)b * 2048 + (i - 8)) * 512; ((f32x4*)o)[lane] = a; ((f32x4*)o)[lane + 64] = c; }
    }
}

#define MFMA32(a, b, c) __builtin_amdgcn_mfma_f32_32x32x16_bf16((a), (b), (c), 0, 0, 0)
__device__ __forceinline__ int crow(int reg, int h) { return (reg & 3) + 8 * (reg >> 2) + 4 * h; }
struct BandArgs {
    const bf16* Qp; int ldq;
    const bf16* Kp; const bf16* Vp; int ldkv;
    int rowbase; int rstride;
    int i0;
    bf16* Op; int ldo;
    float* lsep; int ldl;
    float slope2; float sink2;
};
template <int MODE> __device__ __forceinline__ void band_stage(LAS unsigned char* lds, const BandArgs& a, int tid) {
    constexpr int QB = (MODE == 0) ? 64 : 256, NK = QB + 128, VSTR = 2 * NK + 8;
    LAS unsigned char* Kl = lds; LAS unsigned char* Vt = lds + NK * 144;
#pragma unroll
    for (int c0 = 0; c0 < NK * 8; c0 += NTHREADS) {
        const int c = c0 + tid, kk = c >> 3, ch = c & 7; const int i = a.i0 - 128 + kk;
        v4u kq = {0u, 0u, 0u, 0u}, vq = {0u, 0u, 0u, 0u};
        if (i >= 0) { const size_t row = (size_t)(a.rowbase + i * a.rstride); kq = *(const v4u*)(a.Kp + row * a.ldkv + ch * 8); vq = *(const v4u*)(a.Vp + row * a.ldkv + ch * 8); }
        *(LAS v4u*)(Kl + kk * 144 + ch * 16) = kq;
        LAS unsigned short* vt = (LAS unsigned short*)(Vt + (ch * 8) * VSTR + kk * 2);
        vt[0] = (unsigned short)(vq.x & 0xffffu); *(LAS unsigned short*)((LAS unsigned char*)vt + 1 * VSTR) = (unsigned short)(vq.x >> 16);
        *(LAS unsigned short*)((LAS unsigned char*)vt + 2 * VSTR) = (unsigned short)(vq.y & 0xffffu); *(LAS unsigned short*)((LAS unsigned char*)vt + 3 * VSTR) = (unsigned short)(vq.y >> 16);
        *(LAS unsigned short*)((LAS unsigned char*)vt + 4 * VSTR) = (unsigned short)(vq.z & 0xffffu); *(LAS unsigned short*)((LAS unsigned char*)vt + 5 * VSTR) = (unsigned short)(vq.z >> 16);
        *(LAS unsigned short*)((LAS unsigned char*)vt + 6 * VSTR) = (unsigned short)(vq.w & 0xffffu); *(LAS unsigned short*)((LAS unsigned char*)vt + 7 * VSTR) = (unsigned short)(vq.w >> 16);
    }
}
template <int NK, int MAXD, bool SINK>
__device__ __forceinline__ void band_compute(LAS unsigned char* Kl, LAS unsigned char* Vt, int kk0, const bf16x8 (&qf)[4], int distbase, int keyidx0, float slope2, float sink2, int lane, f32x16 (&o)[2], float& m_out, float& l_out) {
    constexpr int VSTR = 2 * NK + 8; const int rl = lane & 31, h = lane >> 5;
    f32x16 S[5];
#pragma unroll
    for (int kt = 0; kt < 5; ++kt) {
        f32x16 accs = {0.f, 0.f, 0.f, 0.f, 0.f, 0.f, 0.f, 0.f, 0.f, 0.f, 0.f, 0.f, 0.f, 0.f, 0.f, 0.f};
#pragma unroll
        for (int d0 = 0; d0 < 4; ++d0) { const bf16x8 kf = *(const LAS bf16x8*)(Kl + (kk0 + 32 * kt + rl) * 144 + (16 * d0 + 8 * h) * 2); accs = MFMA32(kf, qf[d0], accs); }
        S[kt] = accs;
    }
    float mx = -INFINITY;
#pragma unroll
    for (int kt = 0; kt < 5; ++kt)
#pragma unroll
        for (int rg = 0; rg < 16; ++rg) { const int kofs = 32 * kt + crow(rg, h); const int dist = distbase + rl - kofs; const bool ok = (dist >= 0) && (dist <= MAXD) && (keyidx0 + kofs >= 0);
            const float s = ok ? (S[kt][rg] - slope2 * (float)dist) : -INFINITY; S[kt][rg] = s; mx = fmaxf(mx, s); }
    mx = fmaxf(mx, __shfl_xor(mx, 32)); if (SINK) mx = fmaxf(mx, sink2);
    float l = 0.f;
#pragma unroll
    for (int kt = 0; kt < 5; ++kt)
#pragma unroll
        for (int rg = 0; rg < 16; ++rg) { const float p = __builtin_amdgcn_exp2f(S[kt][rg] - mx); S[kt][rg] = p; l += p; }
    l += __shfl_xor(l, 32); if (SINK) l += __builtin_amdgcn_exp2f(sink2 - mx);
    o[0] = (f32x16){0.f, 0.f, 0.f, 0.f, 0.f, 0.f, 0.f, 0.f, 0.f, 0.f, 0.f, 0.f, 0.f, 0.f, 0.f, 0.f}; o[1] = o[0];
#pragma unroll
    for (int kt = 0; kt < 5; ++kt)
#pragma unroll
        for (int s2 = 0; s2 < 2; ++s2) {
            v4u pw; pw.x = pkbf(S[kt][8 * s2 + 0], S[kt][8 * s2 + 1]); pw.y = pkbf(S[kt][8 * s2 + 2], S[kt][8 * s2 + 3]); pw.z = pkbf(S[kt][8 * s2 + 4], S[kt][8 * s2 + 5]); pw.w = pkbf(S[kt][8 * s2 + 6], S[kt][8 * s2 + 7]);
            const bf16x8 xs = __builtin_bit_cast(bf16x8, pw);
#pragma unroll
            for (int dh = 0; dh < 2; ++dh) {
                const LAS unsigned char* vp = Vt + (32 * dh + rl) * VSTR + (kk0 + 32 * kt + 16 * s2 + 4 * h) * 2;
                const s16x4 lo = *(const LAS s16x4*)vp, hi = *(const LAS s16x4*)(vp + 16);
                const bf16x8 va = __builtin_shufflevector(lo, hi, 0, 1, 2, 3, 4, 5, 6, 7);
                o[dh] = MFMA32(va, xs, o[dh]);
            }
        }
    m_out = mx; l_out = l;
}
__device__ __forceinline__ void band_store(bf16* orow, const f32x16 (&o)[2], float inv, int h) {
#pragma unroll
    for (int dh = 0; dh < 2; ++dh)
#pragma unroll
        for (int g4 = 0; g4 < 4; ++g4) { v2u w; w.x = pkbf(o[dh][4 * g4 + 0] * inv, o[dh][4 * g4 + 1] * inv); w.y = pkbf(o[dh][4 * g4 + 2] * inv, o[dh][4 * g4 + 3] * inv);
            *(v2u*)(orow + 32 * dh + 8 * g4 + 4 * h) = w; }
}
template <int MODE> __device__ __forceinline__ void band_unit(LAS unsigned char* lds, const BandArgs& a, int sb, int lane) {
    constexpr int QB = (MODE == 0) ? 64 : 256, NK = QB + 128;
    LAS unsigned char* Kl = lds; LAS unsigned char* Vt = lds + NK * 144;
    const int rl = lane & 31, h = lane >> 5;
    const int iq = a.i0 + 32 * sb + rl; const size_t qrow = (size_t)(a.rowbase + iq * a.rstride);
    bf16x8 qf[4];
#pragma unroll
    for (int d0 = 0; d0 < 4; ++d0) qf[d0] = *(const bf16x8*)(a.Qp + qrow * a.ldq + 16 * d0 + 8 * h);
    f32x16 o[2]; float m, l;
    band_compute<NK, (MODE == 0) ? 127 : 128, MODE == 0>(Kl, Vt, 32 * sb, qf, 128, a.i0 - 128 + 32 * sb, a.slope2, a.sink2, lane, o, m, l);
    const float inv = 1.0f / l;
    band_store(a.Op + qrow * a.ldo, o, inv, h);
    if (MODE == 1) { if (h == 0) a.lsep[qrow * a.ldl] = m + __builtin_amdgcn_logf(l); }
}
}
namespace fk {
__device__ __forceinline__ void sample_a_unit(Frame& F, int l, int b, int kvh) {
    constexpr int NK = 160, VSTR = 2 * NK + 8; const int lane = F.lane(), tid = F.wave * 64 + lane;
    LAS unsigned char* Kl = F.lds; LAS unsigned char* Vt = F.lds + NK * 144;
    const float* ck = F.cak + (((size_t)l * NBS + b) * 128) * 256 + kvh * 64; const float* cv = F.cav + (((size_t)l * NBS + b) * 128) * 256 + kvh * 64;
    float* ok = F.out + O6 + (((size_t)l * NBS + b) * 128) * 256 + kvh * 64; float* ov = F.out + O7 + (((size_t)l * NBS + b) * 128) * 256 + kvh * 64;
#pragma unroll
    for (int c0 = 0; c0 < 2048; c0 += NTHREADS) {
        const int c = c0 + tid, kk = c >> 4, ch = c & 15;
        const f32x4 kq = *(const f32x4*)(ck + (size_t)kk * 256 + ch * 4), vq = *(const f32x4*)(cv + (size_t)kk * 256 + ch * 4);
        if (kk >= 8) { *(f32x4*)(ok + (size_t)(kk - 8) * 256 + ch * 4) = kq; *(f32x4*)(ov + (size_t)(kk - 8) * 256 + ch * 4) = vq; }
        v2u kw; kw.x = pkbf(kq.x, kq.y); kw.y = pkbf(kq.z, kq.w);
        *(LAS v2u*)(Kl + kk * 144 + ch * 8) = kw;
        const unsigned v01 = pkbf(vq.x, vq.y), v23 = pkbf(vq.z, vq.w);
        LAS unsigned char* vt = Vt + (ch * 4) * VSTR + kk * 2;
        *(LAS unsigned short*)(vt) = (unsigned short)(v01 & 0xffffu); *(LAS unsigned short*)(vt + VSTR) = (unsigned short)(v01 >> 16);
        *(LAS unsigned short*)(vt + 2 * VSTR) = (unsigned short)(v23 & 0xffffu); *(LAS unsigned short*)(vt + 3 * VSTR) = (unsigned short)(v23 >> 16);
    }
    if (tid < 256) {
        const int kk = 128 + (tid >> 3), ch = tid & 7; v4u kq = {0u, 0u, 0u, 0u}, vq = {0u, 0u, 0u, 0u};
        if (kk < 136) { const size_t row = (size_t)(MP + b * 8 + (kk - 128)); kq = *(const v4u*)(F.KA + row * 256 + kvh * 64 + ch * 8); vq = *(const v4u*)(F.VA + row * 256 + kvh * 64 + ch * 8); }
        *(LAS v4u*)(Kl + kk * 144 + ch * 16) = kq;
        LAS unsigned char* vt = Vt + (ch * 8) * VSTR + kk * 2;
        *(LAS unsigned short*)(vt) = (unsigned short)(vq.x & 0xffffu); *(LAS unsigned short*)(vt + 1 * VSTR) = (unsigned short)(vq.x >> 16);
        *(LAS unsigned short*)(vt + 2 * VSTR) = (unsigned short)(vq.y & 0xffffu); *(LAS unsigned short*)(vt + 3 * VSTR) = (unsigned short)(vq.y >> 16);
        *(LAS unsigned short*)(vt + 4 * VSTR) = (unsigned short)(vq.z & 0xffffu); *(LAS unsigned short*)(vt + 5 * VSTR) = (unsigned short)(vq.z >> 16);
        *(LAS unsigned short*)(vt + 6 * VSTR) = (unsigned short)(vq.w & 0xffffu); *(LAS unsigned short*)(vt + 7 * VSTR) = (unsigned short)(vq.w >> 16);
    }
    __syncthreads();
    if (F.wave == 0) {
        const int rl = lane & 31, h = lane >> 5, g = rl >> 3, s = rl & 7, head = kvh * 4 + g;
        const size_t qrow = (size_t)(MP + b * 8 + s);
        bf16x8 qf[4];
#pragma unroll
        for (int d0 = 0; d0 < 4; ++d0) qf[d0] = *(const bf16x8*)(F.Q + qrow * 1024 + head * 64 + 16 * d0 + 8 * h);
        const float slope2 = slope_of(head, 16) * LOG2E, sink2 = F.sinks_a[l * 16 + head] * LOG2E;
        f32x16 o[2]; float m, lsum;
        band_compute<NK, 127, true>(Kl, Vt, 0, qf, 128 + s - rl, 0, slope2, sink2, lane, o, m, lsum);
        band_store(F.ATT + qrow * 1024 + head * 64, o, 1.0f / lsum, h);
    }
    __syncthreads();
}
__device__ __forceinline__ void sample_b_task(Frame& F, int b, int s, int slot) {
    const int lane = F.lane(), sub = lane & 7, kg = lane >> 3;
    const size_t qrow = (size_t)(MP + b * 8 + s);
    float mc = -INFINITY, den = 0.f; float num[8];
#pragma unroll
    for (int e = 0; e < 8; ++e) num[e] = 0.f;
    for (int grp = 0; grp < 3; ++grp) {
        const int r = (grp == 0) ? 1 : (grp == 1) ? 4 : 16; const float slope2 = slope_of(grp * 8 + slot, 24) * (float)r * LOG2E;
        const v4u qq = *(const v4u*)(F.Q + qrow * 1536 + grp * 512 + slot * 64 + sub * 8);
        const float q0 = bflo(qq.x), q1 = bfhi(qq.x), q2 = bflo(qq.y), q3 = bfhi(qq.y), q4 = bflo(qq.z), q5 = bfhi(qq.z), q6 = bflo(qq.w), q7 = bfhi(qq.w);
        float sc[17]; float mx = -INFINITY;
#pragma unroll
        for (int st = 0; st < 17; ++st) {
            const int k = st * 8 + kg; const bool ok = (k <= 128); const int idx = 2048 + s - r * (ok ? k : 0);
            const bf16* kp = (idx < 2048) ? F.CBK + ((size_t)b * 2048 + idx) * 512 + slot * 64 + sub * 8 : F.KB + (size_t)(MP + b * 8 + (idx - 2048)) * 512 + slot * 64 + sub * 8;
            const v4u kk = *(const v4u*)kp;
            float d = bflo(kk.x) * q0 + bfhi(kk.x) * q1 + bflo(kk.y) * q2 + bfhi(kk.y) * q3 + bflo(kk.z) * q4 + bfhi(kk.z) * q5 + bflo(kk.w) * q6 + bfhi(kk.w) * q7;
            d += __shfl_xor(d, 1); d += __shfl_xor(d, 2); d += __shfl_xor(d, 4);
            sc[st] = ok ? (d - slope2 * (float)k) : -INFINITY; mx = fmaxf(mx, sc[st]);
        }
        mx = fmaxf(mx, __shfl_xor(mx, 8)); mx = fmaxf(mx, __shfl_xor(mx, 16)); mx = fmaxf(mx, __shfl_xor(mx, 32));
        float lsum = 0.f; float acc[8];
#pragma unroll
        for (int e = 0; e < 8; ++e) acc[e] = 0.f;
#pragma unroll
        for (int st = 0; st < 17; ++st) {
            const int k = st * 8 + kg; const bool ok = (k <= 128); const int idx = 2048 + s - r * (ok ? k : 0);
            const bf16* vp = (idx < 2048) ? F.CBV + ((size_t)b * 2048 + idx) * 512 + slot * 64 + sub * 8 : F.VB + (size_t)(MP + b * 8 + (idx - 2048)) * 512 + slot * 64 + sub * 8;
            const v4u vv = *(const v4u*)vp;
            const float p = __builtin_amdgcn_exp2f(sc[st] - mx); lsum += p;
            acc[0] += p * bflo(vv.x); acc[1] += p * bfhi(vv.x); acc[2] += p * bflo(vv.y); acc[3] += p * bfhi(vv.y); acc[4] += p * bflo(vv.z); acc[5] += p * bfhi(vv.z); acc[6] += p * bflo(vv.w); acc[7] += p * bfhi(vv.w);
        }
        lsum += __shfl_xor(lsum, 8); lsum += __shfl_xor(lsum, 16); lsum += __shfl_xor(lsum, 32);
#pragma unroll
        for (int e = 0; e < 8; ++e) { acc[e] += __shfl_xor(acc[e], 8); acc[e] += __shfl_xor(acc[e], 16); acc[e] += __shfl_xor(acc[e], 32); }
        const float lse2 = mx + __builtin_amdgcn_logf(lsum), inv = 1.0f / lsum;
        const float mn = fmaxf(mc, lse2), so = __builtin_amdgcn_exp2f(mc - mn), w = __builtin_amdgcn_exp2f(lse2 - mn);
        den = den * so + w;
#pragma unroll
        for (int e = 0; e < 8; ++e) num[e] = num[e] * so + w * acc[e] * inv;
        mc = mn;
    }
    if (kg == 0) { const float id = 1.0f / den; v4u w; w.x = pkbf(num[0] * id, num[1] * id); w.y = pkbf(num[2] * id, num[3] * id); w.z = pkbf(num[4] * id, num[5] * id); w.w = pkbf(num[6] * id, num[7] * id);
        *(v4u*)(F.ATT + qrow * 512 + slot * 64 + sub * 8) = w; }
}
__device__ __forceinline__ void combine_b(Frame& F) {
    const int tid = F.tid(); const size_t nth = (size_t)F.G * NTHREADS; const size_t total = (size_t)MP * 64;
    for (size_t it = (size_t)F.vcu * NTHREADS + tid; it < total; it += nth) {
        const size_t row = it >> 6; const int c8 = (int)(it & 63), slot = c8 >> 3;
        const float l0 = F.LSE[(size_t)0 * M * 8 + row * 8 + slot], l1 = F.LSE[(size_t)1 * M * 8 + row * 8 + slot], l2 = F.LSE[(size_t)2 * M * 8 + row * 8 + slot];
        const float mx = fmaxf(fmaxf(l0, l1), l2); float w0 = __builtin_amdgcn_exp2f(l0 - mx), w1 = __builtin_amdgcn_exp2f(l1 - mx), w2 = __builtin_amdgcn_exp2f(l2 - mx);
        const float id = 1.0f / (w0 + w1 + w2); w0 *= id; w1 *= id; w2 *= id;
        const v4u a = *(const v4u*)(F.OG + ((size_t)0 * M + row) * 512 + c8 * 8), b = *(const v4u*)(F.OG + ((size_t)1 * M + row) * 512 + c8 * 8), c = *(const v4u*)(F.OG + ((size_t)2 * M + row) * 512 + c8 * 8);
        v4u o;
        o.x = pkbf(w0 * bflo(a.x) + w1 * bflo(b.x) + w2 * bflo(c.x), w0 * bfhi(a.x) + w1 * bfhi(b.x) + w2 * bfhi(c.x));
        o.y = pkbf(w0 * bflo(a.y) + w1 * bflo(b.y) + w2 * bflo(c.y), w0 * bfhi(a.y) + w1 * bfhi(b.y) + w2 * bfhi(c.y));
        o.z = pkbf(w0 * bflo(a.z) + w1 * bflo(b.z) + w2 * bflo(c.z), w0 * bfhi(a.z) + w1 * bfhi(b.z) + w2 * bfhi(c.z));
        o.w = pkbf(w0 * bflo(a.w) + w1 * bflo(b.w) + w2 * bflo(c.w), w0 * bfhi(a.w) + w1 * bfhi(b.w) + w2 * bfhi(c.w));
        *(v4u*)(F.ATT + row * 512 + c8 * 8) = o;
    }
}
__device__ __forceinline__ void final_norm(Frame& F) {
    const int lane = F.lane(); const int gw = F.vcu * NWAVES + F.wave, NGW = F.G * NWAVES;
    for (int m = gw; m < M; m += NGW) {
        const float rs = rstd_row(F.SS, m);
        const f32x4* xr = (const f32x4*)(F.X + (size_t)m * D) + lane; f32x4* yo = (f32x4*)(F.out + (size_t)m * D) + lane; const f32x4* gg = (const f32x4*)F.g_final + lane;
#pragma unroll
        for (int j = 0; j < 4; ++j) { const f32x4 v = xr[64 * j], g = gg[64 * j]; f32x4 o; o.x = v.x * rs * g.x; o.y = v.y * rs * g.y; o.z = v.z * rs * g.z; o.w = v.w * rs * g.w; yo[64 * j] = o; }
    }
}
__device__ __forceinline__ void attn_a_phase(Frame& F, int l) {
    for (int u = F.vcu; u < NBP * 4 * 128; u += F.G) {
        const int lane = F.lane(), tid = F.wave * 64 + lane;
        const int qblk = u & 127, kvh = (u >> 7) & 3, b = u >> 9;
        const int g = F.wave >> 1, sb = F.wave & 1, head = kvh * 4 + g;
        BandArgs a; a.Qp = F.Q + head * 64; a.ldq = 1024; a.Kp = F.KA + kvh * 64; a.Vp = F.VA + kvh * 64; a.ldkv = 256; a.rowbase = b * TP; a.rstride = 1; a.i0 = qblk * 64;
        a.Op = F.ATT + head * 64; a.ldo = 1024; a.lsep = nullptr; a.ldl = 0; a.slope2 = slope_of(head, 16) * LOG2E; a.sink2 = F.sinks_a[l * 16 + head] * LOG2E;
        band_stage<0>(F.lds, a, tid);
        __syncthreads();
        band_unit<0>(F.lds, a, sb, lane);
        __syncthreads();
    }
    for (int u = F.vcu; u < NBS * 4; u += F.G) sample_a_unit(F, l, u >> 2, u & 3);
}
__device__ __forceinline__ void attn_b_phase(Frame& F) {
    for (int u = F.vcu; u < 3 * 512; u += F.G) {
        const int lane = F.lane(), tid = F.wave * 64 + lane;
        const int grp = u >> 9, v = u & 511; const int r = (grp == 0) ? 1 : (grp == 1) ? 4 : 16; const int L = TP / r, nqb = L / 256;
        const int slot = v & 7, w = v >> 3;
        const int qblk = w % nqb, br = w / nqb, res = br % r, b = br / r;
        BandArgs a; a.Qp = F.Q + grp * 512 + slot * 64; a.ldq = 1536; a.Kp = F.KB + slot * 64; a.Vp = F.VB + slot * 64; a.ldkv = 512; a.rowbase = b * TP + res; a.rstride = r; a.i0 = qblk * 256;
        a.Op = F.OG + (size_t)grp * M * 512 + slot * 64; a.ldo = 512; a.lsep = F.LSE + (size_t)grp * M * 8 + slot; a.ldl = 8; a.slope2 = slope_of(grp * 8 + slot, 24) * (float)r * LOG2E; a.sink2 = 0.f;
        band_stage<1>(F.lds, a, tid);
        __syncthreads();
        band_unit<1>(F.lds, a, F.wave, lane);
        __syncthreads();
    }
    const int gw = F.vcu * NWAVES + F.wave, NGW = F.G * NWAVES;
    for (int t = gw; t < NBS * 8 * 8; t += NGW) sample_b_task(F, t >> 6, (t >> 3) & 7, t & 7);
}
}
namespace fk {
constexpr int NPHASE = 24;
struct Args { const float* in[18]; float* out; unsigned char* ws; int ph_lo, ph_hi; };
__global__ void __launch_bounds__(NTHREADS, 2) yoco_fwd(Args args) {
    extern __shared__ __attribute__((aligned(16))) unsigned char lds[];
    Frame F;
    F.lds = (LAS unsigned char*)lds; F.MISC = (volatile LAS unsigned*)(F.lds + MISC_OFF);
    F.wave = __builtin_amdgcn_readfirstlane((int)threadIdx.x >> 6);
    F.G = gridDim.x; { const int bx = blockIdx.x; F.vcu = (F.G % 8 == 0) ? (bx % 8) * (F.G / 8) + bx / 8 : bx; }
    unsigned char* ws = args.ws; F.ctl = (unsigned*)(ws + WS_CTL);
    F.xp = args.in[0]; F.xs = args.in[1]; F.cak = args.in[2]; F.cav = args.in[3]; F.cbk = args.in[4]; F.cbv = args.in[5]; F.g_attn = args.in[6]; F.g_ffn = args.in[7]; F.w_qkv_a = args.in[8];
    F.sinks_a = args.in[9]; F.w_o_a = args.in[10]; F.g_kv = args.in[11]; F.w_kv_s = args.in[12]; F.w_q_b = args.in[13]; F.w_o_b = args.in[14]; F.w_gu = args.in[15]; F.w_dn = args.in[16]; F.g_final = args.in[17];
    F.out = args.out;
    F.WqkvA = (bf16*)(ws + WS_WQKVA); F.WoA = (bf16*)(ws + WS_WOA); F.Wb2 = (bf16*)(ws + WS_WB2); F.Wb3 = (bf16*)(ws + WS_WB3); F.WoB = (bf16*)(ws + WS_WOB); F.Wgu = (bf16*)(ws + WS_WGU); F.Wd = (bf16*)(ws + WS_WD);
    F.X = (float*)(ws + WS_X); F.XB = (bf16*)(ws + WS_XB); F.SS = (float*)(ws + WS_SS);
    F.Q = (bf16*)(ws + WS_Q); F.KA = (bf16*)(ws + WS_KA); F.VA = (bf16*)(ws + WS_VA); F.KB = (bf16*)(ws + WS_KB); F.VB = (bf16*)(ws + WS_VB); F.ATT = (bf16*)(ws + WS_ATT);
    F.OG = (bf16*)(ws + WS_OG); F.LSE = (float*)(ws + WS_LSE); F.H = (bf16*)(ws + WS_H); F.CBK = (bf16*)(ws + WS_CBK); F.CBV = (bf16*)(ws + WS_CBV);
    for (int u = threadIdx.x; u < (LDS_BYTES - RING_BYTES) / 4; u += NTHREADS) ((LAS unsigned*)(F.lds + RING_BYTES))[u] = 0u;
    __syncthreads();
    const int lo = args.ph_lo, hi = args.ph_hi;
    XcdBarrier bar; bar.bar = (unsigned*)(F.ctl + CW_BAR); bar.x = 0; bar.st = nullptr;
    if (hi - lo > 1) bar = xcd_barrier_post((unsigned*)(F.ctl + CW_BAR), F.MISC + 8);
#ifdef NO_ATTN_A
#define ATTN_A(F, l)
#else
#define ATTN_A(F, l) attn_a_phase(F, l)
#endif
#ifdef NO_ATTN_B
#define ATTN_B(F)
#else
#define ATTN_B(F) attn_b_phase(F)
#endif
#define IN(k) (lo <= (k) && (k) < hi)
#define SEAM(k) do { if (IN(k) && IN((k) + 1)) xcd_barrier(bar); } while (0)
#define GEMM_PHASE(EpiT, Aptr, Bptr, Nn, Kk, ...) do { pg8::Gemm g{(const pg8::bf16_t*)(Aptr), (const pg8::bf16_t*)(Bptr), M, (Nn), (Kk)}; pg8::StaticOrder S; S.init(M, (Nn), F.G, (int)blockIdx.x); \
        EpiT E{__VA_ARGS__}; pg8::gemm_phase<EpiT, pg8::StaticOrder, true, true>(F.lds, g, S, E); } while (0)

    if (IN(0)) { p0_weights(F); p0_x(F); p0_cache_b(F); } SEAM(0);
#define A_LAYER(l) do { const int pb = 1 + 5 * (l); \
    if (IN(pb)) GEMM_PHASE(pg8::EpiProj<0>, F.XB, F.WqkvA + (size_t)(l) * 1536 * 1024, 1536, 1024, F.SS, F.Q, F.KA, F.VA, F.out + O2 + (size_t)(l) * 2 * 128 * 256, F.out + O3 + (size_t)(l) * 2 * 128 * 256, F.out + O6 + (size_t)(l) * 128 * 128 * 256, F.out + O7 + (size_t)(l) * 128 * 128 * 256); \
    SEAM(pb); \
    if (IN(pb + 1)) { ATTN_A(F, (l)); } SEAM(pb + 1); \
    if (IN(pb + 2)) GEMM_PHASE(pg8::EpiRes, F.ATT, F.WoA + (size_t)(l) * 1024 * 1024, 1024, 1024, F.X, F.XB, F.SS); SEAM(pb + 2); \
    if (IN(pb + 3)) GEMM_PHASE(pg8::EpiGlu, F.XB, F.Wgu + (size_t)(l) * NGU * 1024, NGU, 1024, F.SS, F.H); SEAM(pb + 3); \
    if (IN(pb + 4)) GEMM_PHASE(pg8::EpiRes, F.H, F.Wd + (size_t)(l) * 1024 * DFF, 1024, DFF, F.X, F.XB, F.SS); SEAM(pb + 4); } while (0)
    A_LAYER(0);
    A_LAYER(1);
    if (IN(11)) GEMM_PHASE(pg8::EpiProj<1>, F.XB, F.Wb2, 2560, 1024, F.SS, F.Q, F.KB, F.VB, F.out + O4, F.out + O5, F.out + O8, F.out + O9); SEAM(11);
    if (IN(12)) { ATTN_B(F); } SEAM(12);
    if (IN(13)) combine_b(F); SEAM(13);
    if (IN(14)) GEMM_PHASE(pg8::EpiRes, F.ATT, F.WoB, 1024, 512, F.X, F.XB, F.SS); SEAM(14);
    if (IN(15)) GEMM_PHASE(pg8::EpiGlu, F.XB, F.Wgu + (size_t)2 * NGU * 1024, NGU, 1024, F.SS, F.H); SEAM(15);
    if (IN(16)) GEMM_PHASE(pg8::EpiRes, F.H, F.Wd + (size_t)2 * 1024 * DFF, 1024, DFF, F.X, F.XB, F.SS); SEAM(16);
    if (IN(17)) GEMM_PHASE(pg8::EpiProj<2>, F.XB, F.Wb3, 1536, 1024, F.SS, F.Q, nullptr, nullptr, nullptr, nullptr, nullptr, nullptr); SEAM(17);
    if (IN(18)) { ATTN_B(F); } SEAM(18);
    if (IN(19)) combine_b(F); SEAM(19);
    if (IN(20)) GEMM_PHASE(pg8::EpiRes, F.ATT, F.WoB + (size_t)1024 * 512, 1024, 512, F.X, F.XB, F.SS); SEAM(20);
    if (IN(21)) GEMM_PHASE(pg8::EpiGlu, F.XB, F.Wgu + (size_t)3 * NGU * 1024, NGU, 1024, F.SS, F.H); SEAM(21);
    if (IN(22)) GEMM_PHASE(pg8::EpiRes, F.H, F.Wd + (size_t)3 * 1024 * DFF, 1024, DFF, F.X, F.XB, F.SS); SEAM(22);
    if (IN(23)) final_norm(F);
#undef IN
#undef SEAM
#undef GEMM_PHASE
#undef A_LAYER
}
static int g_grid = 0;
static bool setup() {
    if (g_grid) return g_grid > 0;
    int dev = 0, cus = 0;
    if (hipGetDevice(&dev) != hipSuccess || hipDeviceGetAttribute(&cus, hipDeviceAttributeMultiprocessorCount, dev) != hipSuccess) { g_grid = -1; return false; }
    if (hipFuncSetAttribute((const void*)yoco_fwd, hipFuncAttributeMaxDynamicSharedMemorySize, LDS_BYTES) != hipSuccess) { fprintf(stderr, "hipFuncSetAttribute failed\n"); g_grid = -1; return false; }
    int per_cu = 0; (void)hipOccupancyMaxActiveBlocksPerMultiprocessor(&per_cu, (const void*)yoco_fwd, NTHREADS, LDS_BYTES); (void)hipGetLastError();
    if (per_cu < 1) fprintf(stderr, "occupancy query says %d blocks/CU\n", per_cu);
    g_grid = cus;
    return true;
}
static void launch(void* const* d_in, float* out, void* ws, int lo, int hi, hipStream_t st) {
    Args a{}; for (int i = 0; i < 18; ++i) a.in[i] = (const float*)d_in[i]; a.out = out; a.ws = (unsigned char*)ws; a.ph_lo = lo; a.ph_hi = hi;
    hipLaunchKernelGGL(yoco_fwd, dim3(g_grid), dim3(NTHREADS), LDS_BYTES, st, a);
}
}
extern "C" void kernel_launch(void* const* d_in, const int* in_sizes, int n_in, void* d_out, int out_size, void* d_ws, size_t ws_size, hipStream_t stream) {
    if (!fk::setup()) return;
    if (ws_size < fk::WS_END) { fprintf(stderr, "ws too small\n"); return; }
    (void)hipMemsetAsync((char*)d_ws + fk::WS_CTL, 0, fk::CTL_ZERO_BYTES, stream);
    fk::launch(d_in, (float*)d_out, d_ws, 0, fk::NPHASE, stream);
}
```

```cpp
#define RESBF16 1
#include <hip/hip_runtime.h>
#include <cstdint>
#include <cstdio>
#include <cmath>
namespace fk {
constexpr int D = 1024, TP = 8192, NBP = 2, MP = NBP * TP, NBS = 128, SS_ = 8, MS = NBS * SS_, M = MP + MS;
constexpr int DFF = 2816, NGU = 2 * DFF, HD = 64;
constexpr int NWAVES = 8, NTHREADS = 512;
constexpr float LOG2E = 1.4426950408889634f, C2 = 0.125f * LOG2E, EPS = 1e-6f;
constexpr size_t MiB = 1u << 20;
constexpr size_t WS_CTL = 0, CTL_ZERO_BYTES = 1 * MiB;
constexpr size_t WS_WQKVA = 1 * MiB;
constexpr size_t WS_WOA = WS_WQKVA + 6 * MiB;
constexpr size_t WS_WB2 = WS_WOA + 4 * MiB;
constexpr size_t WS_WB3 = WS_WB2 + 5 * MiB;
constexpr size_t WS_WOB = WS_WB3 + 3 * MiB;
constexpr size_t WS_WGU = WS_WOB + 2 * MiB;
constexpr size_t WS_WD = WS_WGU + 44 * MiB;
constexpr size_t WS_X = WS_WD + 22 * MiB;
constexpr size_t WS_XB = WS_X + 68 * MiB;
constexpr size_t WS_SS = WS_XB + 34 * MiB;
constexpr size_t WS_Q = WS_SS + 2 * MiB;
constexpr size_t WS_KA = WS_Q + 51 * MiB;
constexpr size_t WS_VA = WS_KA + 9 * MiB;
constexpr size_t WS_KB = WS_VA + 9 * MiB;
constexpr size_t WS_VB = WS_KB + 17 * MiB;
constexpr size_t WS_ATT = WS_VB + 17 * MiB;
constexpr size_t WS_OG = WS_ATT + 34 * MiB;
constexpr size_t WS_LSE = WS_OG + 51 * MiB;
constexpr size_t WS_H = WS_LSE + 2 * MiB;
constexpr size_t WS_CBK = WS_H + 94 * MiB;
constexpr size_t WS_CBV = WS_CBK + 256 * MiB;
constexpr size_t WS_END = WS_CBV + 256 * MiB;
static_assert(WS_END <= 1024 * MiB, "fast workspace must fit below 1 GiB");
constexpr size_t O0 = 0, O1 = 16777216ull, O2 = O1 + 1048576ull, O3 = O2 + 131072ull, O4 = O3 + 131072ull, O5 = O4 + 2097152ull,
                 O6 = O5 + 2097152ull, O7 = O6 + 8388608ull, O8 = O7 + 8388608ull, O9 = O8 + 134217728ull;
constexpr int CW_BAR = 4096;
constexpr int CW_BAR2 = 12288;
constexpr int RING_BYTES = 131072, MISC_OFF = RING_BYTES + 320, LDS_BYTES = 147456;

#define GAS __attribute__((address_space(1)))
#define LAS __attribute__((address_space(3)))
typedef unsigned short bf16;
typedef unsigned v4u __attribute__((ext_vector_type(4)));
typedef unsigned v2u __attribute__((ext_vector_type(2)));
typedef float f32x4 __attribute__((ext_vector_type(4)));
typedef float f32x16 __attribute__((ext_vector_type(16)));
typedef short bf16x8 __attribute__((ext_vector_type(8)));
typedef short s16x4 __attribute__((ext_vector_type(4)));
typedef float f32x2_t __attribute__((ext_vector_type(2)));
typedef __bf16 bf16x2_t __attribute__((ext_vector_type(2)));
__device__ __forceinline__ unsigned pkbf(float lo, float hi) { f32x2_t v = {lo, hi}; bf16x2_t b = __builtin_convertvector(v, bf16x2_t); return __builtin_bit_cast(unsigned, b); }
__device__ __forceinline__ float bflo(unsigned u) { return __uint_as_float(u << 16); }
__device__ __forceinline__ float bfhi(unsigned u) { return __uint_as_float(u & 0xffff0000u); }
__device__ __forceinline__ float wave_sum(float v) {
#pragma unroll
    for (int o = 1; o < 64; o <<= 1) v += __shfl_xor(v, o);
    return v;
}
__device__ __forceinline__ float rstd_row(const float* ss, int row) {
    const f32x4* p = (const f32x4*)(ss + (size_t)row * 16); const f32x4 a = p[0], b = p[1], c = p[2], d = p[3];
    const float s = ((a.x + a.y) + (a.z + a.w)) + ((b.x + b.y) + (b.z + b.w)) + ((c.x + c.y) + (c.z + c.w)) + ((d.x + d.y) + (d.z + d.w));
    return 1.0f / sqrtf(s * (1.0f / 1024.0f) + EPS);
}
__device__ __forceinline__ float slope_of(int idx, int n) { return exp2f(-8.0f * (float)(idx + 1) / (float)n); }
}
namespace pg8 {
#define PG8_LAS __attribute__((address_space(3)))
typedef unsigned short bf16_t;
typedef short bf16x8 __attribute__((ext_vector_type(8)));
typedef float f32x4 __attribute__((ext_vector_type(4)));
typedef unsigned u32x4 __attribute__((ext_vector_type(4)));
constexpr int BM = 256, BK = 64, HALF = 128, HTB = HALF * BK * 2  , STAGE_BYTES = 8 * HTB, NXCD = 8, WGM = 8;

__host__ __device__ __forceinline__ int lds_byte(int r, int c) { const int st = (r >> 4) * 2 + (c >> 5), rr = r & 15, cc = c & 31, ob = rr * 64 + cc * 2; return st * 1024 + (ob ^ (((ob >> 9) & 1) << 5)); }
__host__ __device__ __forceinline__ void stage_rc(int b, int& R, int& C) { const int st = b / 1024, sb = b % 1024, swz = sb ^ (((sb >> 9) & 1) << 5); R = (st >> 1) * 16 + swz / 64; C = (st & 1) * 32 + (swz % 64) / 2; }
__host__ __device__ __forceinline__ int perm32(int rho) { const int n = rho >> 4, i = rho & 15; return 8 * (i >> 2) + 4 * n + (i & 3); }

struct Unit { int pm, pn; };
struct Gemm { const bf16_t* A; const bf16_t* Bt; int M, N, K; };

struct StaticOrder {
    int nM, nN, nwg, G, c;
    __host__ __device__ void init(int M, int N, int G_, int c_) { nM = M / BM; nN = N / BM; nwg = nM * nN; G = G_; c = c_; }
    __host__ __device__ bool next(int i, Unit& u) const {
        const long L = (long)i * G + c; if (L >= nwg) return false;
        int wgid = (int)L; { const int q = nwg / NXCD, r = nwg % NXCD, xcd = wgid % NXCD, off = wgid / NXCD; wgid = (xcd < r ? xcd * (q + 1) : r * (q + 1) + (xcd - r) * q) + off; }
        const int nig = WGM * nN, gid = wgid / nig, fm = gid * WGM, gsz = (nM - fm) < WGM ? (nM - fm) : WGM;
        u.pm = fm + ((wgid % nig) % gsz); u.pn = (wgid % nig) / gsz; return true;
    }
    __device__ __forceinline__ void a_ready(const Unit&) const {}
    __device__ __forceinline__ void done(const Unit&) const {}
};

__device__ __forceinline__ unsigned cvt_pk_bf16(float lo, float hi) { unsigned r; asm volatile("v_cvt_pk_bf16_f32 %0, %1, %2" : "=v"(r) : "v"(lo), "v"(hi)); return r; }
typedef float f32x2 __attribute__((ext_vector_type(2)));
#ifndef REP_PROJ
#define REP_PROJ 1
#endif
#ifndef REP_GLU
#define REP_GLU 1
#endif
template <int KIND> struct EpiProj {
    static constexpr bool PERM = true, AFTER_DRAIN = false; static constexpr int REPS = REP_PROJ;
    const float* ss; bf16_t* Q; bf16_t* K; bf16_t* V; float* outKp; float* outVp; float* outKs; float* outVs;
    __device__ __forceinline__ void operator()(const f32x4 (&acc)[2][2][4][2], const Unit& u, int wr, int wc, int fr, int fq) const {
        const int row0 = u.pm * BM + wr * 64 + fr; const int pn = u.pn;
        bf16_t* dst; int ld, col; float sc = 1.0f; float* o32p = nullptr; float* o32s = nullptr; int kvw = 0;
        if (KIND == 0) { if (pn < 4) { dst = Q; ld = 1024; col = pn * 256; sc = fk::C2; } else if (pn == 4) { dst = K; ld = 256; col = 0; o32p = outKp; o32s = outKs; kvw = 256; } else { dst = V; ld = 256; col = 0; o32p = outVp; o32s = outVs; kvw = 256; } }
        else if (KIND == 1) { if (pn < 6) { dst = Q; ld = 1536; col = pn * 256; sc = fk::C2; } else if (pn < 8) { dst = K; ld = 512; col = (pn - 6) * 256; o32p = outKp; o32s = outKs; kvw = 512; } else { dst = V; ld = 512; col = (pn - 8) * 256; o32p = outVp; o32s = outVs; kvw = 512; } }
        else { dst = Q; ld = 1536; col = pn * 256; sc = fk::C2; }
        const int cl = col + wc * 32 + 8 * fq;
        float rsv[2][4];
#pragma unroll
        for (int ai = 0; ai < 2; ++ai)
#pragma unroll
            for (int m = 0; m < 4; ++m) { const f32x4 v = *(const f32x4*)(ss + (size_t)(row0 + ai * HALF + m * 16) * 16 + 4 * fq); rsv[ai][m] = (v[0] + v[1]) + (v[2] + v[3]); }
#pragma unroll
        for (int ai = 0; ai < 2; ++ai)
#pragma unroll
            for (int m = 0; m < 4; ++m) { float s = rsv[ai][m]; s += __shfl_xor(s, 16); s += __shfl_xor(s, 32); rsv[ai][m] = (1.0f / sqrtf(s * (1.0f / 1024.0f) + fk::EPS)) * sc; }
#pragma unroll
        for (int ai = 0; ai < 2; ++ai)
#pragma unroll
            for (int m = 0; m < 4; ++m) {
                const int r = row0 + ai * HALF + m * 16; const float rs = rsv[ai][m];
                float* o32 = nullptr;
                if (KIND != 2 && kvw) {
                    if (r < fk::MP) { const int b = r >> 13, t = r & 8191; const int W = (KIND == 0) ? 128 : 2048; if (t >= 8192 - W) o32 = o32p + ((size_t)b * W + (t - (8192 - W))) * kvw; }
                    else { const int rsx = r - fk::MP, b = rsx >> 3, s = rsx & 7; const int W = (KIND == 0) ? 128 : 2048; o32 = o32s + ((size_t)b * W + (W - 8) + s) * kvw; }
                }
#pragma unroll
                for (int bj = 0; bj < 2; ++bj) {
                    const f32x4 v0 = acc[ai][bj][m][0] * rs, v1 = acc[ai][bj][m][1] * rs;
                    u32x4 w; w.x = fk::pkbf(v0[0], v0[1]); w.y = fk::pkbf(v0[2], v0[3]); w.z = fk::pkbf(v1[0], v1[1]); w.w = fk::pkbf(v1[2], v1[3]);
                    *(u32x4*)(dst + (size_t)r * ld + cl + bj * HALF) = w;
                    if (KIND != 2) { if (o32) { *(f32x4*)(o32 + cl + bj * HALF) = v0; *(f32x4*)(o32 + cl + bj * HALF + 4) = v1; } }
                }
            }
    }
};
struct EpiRes {
    static constexpr bool PERM = true, AFTER_DRAIN = false; static constexpr int REPS = 1;
    float* X; bf16_t* XB; float* SS; float* Xo;
    __device__ __forceinline__ void operator()(const f32x4 (&acc)[2][2][4][2], const Unit& u, int wr, int wc, int fr, int fq) const {
        const int row0 = u.pm * BM + wr * 64 + fr; const int cl = u.pn * BM + wc * 32 + 8 * fq;
#ifdef RESBF16
#pragma unroll
        for (int ai = 0; ai < 2; ++ai) {
            u32x4 xin[4][2];
#pragma unroll
            for (int m = 0; m < 4; ++m)
#pragma unroll
                for (int bj = 0; bj < 2; ++bj) xin[m][bj] = *(const u32x4*)(XB + (size_t)(row0 + ai * HALF + m * 16) * 1024 + cl + bj * HALF);
#pragma unroll
            for (int m = 0; m < 4; ++m) {
                const int r = row0 + ai * HALF + m * 16; float q = 0.f;
#pragma unroll
                for (int bj = 0; bj < 2; ++bj) {
                    const u32x4 xb = xin[m][bj];
                    f32x4 x0 = {fk::bflo(xb.x), fk::bfhi(xb.x), fk::bflo(xb.y), fk::bfhi(xb.y)}, x1 = {fk::bflo(xb.z), fk::bfhi(xb.z), fk::bflo(xb.w), fk::bfhi(xb.w)};
                    x0 = x0 + acc[ai][bj][m][0]; x1 = x1 + acc[ai][bj][m][1];
                    u32x4 w; w.x = fk::pkbf(x0[0], x0[1]); w.y = fk::pkbf(x0[2], x0[3]); w.z = fk::pkbf(x1[0], x1[1]); w.w = fk::pkbf(x1[2], x1[3]);
                    *(u32x4*)(XB + (size_t)r * 1024 + cl + bj * HALF) = w;
                    const float r0 = fk::bflo(w.x), r1 = fk::bfhi(w.x), r2 = fk::bflo(w.y), r3 = fk::bfhi(w.y), r4 = fk::bflo(w.z), r5 = fk::bfhi(w.z), r6 = fk::bflo(w.w), r7 = fk::bfhi(w.w);
                    q += (r0 * r0 + r1 * r1) + (r2 * r2 + r3 * r3) + (r4 * r4 + r5 * r5) + (r6 * r6 + r7 * r7);
                }
                q += __shfl_xor(q, 16); q += __shfl_xor(q, 32);
                if (fq == 0) SS[(size_t)r * 16 + u.pn * 4 + wc] = q;
            }
        }
#else
#pragma unroll
        for (int ai = 0; ai < 2; ++ai) {
            f32x4 xin[4][2][2];
#pragma unroll
            for (int m = 0; m < 4; ++m)
#pragma unroll
                for (int bj = 0; bj < 2; ++bj) { const float* xp = X + (size_t)(row0 + ai * HALF + m * 16) * 1024 + cl + bj * HALF; xin[m][bj][0] = *(const f32x4*)xp; xin[m][bj][1] = *(const f32x4*)(xp + 4); }
#pragma unroll
            for (int m = 0; m < 4; ++m) {
                const int r = row0 + ai * HALF + m * 16; float q = 0.f;
#pragma unroll
                for (int bj = 0; bj < 2; ++bj) {
                    const f32x4 x0 = xin[m][bj][0] + acc[ai][bj][m][0], x1 = xin[m][bj][1] + acc[ai][bj][m][1];
                    { float* xo = Xo + (size_t)r * 1024 + cl + bj * HALF; *(f32x4*)xo = x0; *(f32x4*)(xo + 4) = x1; }
                    q += (x0[0] * x0[0] + x0[1] * x0[1]) + (x0[2] * x0[2] + x0[3] * x0[3]) + (x1[0] * x1[0] + x1[1] * x1[1]) + (x1[2] * x1[2] + x1[3] * x1[3]);
                    u32x4 w; w.x = fk::pkbf(x0[0], x0[1]); w.y = fk::pkbf(x0[2], x0[3]); w.z = fk::pkbf(x1[0], x1[1]); w.w = fk::pkbf(x1[2], x1[3]);
                    *(u32x4*)(XB + (size_t)r * 1024 + cl + bj * HALF) = w;
                }
                q += __shfl_xor(q, 16); q += __shfl_xor(q, 32);
                if (fq == 0) SS[(size_t)r * 16 + u.pn * 4 + wc] = q;
            }
        }
#endif
    }
};
struct EpiGlu {
    static constexpr bool PERM = true, AFTER_DRAIN = false; static constexpr int REPS = REP_GLU;
    const float* ss; bf16_t* H;
    __device__ __forceinline__ void operator()(const f32x4 (&acc)[2][2][4][2], const Unit& u, int wr, int wc, int fr, int fq) const {
        const int row0 = u.pm * BM + wr * 64 + fr; const int cl = u.pn * HALF + wc * 32 + 8 * fq;
        float rsv[2][4];
#pragma unroll
        for (int ai = 0; ai < 2; ++ai)
#pragma unroll
            for (int m = 0; m < 4; ++m) { const f32x4 v = *(const f32x4*)(ss + (size_t)(row0 + ai * HALF + m * 16) * 16 + 4 * fq); rsv[ai][m] = (v[0] + v[1]) + (v[2] + v[3]); }
#pragma unroll
        for (int ai = 0; ai < 2; ++ai)
#pragma unroll
            for (int m = 0; m < 4; ++m) { float s = rsv[ai][m]; s += __shfl_xor(s, 16); s += __shfl_xor(s, 32); rsv[ai][m] = 1.0f / sqrtf(s * (1.0f / 1024.0f) + fk::EPS); }
#pragma unroll
        for (int ai = 0; ai < 2; ++ai)
#pragma unroll
            for (int m = 0; m < 4; ++m) {
                const int r = row0 + ai * HALF + m * 16; const float rs = rsv[ai][m];
                float h[8];
#pragma unroll
                for (int n = 0; n < 2; ++n)
#pragma unroll
                    for (int e = 0; e < 4; ++e) { const float g = acc[ai][0][m][n][e] * rs, up = acc[ai][1][m][n][e] * rs;
                        const float sg = __builtin_amdgcn_rcpf(1.0f + __builtin_amdgcn_exp2f(-g * fk::LOG2E)); h[n * 4 + e] = g * sg * up; }
                u32x4 w; w.x = fk::pkbf(h[0], h[1]); w.y = fk::pkbf(h[2], h[3]); w.z = fk::pkbf(h[4], h[5]); w.w = fk::pkbf(h[6], h[7]);
                *(u32x4*)(H + (size_t)r * fk::DFF + cl) = w;
            }
    }
};
struct NoCopy { static constexpr bool ON = false; static constexpr int NP = 0; };
template <int NP_> struct CopyStreamT { static constexpr bool ON = true; static constexpr int NP = NP_; const char* src; char* dst; int& step; int nchunks; };
typedef CopyStreamT<2> CopyStream;
typedef unsigned cp_v4u __attribute__((ext_vector_type(4)));
template <class Epi, class Sched, bool ALIGN_EPI = false, bool SP2 = false, class CP = NoCopy>
__device__ __forceinline__ void gemm_phase(PG8_LAS unsigned char* lds, const Gemm g, const Sched& S, const Epi& E, const CP& cp = CP()) {
    const int tid = threadIdx.x, wid = __builtin_amdgcn_readfirstlane(tid >> 6), lane = tid & 63, wr = wid >> 2, wc = wid & 3, fr = lane & 15, fq = lane >> 4;
    const int K = g.K, nt = K / BK;
    unsigned voffA[2], voffB[2];
#pragma unroll
    for (int i = 0; i < 2; ++i) { int R, C; stage_rc(tid * 16 + i * 8192, R, C); const int Rb = Epi::PERM ? ((R & ~31) + perm32(R & 31)) : R;
        voffA[i] = (unsigned)(R * K + C) * 2u; voffB[i] = (unsigned)(Rb * K + C) * 2u; }
    const size_t kstep = (size_t)(BK * 2);
    const size_t hstep = (size_t)HALF * K * 2;
    const size_t tstep = 2 * hstep;
    const unsigned ldsw = (unsigned)wid * 1024u;
    const int aoff = lds_byte(wr * 64 + fr, fq * 8), boff = lds_byte(wc * 32 + fr, fq * 8);
#define PG8_SA(b, h) (((b) * 2 + (h)) * HTB)
#define PG8_SB(b, h) ((4 + (b) * 2 + (h)) * HTB)
#define PG8_STAGE(bufoff, gbase, voff) do { _Pragma("unroll") for (int _i = 0; _i < 2; ++_i) \
        __builtin_amdgcn_global_load_lds((const unsigned*)((const char*)(gbase) + (voff)[_i]), (PG8_LAS unsigned*)(lds + (bufoff) + ldsw + _i * 8192), 16, 0, 0); } while (0)
#define PG8_LDA(dst, b, h) do { _Pragma("unroll") for (int m = 0; m < 4; ++m) _Pragma("unroll") for (int k = 0; k < 2; ++k) dst[m][k] = *(const PG8_LAS bf16x8*)(lds + PG8_SA(b, h) + aoff + m * 2048 + k * 1024); } while (0)
#define PG8_LDB(dst, b, h) do { _Pragma("unroll") for (int n = 0; n < 2; ++n) _Pragma("unroll") for (int k = 0; k < 2; ++k) dst[n][k] = *(const PG8_LAS bf16x8*)(lds + PG8_SB(b, h) + boff + n * 2048 + k * 1024); } while (0)
#define PG8_MMA(ai, bj, At, Bt) do { __builtin_amdgcn_s_setprio(1); _Pragma("unroll") for (int m = 0; m < 4; ++m) _Pragma("unroll") for (int n = 0; n < 2; ++n) _Pragma("unroll") for (int k = 0; k < 2; ++k) \
        acc[ai][bj][m][n] = __builtin_amdgcn_mfma_f32_16x16x32_bf16(Bt[n][k], At[m][k], acc[ai][bj][m][n], 0, 0, 0); __builtin_amdgcn_s_setprio(0); } while (0)
#define PG8_WAIT_V(n) asm volatile("s_waitcnt vmcnt(" #n ")" ::: "memory")
#define PG8_WAIT_L(n) asm volatile("s_waitcnt lgkmcnt(" #n ")" ::: "memory")
#define PG8_BAR __builtin_amdgcn_s_barrier()
#define PG8_SCHED __builtin_amdgcn_sched_barrier(0)
    Unit cur, nxt; int ui = 0;
    if (!S.next(0, cur)) return;
    int cpstep = 0; unsigned cpoff = 0u; cp_v4u cpA = {0u, 0u, 0u, 0u}, cpB = {0u, 0u, 0u, 0u}, cpC = {0u, 0u, 0u, 0u}, cpD = {0u, 0u, 0u, 0u}; int cA_ = 0, cB_ = 0, cC_ = 0, cD_ = 0;
    if constexpr (CP::ON) { static_assert(SP2, "CopyStream rides the SP2 loop"); cpstep = cp.step; cpoff = (unsigned)wid * 1024u + (unsigned)lane * 16u; }
#define PG8_CPLOAD(buf, c) do { if constexpr (CP::ON) { const char* p_ = cp.src + (size_t)(c) * 8192 + cpoff; asm volatile("global_load_dwordx4 %0, %1, off nt" : "=v"(buf) : "v"(p_) : "memory"); } } while (0)
#define PG8_CPSTORE(buf, c) do { if constexpr (CP::ON) { char* p_ = cp.dst + (size_t)(c) * 8192 + cpoff; \
        if constexpr (CP::NP == 1) asm volatile("s_waitcnt vmcnt(8)\n\tglobal_store_dwordx4 %1, %0, off nt\n\ts_nop 1" : "+v"(buf) : "v"(p_) : "memory"); \
        else if constexpr (CP::NP == 2) asm volatile("s_waitcnt vmcnt(9)\n\tglobal_store_dwordx4 %1, %0, off nt\n\ts_nop 1" : "+v"(buf) : "v"(p_) : "memory"); \
        else if constexpr (CP::NP == 3) asm volatile("s_waitcnt vmcnt(10)\n\tglobal_store_dwordx4 %1, %0, off nt\n\ts_nop 1" : "+v"(buf) : "v"(p_) : "memory"); \
        else asm volatile("s_waitcnt vmcnt(11)\n\tglobal_store_dwordx4 %1, %0, off nt\n\ts_nop 1" : "+v"(buf) : "v"(p_) : "memory"); } } while (0)
#define PG8_CPBEGIN() do { if constexpr (CP::ON) { const int l_ = cp.nchunks - 1; cA_ = cpstep < l_ ? cpstep : l_; cB_ = cpstep + 1 < l_ ? cpstep + 1 : l_; cC_ = cpstep + 2 < l_ ? cpstep + 2 : l_; cD_ = cpstep + 3 < l_ ? cpstep + 3 : l_; cpstep = cpstep + CP::NP < cp.nchunks ? cpstep + CP::NP : cp.nchunks; } } while (0)
#define PG8_WAIT_VL() do { if constexpr (CP::NP == 4) { PG8_WAIT_V(12); } else if constexpr (CP::NP == 3) { PG8_WAIT_V(11); } else if constexpr (CP::NP == 2) { PG8_WAIT_V(10); } else if constexpr (CP::NP == 1) { PG8_WAIT_V(9); } else { PG8_WAIT_V(8); } } while (0)
    f32x4 acc[2][2][4][2];
#pragma unroll
    for (int a = 0; a < 2; ++a)
#pragma unroll
        for (int b = 0; b < 2; ++b)
#pragma unroll
            for (int m = 0; m < 4; ++m)
#pragma unroll
                for (int n = 0; n < 2; ++n) acc[a][b][m][n] = (f32x4){0.f, 0.f, 0.f, 0.f};
    bf16x8 At[4][2], B0[2][2], B1[2][2];
    const char* cA = (const char*)g.A + (size_t)cur.pm * tstep; const char* cB = (const char*)g.Bt + (size_t)cur.pn * tstep;
    S.a_ready(cur);
    if constexpr (SP2) {
        PG8_STAGE(PG8_SB(0, 0), cB, voffB); PG8_STAGE(PG8_SB(0, 1), cB + hstep, voffB); PG8_STAGE(PG8_SA(0, 0), cA, voffA); PG8_STAGE(PG8_SA(0, 1), cA + hstep, voffA);
        if (wr == 1) PG8_BAR;
        PG8_WAIT_V(2); PG8_BAR;
        PG8_STAGE(PG8_SB(1, 0), cB + kstep, voffB); PG8_STAGE(PG8_SA(1, 0), cA + kstep, voffA); PG8_STAGE(PG8_SB(1, 1), cB + hstep + kstep, voffB);
        PG8_WAIT_V(6); PG8_BAR;
    } else {
        PG8_STAGE(PG8_SB(0, 0), cB, voffB); PG8_STAGE(PG8_SA(0, 0), cA, voffA); PG8_STAGE(PG8_SB(0, 1), cB + hstep, voffB); PG8_STAGE(PG8_SA(0, 1), cA + hstep, voffA);
        if (wr == 1) PG8_BAR;
        PG8_WAIT_V(4); PG8_BAR;
        PG8_STAGE(PG8_SB(1, 0), cB + kstep, voffB); PG8_STAGE(PG8_SA(1, 0), cA + kstep, voffA); PG8_STAGE(PG8_SB(1, 1), cB + hstep + kstep, voffB);
        PG8_WAIT_V(6); PG8_BAR;
    }
    for (;;) {
        const bool has_next = S.next(ui + 1, nxt);
        const char* nA = has_next ? (const char*)g.A + (size_t)nxt.pm * tstep : cA; const char* nB = has_next ? (const char*)g.Bt + (size_t)nxt.pn * tstep : cB;
        for (int t = 0; t < nt; t += 2) {
            const bool last = (t == nt - 2);
            const char* a1 = cA + (size_t)(t + 1) * kstep;
            const char* a2 = last ? nA : cA + (size_t)(t + 2) * kstep; const char* b2 = last ? nB : cB + (size_t)(t + 2) * kstep;
            const char* a3 = a2 + kstep; const char* b3 = b2 + kstep;
            if (last && has_next) S.a_ready(nxt);
            if constexpr (SP2) {
            PG8_LDB(B0, 0, 0); PG8_LDB(B1, 0, 1); PG8_SCHED; PG8_LDA(At, 0, 0); PG8_STAGE(PG8_SA(1, 1), a1 + hstep, voffA); PG8_CPBEGIN(); PG8_CPLOAD(cpA, cA_); if constexpr (CP::NP >= 2) { PG8_CPLOAD(cpB, cB_); } if constexpr (CP::NP >= 3) { PG8_CPLOAD(cpC, cC_); } if constexpr (CP::NP >= 4) { PG8_CPLOAD(cpD, cD_); }
            PG8_WAIT_VL(); PG8_WAIT_L(0); PG8_BAR; PG8_MMA(0, 0, At, B0); PG8_MMA(0, 1, At, B1); PG8_BAR; PG8_SCHED;
            PG8_LDA(At, 0, 1); PG8_STAGE(PG8_SB(0, 0), b2, voffB); PG8_STAGE(PG8_SB(0, 1), b2 + hstep, voffB); PG8_STAGE(PG8_SA(0, 0), a2, voffA);
            PG8_WAIT_VL(); PG8_WAIT_L(0); PG8_BAR; PG8_MMA(1, 0, At, B0); PG8_MMA(1, 1, At, B1); PG8_BAR; PG8_SCHED;
            PG8_LDB(B0, 1, 0); PG8_LDB(B1, 1, 1); PG8_SCHED; PG8_LDA(At, 1, 0); PG8_STAGE(PG8_SA(0, 1), a2 + hstep, voffA); PG8_CPSTORE(cpA, cA_); if constexpr (CP::NP >= 2) { PG8_CPSTORE(cpB, cB_); } if constexpr (CP::NP >= 3) { PG8_CPSTORE(cpC, cC_); } if constexpr (CP::NP >= 4) { PG8_CPSTORE(cpD, cD_); }
            PG8_WAIT_VL(); PG8_WAIT_L(0); PG8_BAR; PG8_MMA(0, 0, At, B0); PG8_MMA(0, 1, At, B1); PG8_BAR; PG8_SCHED;
            PG8_LDA(At, 1, 1); PG8_STAGE(PG8_SB(1, 0), b3, voffB); PG8_STAGE(PG8_SB(1, 1), b3 + hstep, voffB); PG8_STAGE(PG8_SA(1, 0), a3, voffA);
            PG8_WAIT_VL(); PG8_WAIT_L(0); PG8_BAR; PG8_MMA(1, 0, At, B0); PG8_MMA(1, 1, At, B1); PG8_BAR; PG8_SCHED;
            } else {
            PG8_LDB(B0, 0, 0); PG8_SCHED; PG8_LDA(At, 0, 0); PG8_STAGE(PG8_SA(1, 1), a1 + hstep, voffA);
            PG8_WAIT_L(8); PG8_BAR; PG8_WAIT_L(0); PG8_MMA(0, 0, At, B0); PG8_BAR; PG8_SCHED;
            PG8_LDB(B1, 0, 1); PG8_STAGE(PG8_SB(0, 0), b2, voffB);
            PG8_BAR; PG8_WAIT_L(0); PG8_MMA(0, 1, At, B1); PG8_BAR;
            PG8_LDA(At, 0, 1); PG8_STAGE(PG8_SA(0, 0), a2, voffA);
            PG8_BAR; PG8_WAIT_L(0); PG8_MMA(1, 0, At, B0); PG8_BAR; PG8_SCHED;
            PG8_STAGE(PG8_SB(0, 1), b2 + hstep, voffB);
            PG8_WAIT_V(6); PG8_BAR; PG8_MMA(1, 1, At, B1); PG8_BAR;
            PG8_LDB(B0, 1, 0); PG8_SCHED; PG8_LDA(At, 1, 0); PG8_STAGE(PG8_SA(0, 1), a2 + hstep, voffA);
            PG8_WAIT_L(8); PG8_BAR; PG8_WAIT_L(0); PG8_MMA(0, 0, At, B0); PG8_BAR; PG8_SCHED;
            PG8_LDB(B1, 1, 1); PG8_STAGE(PG8_SB(1, 0), b3, voffB);
            PG8_BAR; PG8_WAIT_L(0); PG8_MMA(0, 1, At, B1); PG8_BAR;
            PG8_LDA(At, 1, 1); PG8_STAGE(PG8_SA(1, 0), a3, voffA);
            PG8_BAR; PG8_WAIT_L(0); PG8_MMA(1, 0, At, B0); PG8_BAR; PG8_SCHED;
            PG8_STAGE(PG8_SB(1, 1), b3 + hstep, voffB);
            PG8_WAIT_V(6); PG8_BAR; PG8_MMA(1, 1, At, B1); PG8_BAR;
            }
        }
        if constexpr (ALIGN_EPI) { if (wr == 0) PG8_BAR; }
        if constexpr (!Epi::AFTER_DRAIN) { E(acc, cur, wr, wc, fr, fq); S.done(cur); }
        if (!has_next) break;
#pragma unroll
        for (int a = 0; a < 2; ++a)
#pragma unroll
            for (int b = 0; b < 2; ++b)
#pragma unroll
                for (int m = 0; m < 4; ++m)
#pragma unroll
                    for (int n = 0; n < 2; ++n) acc[a][b][m][n] = (f32x4){0.f, 0.f, 0.f, 0.f};
        cur = nxt; cA = nA; cB = nB; ++ui;
        if constexpr (ALIGN_EPI) { if (wr == 1) PG8_BAR; }
    }
    if constexpr (CP::ON) cp.step = cpstep;
    PG8_WAIT_V(0);
    if constexpr (!ALIGN_EPI) { if (wr == 0) PG8_BAR; }
    PG8_BAR;
    if constexpr (Epi::AFTER_DRAIN) { E.fused(acc, cur, wr, wc, fr, fq, lds, wid, lane); S.done(cur); }
#undef PG8_SA
#undef PG8_SB
#undef PG8_STAGE
#undef PG8_LDA
#undef PG8_LDB
#undef PG8_MMA
#undef PG8_WAIT_V
#undef PG8_WAIT_L
#undef PG8_BAR
#undef PG8_SCHED
#undef PG8_CPLOAD
#undef PG8_CPSTORE
#undef PG8_CPBEGIN
#undef PG8_WAIT_VL
}
}
#define XB_TMO      128
#define XB_XCNT(j)  (256  + 64 * (j))
#define XB_XSUB(j)  (1280 + 64 * (j))
#define XB_XGEN(j)  (2304 + 64 * (j))
#define XB_TOP      3328
#define XB_TOPGEN   3392
#define XCD_BAR_WORDS 3456
#define XB_SPIN_CAP (1u << 18)

__device__ __forceinline__ unsigned xb_ld(unsigned* p)              { return __hip_atomic_load(p, __ATOMIC_RELAXED, __HIP_MEMORY_SCOPE_AGENT); }
__device__ __forceinline__ unsigned xb_add(unsigned* p, unsigned v) { return __hip_atomic_fetch_add(p, v, __ATOMIC_RELAXED, __HIP_MEMORY_SCOPE_AGENT); }
__device__ __forceinline__ unsigned xb_xcc_id() { return (unsigned)__builtin_amdgcn_s_getreg((3 << 11) | 20) & 0xFu; }
#define XB_SPIN(cond, bar) do { unsigned _sp = 0; while (cond) { __builtin_amdgcn_s_sleep(1); \
    if ((++_sp & 255u) == 0u) { if (xb_ld(&(bar)[XB_TMO])) break; if (_sp > XB_SPIN_CAP) { atomicAdd(&(bar)[XB_TMO], 1u); break; } } } } while (0)

struct XcdBarrier {
    unsigned* bar; unsigned x;
    volatile LAS unsigned* st;
};

__device__ __forceinline__ XcdBarrier xcd_barrier_post(unsigned* bar, volatile LAS unsigned* st) {
    XcdBarrier b; b.bar = bar; b.x = xb_xcc_id(); b.st = st;
    if (threadIdx.x == 0) (void)xb_add(&bar[XB_XCNT(b.x)], 1u);
    return b;
}
__device__ __forceinline__ void xcd_barrier_complete(unsigned* bar, unsigned x, unsigned& nloc, unsigned& nx) {
    const unsigned G = gridDim.x * gridDim.y * gridDim.z;
    unsigned sum, cnt, mine, sp = 0u;
    for (;;) {
        sum = 0u; cnt = 0u; mine = 0u;
#pragma unroll
        for (unsigned j = 0; j < 16; ++j) { const unsigned c = xb_ld(&bar[XB_XCNT(j)]); sum += c; cnt += (c > 0u) ? 1u : 0u; mine = (j == x) ? c : mine; }
        if (sum == G) break;
        __builtin_amdgcn_s_sleep(1);
        if ((++sp & 255u) == 0u) { if (xb_ld(&bar[XB_TMO])) break; if (sp > XB_SPIN_CAP) { atomicAdd(&bar[XB_TMO], 1u); break; } }
    }
    nloc = mine > 0u ? mine : 1u; nx = cnt > 0u ? cnt : 1u;
}

__device__ __forceinline__ void xcd_barrier_thread(const XcdBarrier& b) {
    {
        unsigned* bar = b.bar;
        __builtin_amdgcn_s_waitcnt(0);
        unsigned nloc = b.st[0], nx = b.st[1];
        if (nloc == 0u) { xcd_barrier_complete(bar, b.x, nloc, nx); b.st[0] = nloc; b.st[1] = nx; }
        const unsigned old = xb_add(&bar[XB_XSUB(b.x)], 1u);
        const unsigned gen = old / nloc;
        if (old + 1u == (gen + 1u) * nloc) {
            __builtin_amdgcn_fence(__ATOMIC_RELEASE, "agent");
            asm volatile("s_waitcnt vmcnt(0)" ::: "memory");
            const unsigned og = xb_add(&bar[XB_TOP], 1u);
            const unsigned tg = og / nx;
            if (og + 1u == (tg + 1u) * nx) xb_add(&bar[XB_TOPGEN], 1u);
            else XB_SPIN(xb_ld(&bar[XB_TOPGEN]) == tg, bar);
            __builtin_amdgcn_fence(__ATOMIC_ACQUIRE, "agent");
            xb_add(&bar[XB_XGEN(b.x)], 1u);
            asm volatile("s_waitcnt vmcnt(0)" ::: "memory");
        } else {
            XB_SPIN(xb_ld(&bar[XB_XGEN(b.x)]) == gen, bar);
            __builtin_amdgcn_fence(__ATOMIC_ACQUIRE, "agent");
            asm volatile("s_waitcnt vmcnt(0)" ::: "memory");
        }
    }
}
__device__ __forceinline__ void xcd_barrier(const XcdBarrier& b) {
    asm volatile("s_waitcnt vmcnt(0)" ::: "memory");
    __syncthreads();
    if (threadIdx.x == 0) xcd_barrier_thread(b);
    __syncthreads();
}
namespace fk {
struct Frame {
    LAS unsigned char* lds; volatile LAS unsigned* MISC; unsigned* ctl;
    int wave, vcu, G;
    int fuse;
    int cps;
    __device__ __forceinline__ int lane() const { int l; asm volatile("v_mbcnt_lo_u32_b32 %0, -1, 0\n\tv_mbcnt_hi_u32_b32 %0, -1, %0" : "=v"(l)); return l; }
    __device__ __forceinline__ int tid() const { return wave * 64 + lane(); }
    const float *xp, *xs, *cak, *cav, *cbk, *cbv, *g_attn, *g_ffn, *w_qkv_a, *sinks_a, *w_o_a, *g_kv, *w_kv_s, *w_q_b, *w_o_b, *w_gu, *w_dn, *g_final;
    float* out;
    bf16 *WqkvA, *WoA, *Wb2, *Wb3, *WoB, *Wgu, *Wd;
    float* X; bf16* XB; float* SS;
    bf16 *Q, *KA, *VA, *KB, *VB, *ATT, *OG, *H, *CBK, *CBV; float* LSE;
};
__device__ __forceinline__ void transpose_item(const float* W, int ldw, int K, const float* gain, bf16* WT, int n0dst, int csrc, int k0, LAS float* scr, int lane) {
    f32x4 v[16];
#pragma unroll
    for (int i = 0; i < 16; ++i) { const int kk = 2 * i + (lane >> 5); v[i] = *(const f32x4*)(W + (size_t)(k0 + kk) * ldw + csrc + 4 * (lane & 31)); }
#pragma unroll
    for (int i = 0; i < 16; ++i) { const int kk = 2 * i + (lane >> 5); f32x4 x = v[i]; if (gain) { const float g = gain[k0 + kk]; x = x * g; } *(LAS f32x4*)(scr + kk * 128 + 4 * (lane & 31)) = x; }
    asm volatile("s_waitcnt lgkmcnt(0)" ::: "memory");
    const int kc = lane & 3;
#pragma unroll
    for (int j = 0; j < 8; ++j) { const int n = (lane >> 2) + 16 * j; const LAS float* s = scr + (8 * kc) * 128 + n;
        v4u o; o.x = pkbf(s[0 * 128], s[1 * 128]); o.y = pkbf(s[2 * 128], s[3 * 128]); o.z = pkbf(s[4 * 128], s[5 * 128]); o.w = pkbf(s[6 * 128], s[7 * 128]);
        *(v4u*)(WT + (size_t)(n0dst + n) * K + k0 + 8 * kc) = o; }
    asm volatile("s_waitcnt lgkmcnt(0)" ::: "memory");
}
template <bool GU> __device__ __forceinline__ void transpose_matrix(const float* W, int K, int N, const float* gain, bf16* WT, int rowoff, LAS float* scr, int lane, int item) {
    const int nblk = N / 128, kb = item / nblk, nb = item % nblk; const int n0 = nb * 128; int csrc = n0;
    if (GU) { const int pn = n0 >> 8, j = n0 & 255; csrc = (j < 128) ? (128 * pn) : (DFF + 128 * pn); }
    transpose_item(W, N, K, gain, WT, rowoff + n0, csrc, kb * 32, scr, lane);
}
constexpr int CV_QKV = (1024 / 32) * (1536 / 128), CV_SQ = (1024 / 32) * (1024 / 128), CV_OB = (512 / 32) * (1024 / 128), CV_GU = (1024 / 32) * (NGU / 128), CV_DN = (DFF / 32) * (1024 / 128);
constexpr int CV_A = CV_QKV + CV_SQ + CV_GU + CV_DN, CV_B0 = CV_QKV + CV_SQ + CV_OB + CV_GU + CV_DN, CV_B1 = CV_QKV + CV_OB + CV_GU + CV_DN, CV_ALL = 2 * CV_A + CV_B0 + CV_B1;
static_assert(CV_ALL == 11008, "conversion item count");
constexpr int CONV_P0 = 1200;
constexpr int CONV_WIN[17] = {1200, 3200, 3200, 3900, 3900, 5900, 5900, 6600, 6600, 8300, 8300, 9000, 9000, 10400, 10400, 11008, 11008};
__device__ __forceinline__ void conv_item(Frame& F, LAS float* scr, int lane, int it) {
    int r = it;
    if (r < 2 * CV_A) { const int l = r / CV_A; r -= l * CV_A;
        if (r < CV_QKV) { transpose_matrix<false>(F.w_qkv_a + (size_t)l * 1024 * 1536, 1024, 1536, F.g_attn + l * 1024, F.WqkvA + (size_t)l * 1536 * 1024, 0, scr, lane, r); return; } r -= CV_QKV;
        if (r < CV_SQ) { transpose_matrix<false>(F.w_o_a + (size_t)l * 1024 * 1024, 1024, 1024, nullptr, F.WoA + (size_t)l * 1024 * 1024, 0, scr, lane, r); return; } r -= CV_SQ;
        if (r < CV_GU) { transpose_matrix<true>(F.w_gu + (size_t)l * 1024 * NGU, 1024, NGU, F.g_ffn + l * 1024, F.Wgu + (size_t)l * NGU * 1024, 0, scr, lane, r); return; } r -= CV_GU;
        transpose_matrix<false>(F.w_dn + (size_t)l * DFF * 1024, DFF, 1024, nullptr, F.Wd + (size_t)l * 1024 * DFF, 0, scr, lane, r); return; }
    r -= 2 * CV_A;
    if (r < CV_B0) {
        if (r < CV_QKV) { transpose_matrix<false>(F.w_q_b, 1024, 1536, F.g_attn + 2 * 1024, F.Wb2, 0, scr, lane, r); return; } r -= CV_QKV;
        if (r < CV_SQ) { transpose_matrix<false>(F.w_kv_s, 1024, 1024, F.g_kv, F.Wb2, 1536, scr, lane, r); return; } r -= CV_SQ;
        if (r < CV_OB) { transpose_matrix<false>(F.w_o_b, 512, 1024, nullptr, F.WoB, 0, scr, lane, r); return; } r -= CV_OB;
        if (r < CV_GU) { transpose_matrix<true>(F.w_gu + (size_t)2 * 1024 * NGU, 1024, NGU, F.g_ffn + 2 * 1024, F.Wgu + (size_t)2 * NGU * 1024, 0, scr, lane, r); return; } r -= CV_GU;
        transpose_matrix<false>(F.w_dn + (size_t)2 * DFF * 1024, DFF, 1024, nullptr, F.Wd + (size_t)2 * 1024 * DFF, 0, scr, lane, r); return; }
    r -= CV_B0;
    if (r < CV_QKV) { transpose_matrix<false>(F.w_q_b + (size_t)1024 * 1536, 1024, 1536, F.g_attn + 3 * 1024, F.Wb3, 0, scr, lane, r); return; } r -= CV_QKV;
    if (r < CV_OB) { transpose_matrix<false>(F.w_o_b + (size_t)512 * 1024, 512, 1024, nullptr, F.WoB + (size_t)1024 * 512, 0, scr, lane, r); return; } r -= CV_OB;
    if (r < CV_GU) { transpose_matrix<true>(F.w_gu + (size_t)3 * 1024 * NGU, 1024, NGU, F.g_ffn + 3 * 1024, F.Wgu + (size_t)3 * NGU * 1024, 0, scr, lane, r); return; } r -= CV_GU;
    transpose_matrix<false>(F.w_dn + (size_t)3 * DFF * 1024, DFF, 1024, nullptr, F.Wd + (size_t)3 * 1024 * DFF, 0, scr, lane, r);
}
__device__ __forceinline__ void conv_items(Frame& F, int lo, int hi, int j, int n) {
    LAS float* scr = (LAS float*)(F.lds + F.wave * 16384); const int lane = F.lane();
    for (int it = lo + j * NWAVES + F.wave; it < hi; it += n * NWAVES) conv_item(F, scr, lane, it);
}
__device__ __forceinline__ void p0_weights(Frame& F) { conv_items(F, 0, CONV_P0, F.vcu, F.G); }
template <int WIN> __device__ __forceinline__ void conv_window(Frame& F, int nwg) {
    const int rem = nwg % F.G; if (rem == 0) return; const int c = (int)blockIdx.x; if (c < rem) return;
    if (CONV_WIN[WIN] < CONV_WIN[WIN + 1]) conv_items(F, CONV_WIN[WIN], CONV_WIN[WIN + 1], c - rem, F.G - rem);
}
__device__ __forceinline__ void p0_x(Frame& F) {
    const int lane = F.lane(); const int gw = F.vcu * NWAVES + F.wave, NGW = F.G * NWAVES;
    for (int m0 = gw * 2; m0 < M; m0 += NGW * 2) {
        f32x4 v[2][4]; float s[2];
#pragma unroll
        for (int q = 0; q < 2; ++q) { const int m = m0 + q; const float* src = (m < MP) ? F.xp + (size_t)m * D : F.xs + (size_t)(m - MP) * D; const f32x4* xr = (const f32x4*)src + lane;
#pragma unroll
            for (int j = 0; j < 4; ++j) v[q][j] = xr[64 * j]; }
#ifdef RESBF16
#pragma unroll
        for (int q = 0; q < 2; ++q) { float a = 0.f; const int m = m0 + q; v2u* bo = (v2u*)(F.XB + (size_t)m * D) + lane;
#pragma unroll
            for (int j = 0; j < 4; ++j) { v2u w; w.x = pkbf(v[q][j].x, v[q][j].y); w.y = pkbf(v[q][j].z, v[q][j].w); bo[64 * j] = w;
                const float r0 = bflo(w.x), r1 = bfhi(w.x), r2 = bflo(w.y), r3 = bfhi(w.y); a += (r0 * r0 + r1 * r1) + (r2 * r2 + r3 * r3); }
            s[q] = wave_sum(a); if (lane < 16) F.SS[(size_t)m * 16 + lane] = (lane == 0) ? s[q] : 0.f; }
#else
#pragma unroll
        for (int q = 0; q < 2; ++q) { float a = 0.f;
#pragma unroll
            for (int j = 0; j < 4; ++j) a += (v[q][j].x * v[q][j].x + v[q][j].y * v[q][j].y) + (v[q][j].z * v[q][j].z + v[q][j].w * v[q][j].w);
            s[q] = wave_sum(a); }
#pragma unroll
        for (int q = 0; q < 2; ++q) { const int m = m0 + q; f32x4* xo = (f32x4*)(F.X + (size_t)m * D) + lane; v2u* bo = (v2u*)(F.XB + (size_t)m * D) + lane;
#pragma unroll
            for (int j = 0; j < 4; ++j) { xo[64 * j] = v[q][j]; v2u w; w.x = pkbf(v[q][j].x, v[q][j].y); w.y = pkbf(v[q][j].z, v[q][j].w); bo[64 * j] = w; }
            if (lane < 16) F.SS[(size_t)m * 16 + lane] = (lane == 0) ? s[q] : 0.f; }
#endif
    }
}
constexpr int BG_ROWS = 2 * NBS * 2040;
constexpr int BG_NWIN = 16;
constexpr int BG_W[BG_NWIN + 1] = {124, 0, 48, 0, 124, 0, 48, 0, 105, 0, 48, 0, 124, 0, 48, 0, 4100};
constexpr int bg_wsum(int n) { int s = 0; for (int i = 0; i < n; ++i) s += BG_W[i]; return s; }
constexpr int bg_row0(int w) { return (int)((long long)BG_ROWS * bg_wsum(w) / bg_wsum(BG_NWIN + 1)); }
__device__ __forceinline__ void bg_copy_rows(Frame& F, int r0, int r1, int j, int n) {
    const int lane = F.lane(); const int nwv = n * NWAVES;
    for (int r = r0 + (j * NWAVES + F.wave) * 4; r < r1; r += nwv * 4) {
        f32x4 a[4], c[4]; float* dst[4];
#pragma unroll
        for (int q = 0; q < 4; ++q) { const int rid = (r + q < r1) ? (r + q) : (r1 - 1); const int kv = rid / (NBS * 2040), rem = rid - kv * (NBS * 2040), b = rem / 2040, i = rem - b * 2040;
            const float* src = (kv ? F.cbv : F.cbk) + ((size_t)b * 2048 + i + 8) * 512; dst[q] = F.out + (kv ? O9 : O8) + ((size_t)b * 2048 + i) * 512;
            a[q] = ((const f32x4*)src)[lane]; c[q] = ((const f32x4*)src)[lane + 64]; }
#pragma unroll
        for (int q = 0; q < 4; ++q) { ((f32x4*)dst[q])[lane] = a[q]; ((f32x4*)dst[q])[lane + 64] = c[q]; }
    }
}
template <int WIN> __device__ __forceinline__ void bg_window(Frame& F, int nwg) {
    const int rem = nwg % F.G; if (rem == 0) return; const int c = (int)blockIdx.x; if (c < rem) return;
#ifndef REP_BG
#define REP_BG 1
#endif
    for (int rep = 0; rep < REP_BG; ++rep) bg_copy_rows(F, bg_row0(WIN), bg_row0(WIN + 1), c - rem, F.G - rem);
}
constexpr int CP_NCHUNKS = 510;
__device__ __forceinline__ const char* cp_src(Frame& F) { const int c = (int)blockIdx.x, kv = (c >> 7) & 1, b = c & 127; return (const char*)((kv ? F.cbv : F.cbk) + ((size_t)b * 2048 + 8) * 512); }
__device__ __forceinline__ char* cp_dst(Frame& F) { const int c = (int)blockIdx.x, kv = (c >> 7) & 1, b = c & 127; return (char*)(F.out + (kv ? O9 : O8) + (size_t)b * 2048 * 512); }
__device__ __forceinline__ void cp_finish(Frame& F) {
    const int lane = F.lane(); const unsigned off = (unsigned)F.wave * 1024u + (unsigned)lane * 16u; const char* s = cp_src(F); char* d = cp_dst(F);
    for (int c = F.cps; c < CP_NCHUNKS; c += 4) { v4u v[4];
#pragma unroll
        for (int q = 0; q < 4; ++q) { const int cc = (c + q < CP_NCHUNKS) ? c + q : CP_NCHUNKS - 1; v[q] = *(const v4u*)(s + (size_t)cc * 8192 + off); }
#pragma unroll
        for (int q = 0; q < 4; ++q) { const int cc = (c + q < CP_NCHUNKS) ? c + q : CP_NCHUNKS - 1; *(v4u*)(d + (size_t)cc * 8192 + off) = v[q]; } }
    F.cps = CP_NCHUNKS;
}
#define MFMA32(a, b, c) __builtin_amdgcn_mfma_f32_32x32x16_bf16((a), (b), (c), 0, 0, 0)
__device__ __forceinline__ int crow(int reg, int h) { return (reg & 3) + 8 * (reg >> 2) + 4 * h; }
struct BandArgs {
    const bf16* Qp; int ldq;
    const bf16* Kp; const bf16* Vp; int ldkv;
    int rowbase; int rstride;
    int i0;
    bf16* Op; int ldo;
    float* lsep; int ldl;
    float slope2; float sink2;
};
template <int MODE> struct BandRegs { static constexpr int QB = (MODE == 0) ? 64 : 256, NK = QB + 128, NIT = NK * 8 / NTHREADS; v4u k[NIT], v[NIT]; };
template <int MODE> __device__ __forceinline__ void band_fetch(BandRegs<MODE>& R, const BandArgs& a, int tid) {
    constexpr int NIT = BandRegs<MODE>::NIT;
#pragma unroll
    for (int it = 0; it < NIT; ++it) {
        const int c = it * NTHREADS + tid, kk = c >> 3, ch = c & 7; const int i = a.i0 - 128 + kk;
        R.k[it] = (v4u){0u, 0u, 0u, 0u}; R.v[it] = (v4u){0u, 0u, 0u, 0u};
        if (i >= 0) { const size_t row = (size_t)(a.rowbase + i * a.rstride); R.k[it] = *(const v4u*)(a.Kp + row * a.ldkv + ch * 8); R.v[it] = *(const v4u*)(a.Vp + row * a.ldkv + ch * 8); }
    }
}
template <int MODE> __device__ __forceinline__ void band_put(LAS unsigned char* lds, const BandRegs<MODE>& R, int tid) {
    constexpr int NK = BandRegs<MODE>::NK, NIT = BandRegs<MODE>::NIT, VSTR = 2 * NK + 8;
    LAS unsigned char* Kl = lds; LAS unsigned char* Vt = lds + NK * 144;
#pragma unroll
    for (int it = 0; it < NIT; ++it) {
        const int c = it * NTHREADS + tid, kk = c >> 3, ch = c & 7; const v4u kq = R.k[it], vq = R.v[it];
        *(LAS v4u*)(Kl + kk * 144 + ch * 16) = kq;
        LAS unsigned char* vt = Vt + (ch * 8) * VSTR + kk * 2;
        *(LAS unsigned short*)(vt) = (unsigned short)(vq.x & 0xffffu); *(LAS unsigned short*)(vt + 1 * VSTR) = (unsigned short)(vq.x >> 16);
        *(LAS unsigned short*)(vt + 2 * VSTR) = (unsigned short)(vq.y & 0xffffu); *(LAS unsigned short*)(vt + 3 * VSTR) = (unsigned short)(vq.y >> 16);
        *(LAS unsigned short*)(vt + 4 * VSTR) = (unsigned short)(vq.z & 0xffffu); *(LAS unsigned short*)(vt + 5 * VSTR) = (unsigned short)(vq.z >> 16);
        *(LAS unsigned short*)(vt + 6 * VSTR) = (unsigned short)(vq.w & 0xffffu); *(LAS unsigned short*)(vt + 7 * VSTR) = (unsigned short)(vq.w >> 16);
    }
}
template <int NK, int MAXD, bool SINK>
__device__ __forceinline__ void band_compute(LAS unsigned char* Kl, LAS unsigned char* Vt, int kk0, const bf16x8 (&qf)[4], int distbase, int keyidx0, float slope2, float sink2, int lane, f32x16 (&o)[2], float& m_out, float& l_out) {
    constexpr int VSTR = 2 * NK + 8; const int rl = lane & 31, h = lane >> 5;
    f32x16 S[5];
#pragma unroll
    for (int kt = 0; kt < 5; ++kt) {
        f32x16 accs = {0.f, 0.f, 0.f, 0.f, 0.f, 0.f, 0.f, 0.f, 0.f, 0.f, 0.f, 0.f, 0.f, 0.f, 0.f, 0.f};
#pragma unroll
        for (int d0 = 0; d0 < 4; ++d0) { const bf16x8 kf = *(const LAS bf16x8*)(Kl + (kk0 + 32 * kt + rl) * 144 + (16 * d0 + 8 * h) * 2); accs = MFMA32(kf, qf[d0], accs); }
        S[kt] = accs;
    }
    float mx = -INFINITY;
    const int d0i = distbase + rl - 4 * h, qi = distbase + rl + keyidx0; const unsigned lim = (unsigned)(qi < MAXD ? qi : MAXD); const float nsl = -slope2;
#pragma unroll
    for (int kt = 0; kt < 5; ++kt)
#pragma unroll
        for (int rg = 0; rg < 16; ++rg) { const int dist = d0i - (32 * kt + (rg & 3) + 8 * (rg >> 2)); const bool ok = (unsigned)dist <= lim;
            const float s = ok ? __builtin_fmaf(nsl, (float)dist, S[kt][rg]) : -INFINITY; S[kt][rg] = s; mx = fmaxf(mx, s); }
    mx = fmaxf(mx, __shfl_xor(mx, 32)); if (SINK) mx = fmaxf(mx, sink2);
    float l = 0.f;
#pragma unroll
    for (int kt = 0; kt < 5; ++kt)
#pragma unroll
        for (int rg = 0; rg < 16; ++rg) { const float p = __builtin_amdgcn_exp2f(S[kt][rg] - mx); S[kt][rg] = p; l += p; }
    l += __shfl_xor(l, 32); if (SINK) l += __builtin_amdgcn_exp2f(sink2 - mx);
    o[0] = (f32x16){0.f, 0.f, 0.f, 0.f, 0.f, 0.f, 0.f, 0.f, 0.f, 0.f, 0.f, 0.f, 0.f, 0.f, 0.f, 0.f}; o[1] = o[0];
#pragma unroll
    for (int kt = 0; kt < 5; ++kt)
#pragma unroll
        for (int s2 = 0; s2 < 2; ++s2) {
            v4u pw; pw.x = pkbf(S[kt][8 * s2 + 0], S[kt][8 * s2 + 1]); pw.y = pkbf(S[kt][8 * s2 + 2], S[kt][8 * s2 + 3]); pw.z = pkbf(S[kt][8 * s2 + 4], S[kt][8 * s2 + 5]); pw.w = pkbf(S[kt][8 * s2 + 6], S[kt][8 * s2 + 7]);
            const bf16x8 xs = __builtin_bit_cast(bf16x8, pw);
#pragma unroll
            for (int dh = 0; dh < 2; ++dh) {
                const LAS unsigned char* vp = Vt + (32 * dh + rl) * VSTR + (kk0 + 32 * kt + 16 * s2 + 4 * h) * 2;
                const s16x4 lo = *(const LAS s16x4*)vp, hi = *(const LAS s16x4*)(vp + 16);
                const bf16x8 va = __builtin_shufflevector(lo, hi, 0, 1, 2, 3, 4, 5, 6, 7);
                o[dh] = MFMA32(va, xs, o[dh]);
            }
        }
    m_out = mx; l_out = l;
}
__device__ __forceinline__ void band_store(bf16* orow, const f32x16 (&o)[2], float inv, int h) {
#pragma unroll
    for (int dh = 0; dh < 2; ++dh)
#pragma unroll
        for (int g4 = 0; g4 < 4; ++g4) { v2u w; w.x = pkbf(o[dh][4 * g4 + 0] * inv, o[dh][4 * g4 + 1] * inv); w.y = pkbf(o[dh][4 * g4 + 2] * inv, o[dh][4 * g4 + 3] * inv);
            *(v2u*)(orow + 32 * dh + 8 * g4 + 4 * h) = w; }
}
__device__ __forceinline__ void band_store_lds(LAS unsigned char* ost, const f32x16 (&o)[2], float inv, int lane, bf16* Op, size_t row0, int rstride, int ldo) {
    const int rl = lane & 31, h = lane >> 5;
#pragma unroll
    for (int p = 0; p < 2; ++p) {
        if ((rl >> 4) == p) {
#pragma unroll
            for (int dh = 0; dh < 2; ++dh)
#pragma unroll
                for (int g4 = 0; g4 < 4; ++g4) { v2u w; w.x = pkbf(o[dh][4 * g4 + 0] * inv, o[dh][4 * g4 + 1] * inv); w.y = pkbf(o[dh][4 * g4 + 2] * inv, o[dh][4 * g4 + 3] * inv);
                    *(LAS v2u*)(ost + (rl & 15) * 144 + (32 * dh + 8 * g4 + 4 * h) * 2) = w; }
        }
        asm volatile("s_waitcnt lgkmcnt(0)" ::: "memory");
#pragma unroll
        for (int j = 0; j < 2; ++j) { const int idx = lane + 64 * j, row = idx >> 3, c8 = idx & 7; const v4u v = *(const LAS v4u*)(ost + row * 144 + c8 * 16);
            *(v4u*)(Op + (row0 + (size_t)(16 * p + row) * rstride) * ldo + c8 * 8) = v; }
        asm volatile("s_waitcnt lgkmcnt(0)" ::: "memory");
    }
}
template <int MODE> __device__ __forceinline__ void band_unit(LAS unsigned char* lds, const BandArgs& a, int sb, int lane, int wave) {
    constexpr int QB = (MODE == 0) ? 64 : 256, NK = QB + 128, VSTR = 2 * NK + 8, OST = NK * 144 + 64 * VSTR;
    LAS unsigned char* Kl = lds; LAS unsigned char* Vt = lds + NK * 144;
    const int rl = lane & 31, h = lane >> 5;
    const int iq = a.i0 + 32 * sb + rl; const size_t qrow = (size_t)(a.rowbase + iq * a.rstride);
    bf16x8 qf[4];
#pragma unroll
    for (int d0 = 0; d0 < 4; ++d0) qf[d0] = *(const bf16x8*)(a.Qp + qrow * a.ldq + 16 * d0 + 8 * h);
    f32x16 o[2]; float m, l;
    band_compute<NK, (MODE == 0) ? 127 : 128, MODE == 0>(Kl, Vt, 32 * sb, qf, 128, a.i0 - 128 + 32 * sb, a.slope2, a.sink2, lane, o, m, l);
    const float inv = 1.0f / l;
    band_store_lds(lds + OST + wave * 2304, o, inv, lane, a.Op, (size_t)(a.rowbase + (a.i0 + 32 * sb) * a.rstride), a.rstride, a.ldo);
    if (MODE == 1) { if (h == 0) a.lsep[qrow * a.ldl] = m + __builtin_amdgcn_logf(l); }
}
}
namespace fk {
__device__ __forceinline__ void sample_a_unit(Frame& F, int l, int b, int kvh) {
    constexpr int NK = 160, VSTR = 2 * NK + 8; const int lane = F.lane(), tid = F.wave * 64 + lane;
    LAS unsigned char* Kl = F.lds; LAS unsigned char* Vt = F.lds + NK * 144;
    const float* ck = F.cak + (((size_t)l * NBS + b) * 128) * 256 + kvh * 64; const float* cv = F.cav + (((size_t)l * NBS + b) * 128) * 256 + kvh * 64;
    float* ok = F.out + O6 + (((size_t)l * NBS + b) * 128) * 256 + kvh * 64; float* ov = F.out + O7 + (((size_t)l * NBS + b) * 128) * 256 + kvh * 64;
#pragma unroll
    for (int c0 = 0; c0 < 2048; c0 += NTHREADS) {
        const int c = c0 + tid, kk = c >> 4, ch = c & 15;
        const f32x4 kq = *(const f32x4*)(ck + (size_t)kk * 256 + ch * 4), vq = *(const f32x4*)(cv + (size_t)kk * 256 + ch * 4);
        if (kk >= 8) { *(f32x4*)(ok + (size_t)(kk - 8) * 256 + ch * 4) = kq; *(f32x4*)(ov + (size_t)(kk - 8) * 256 + ch * 4) = vq; }
        v2u kw; kw.x = pkbf(kq.x, kq.y); kw.y = pkbf(kq.z, kq.w);
        *(LAS v2u*)(Kl + kk * 144 + ch * 8) = kw;
        const unsigned v01 = pkbf(vq.x, vq.y), v23 = pkbf(vq.z, vq.w);
        LAS unsigned char* vt = Vt + (ch * 4) * VSTR + kk * 2;
        *(LAS unsigned short*)(vt) = (unsigned short)(v01 & 0xffffu); *(LAS unsigned short*)(vt + VSTR) = (unsigned short)(v01 >> 16);
        *(LAS unsigned short*)(vt + 2 * VSTR) = (unsigned short)(v23 & 0xffffu); *(LAS unsigned short*)(vt + 3 * VSTR) = (unsigned short)(v23 >> 16);
    }
    if (tid < 256) {
        const int kk = 128 + (tid >> 3), ch = tid & 7; v4u kq = {0u, 0u, 0u, 0u}, vq = {0u, 0u, 0u, 0u};
        if (kk < 136) { const size_t row = (size_t)(MP + b * 8 + (kk - 128)); kq = *(const v4u*)(F.KA + row * 256 + kvh * 64 + ch * 8); vq = *(const v4u*)(F.VA + row * 256 + kvh * 64 + ch * 8); }
        *(LAS v4u*)(Kl + kk * 144 + ch * 16) = kq;
        LAS unsigned char* vt = Vt + (ch * 8) * VSTR + kk * 2;
        *(LAS unsigned short*)(vt) = (unsigned short)(vq.x & 0xffffu); *(LAS unsigned short*)(vt + 1 * VSTR) = (unsigned short)(vq.x >> 16);
        *(LAS unsigned short*)(vt + 2 * VSTR) = (unsigned short)(vq.y & 0xffffu); *(LAS unsigned short*)(vt + 3 * VSTR) = (unsigned short)(vq.y >> 16);
        *(LAS unsigned short*)(vt + 4 * VSTR) = (unsigned short)(vq.z & 0xffffu); *(LAS unsigned short*)(vt + 5 * VSTR) = (unsigned short)(vq.z >> 16);
        *(LAS unsigned short*)(vt + 6 * VSTR) = (unsigned short)(vq.w & 0xffffu); *(LAS unsigned short*)(vt + 7 * VSTR) = (unsigned short)(vq.w >> 16);
    }
    __syncthreads();
    if (F.wave == 0) {
        const int rl = lane & 31, h = lane >> 5, g = rl >> 3, s = rl & 7, head = kvh * 4 + g;
        const size_t qrow = (size_t)(MP + b * 8 + s);
        bf16x8 qf[4];
#pragma unroll
        for (int d0 = 0; d0 < 4; ++d0) qf[d0] = *(const bf16x8*)(F.Q + qrow * 1024 + head * 64 + 16 * d0 + 8 * h);
        const float slope2 = slope_of(head, 16) * LOG2E, sink2 = F.sinks_a[l * 16 + head] * LOG2E;
        f32x16 o[2]; float m, lsum;
        band_compute<NK, 127, true>(Kl, Vt, 0, qf, 128 + s - rl, 0, slope2, sink2, lane, o, m, lsum);
        band_store(F.ATT + qrow * 1024 + head * 64, o, 1.0f / lsum, h);
    }
    __syncthreads();
}
struct SbTile { f32x4 k[8]; float v[32]; };
__device__ __forceinline__ int sb_idx(int t, int ioff) { return (t < 24) ? (16 * (4 * t + (ioff >> 3)) + (ioff & 7)) : (32 * t + ioff + 768); }
__device__ __forceinline__ const float* sb_rowptr(const float* cache, const float* outc, int b, int idx, int col) {
    const int ic = idx > 2055 ? 2055 : idx;
    return (ic < 2048) ? cache + ((size_t)b * 2048 + ic) * 512 + col : outc + ((size_t)b * 2048 + (ic - 8)) * 512 + col;
}
__device__ __forceinline__ void sb_load(SbTile& T, const float* ck, const float* cv, const float* ok, const float* ov, int b, int slot, int t, int rl, int h) {
    const float* kp = sb_rowptr(ck, ok, b, sb_idx(t, rl), slot * 64 + 8 * h);
#pragma unroll
    for (int d0 = 0; d0 < 4; ++d0) { T.k[2 * d0] = *(const f32x4*)(kp + 16 * d0); T.k[2 * d0 + 1] = *(const f32x4*)(kp + 16 * d0 + 4); }
#pragma unroll
    for (int s2 = 0; s2 < 2; ++s2)
#pragma unroll
        for (int jj = 0; jj < 2; ++jj)
#pragma unroll
            for (int e = 0; e < 4; ++e) { const float* vp = sb_rowptr(cv, ov, b, sb_idx(t, 16 * s2 + 8 * jj + 4 * h + e), slot * 64 + rl);
                T.v[(s2 * 2 + 0) * 8 + jj * 4 + e] = vp[0]; T.v[(s2 * 2 + 1) * 8 + jj * 4 + e] = vp[32]; }
}
__device__ __forceinline__ void sb_compute(const SbTile& T, int t, const bf16x8 (&qf)[4], int tq, int rmask, int wmax, float slope2, bool colok, int h, f32x16 (&o)[2], float& m, float& l) {
    f32x16 S = {0.f, 0.f, 0.f, 0.f, 0.f, 0.f, 0.f, 0.f, 0.f, 0.f, 0.f, 0.f, 0.f, 0.f, 0.f, 0.f};
#pragma unroll
    for (int d0 = 0; d0 < 4; ++d0) { const f32x4 a = T.k[2 * d0], c = T.k[2 * d0 + 1]; v4u w; w.x = pkbf(a.x, a.y); w.y = pkbf(a.z, a.w); w.z = pkbf(c.x, c.y); w.w = pkbf(c.z, c.w);
        S = MFMA32(__builtin_bit_cast(bf16x8, w), qf[d0], S); }
    float tm = -INFINITY;
#pragma unroll
    for (int rg = 0; rg < 16; ++rg) { const int idx = sb_idx(t, 8 * (rg >> 2) + 4 * h + (rg & 3)); const int dist = tq - idx;
        const bool ok = colok && (dist >= 0) && ((dist & rmask) == 0) && (dist <= wmax);
        const float sc = ok ? (S[rg] - slope2 * (float)dist) : -INFINITY; S[rg] = sc; tm = fmaxf(tm, sc); }
    tm = fmaxf(tm, __shfl_xor(tm, 32));
    const float mn = fmaxf(m, tm), alpha = __builtin_amdgcn_exp2f(m - mn); m = mn;
    float ls = 0.f;
#pragma unroll
    for (int rg = 0; rg < 16; ++rg) { const float p = __builtin_amdgcn_exp2f(S[rg] - mn); S[rg] = p; ls += p; }
    l = l * alpha + ls;
#pragma unroll
    for (int dh = 0; dh < 2; ++dh)
#pragma unroll
        for (int rg = 0; rg < 16; ++rg) o[dh][rg] *= alpha;
#pragma unroll
    for (int s2 = 0; s2 < 2; ++s2) {
        v4u pw; pw.x = pkbf(S[8 * s2 + 0], S[8 * s2 + 1]); pw.y = pkbf(S[8 * s2 + 2], S[8 * s2 + 3]); pw.z = pkbf(S[8 * s2 + 4], S[8 * s2 + 5]); pw.w = pkbf(S[8 * s2 + 6], S[8 * s2 + 7]);
        const bf16x8 xs = __builtin_bit_cast(bf16x8, pw);
#pragma unroll
        for (int dh = 0; dh < 2; ++dh) { const float* vv = &T.v[(s2 * 2 + dh) * 8];
            v4u vw; vw.x = pkbf(vv[0], vv[1]); vw.y = pkbf(vv[2], vv[3]); vw.z = pkbf(vv[4], vv[5]); vw.w = pkbf(vv[6], vv[7]);
            o[dh] = MFMA32(__builtin_bit_cast(bf16x8, vw), xs, o[dh]); }
    }
}
#ifndef SBFORCE0
#define SBFORCE0 0
#endif
struct SbPacked { v4u d[4]; v2u sc; };
__device__ __forceinline__ unsigned q8_pack4(float a, float b, float c, float d, float s) {
    unsigned u = 0u;
    u = __builtin_amdgcn_cvt_pk_u8_f32(__builtin_rintf(__builtin_fmaf(a, s, 128.0f)), 0, u); u = __builtin_amdgcn_cvt_pk_u8_f32(__builtin_rintf(__builtin_fmaf(b, s, 128.0f)), 1, u);
    u = __builtin_amdgcn_cvt_pk_u8_f32(__builtin_rintf(__builtin_fmaf(c, s, 128.0f)), 2, u); u = __builtin_amdgcn_cvt_pk_u8_f32(__builtin_rintf(__builtin_fmaf(d, s, 128.0f)), 3, u);
    return u;
}
__device__ __forceinline__ void q8_unpack4(unsigned w, float s, float& a, float& b, float& c, float& d) {
    a = ((float)(w & 255u) - 128.0f) * s; b = ((float)((w >> 8) & 255u) - 128.0f) * s; c = ((float)((w >> 16) & 255u) - 128.0f) * s; d = ((float)(w >> 24) - 128.0f) * s;
}
__device__ __forceinline__ void sb_encode_store(const SbTile& T, unsigned char* q8, unsigned char* q8s, size_t idx) {
    float km = 0.f, vm = 0.f;
#pragma unroll
    for (int i = 0; i < 8; ++i) km = fmaxf(fmaxf(km, fmaxf(fabsf(T.k[i][0]), fabsf(T.k[i][1]))), fmaxf(fabsf(T.k[i][2]), fabsf(T.k[i][3])));
#pragma unroll
    for (int i = 0; i < 32; ++i) vm = fmaxf(vm, fabsf(T.v[i]));
    const float ks = km > 0.f ? 127.0f / km : 0.f, vs = vm > 0.f ? 127.0f / vm : 0.f;
    v4u* dst = (v4u*)(q8 + idx * 64);
    { v4u d; d.x = q8_pack4(T.k[0][0], T.k[0][1], T.k[0][2], T.k[0][3], ks); d.y = q8_pack4(T.k[1][0], T.k[1][1], T.k[1][2], T.k[1][3], ks); d.z = q8_pack4(T.k[2][0], T.k[2][1], T.k[2][2], T.k[2][3], ks); d.w = q8_pack4(T.k[3][0], T.k[3][1], T.k[3][2], T.k[3][3], ks); dst[0] = d; }
    asm volatile("" ::: "memory");
    { v4u d; d.x = q8_pack4(T.k[4][0], T.k[4][1], T.k[4][2], T.k[4][3], ks); d.y = q8_pack4(T.k[5][0], T.k[5][1], T.k[5][2], T.k[5][3], ks); d.z = q8_pack4(T.k[6][0], T.k[6][1], T.k[6][2], T.k[6][3], ks); d.w = q8_pack4(T.k[7][0], T.k[7][1], T.k[7][2], T.k[7][3], ks); dst[1] = d; }
    asm volatile("" ::: "memory");
    { v4u d; d.x = q8_pack4(T.v[0], T.v[1], T.v[2], T.v[3], vs); d.y = q8_pack4(T.v[4], T.v[5], T.v[6], T.v[7], vs); d.z = q8_pack4(T.v[8], T.v[9], T.v[10], T.v[11], vs); d.w = q8_pack4(T.v[12], T.v[13], T.v[14], T.v[15], vs); dst[2] = d; }
    asm volatile("" ::: "memory");
    { v4u d; d.x = q8_pack4(T.v[16], T.v[17], T.v[18], T.v[19], vs); d.y = q8_pack4(T.v[20], T.v[21], T.v[22], T.v[23], vs); d.z = q8_pack4(T.v[24], T.v[25], T.v[26], T.v[27], vs); d.w = q8_pack4(T.v[28], T.v[29], T.v[30], T.v[31], vs); dst[3] = d; }
    v2u sc; sc.x = __float_as_uint(km * (1.0f / 127.0f)); sc.y = __float_as_uint(vm * (1.0f / 127.0f));
    *(v2u*)(q8s + idx * 8) = sc;
}
__device__ __forceinline__ void sb_load_packed(SbPacked& P, const unsigned char* q8, const unsigned char* q8s, size_t idx) {
    const v4u* src = (const v4u*)(q8 + idx * 64);
#pragma unroll
    for (int i = 0; i < 4; ++i) P.d[i] = src[i];
    P.sc = *(const v2u*)(q8s + idx * 8);
}
__device__ __forceinline__ void sb_decode(SbTile& T, const SbPacked& P) {
    const float ks = __uint_as_float(P.sc.x), vs = __uint_as_float(P.sc.y);
#pragma unroll
    for (int i = 0; i < 8; ++i) { float a, b, c, d; q8_unpack4(P.d[i >> 2][i & 3], ks, a, b, c, d); T.k[i] = (f32x4){a, b, c, d}; }
#pragma unroll
    for (int i = 0; i < 8; ++i) { float a, b, c, d; q8_unpack4(P.d[2 + (i >> 2)][i & 3], vs, a, b, c, d); T.v[4 * i] = a; T.v[4 * i + 1] = b; T.v[4 * i + 2] = c; T.v[4 * i + 3] = d; }
}
struct SbBf { v4u k[4], v[4]; };
__device__ __forceinline__ void sb_to_bf(const SbTile& T, SbBf& B, float& km, float& vm) {
    km = 0.f; vm = 0.f;
#pragma unroll
    for (int d0 = 0; d0 < 4; ++d0) { const f32x4 a = T.k[2 * d0], c = T.k[2 * d0 + 1]; v4u w; w.x = pkbf(a.x, a.y); w.y = pkbf(a.z, a.w); w.z = pkbf(c.x, c.y); w.w = pkbf(c.z, c.w); B.k[d0] = w;
        km = fmaxf(km, fmaxf(fmaxf(fmaxf(fabsf(a.x), fabsf(a.y)), fmaxf(fabsf(a.z), fabsf(a.w))), fmaxf(fmaxf(fabsf(c.x), fabsf(c.y)), fmaxf(fabsf(c.z), fabsf(c.w))))); }
#pragma unroll
    for (int i = 0; i < 4; ++i) { const float* vv = &T.v[i * 8]; v4u w; w.x = pkbf(vv[0], vv[1]); w.y = pkbf(vv[2], vv[3]); w.z = pkbf(vv[4], vv[5]); w.w = pkbf(vv[6], vv[7]); B.v[i] = w;
        vm = fmaxf(vm, fmaxf(fmaxf(fmaxf(fabsf(vv[0]), fabsf(vv[1])), fmaxf(fabsf(vv[2]), fabsf(vv[3]))), fmaxf(fmaxf(fabsf(vv[4]), fabsf(vv[5])), fmaxf(fabsf(vv[6]), fabsf(vv[7]))))); }
}
__device__ __forceinline__ unsigned q8_pack_pair(unsigned w0, unsigned w1, float s) {
    return q8_pack4(bflo(w0), bfhi(w0), bflo(w1), bfhi(w1), s);
}
__device__ __forceinline__ void sb_encode_store_bf(const SbBf& B, float km, float vm, unsigned char* q8, unsigned char* q8s, size_t idx) {
    const float ks = km > 0.f ? 127.0f / km : 0.f, vs = vm > 0.f ? 127.0f / vm : 0.f;
    v4u* dst = (v4u*)(q8 + idx * 64);
    { v4u d; d.x = q8_pack_pair(B.k[0].x, B.k[0].y, ks); d.y = q8_pack_pair(B.k[0].z, B.k[0].w, ks); d.z = q8_pack_pair(B.k[1].x, B.k[1].y, ks); d.w = q8_pack_pair(B.k[1].z, B.k[1].w, ks); dst[0] = d; }
    { v4u d; d.x = q8_pack_pair(B.k[2].x, B.k[2].y, ks); d.y = q8_pack_pair(B.k[2].z, B.k[2].w, ks); d.z = q8_pack_pair(B.k[3].x, B.k[3].y, ks); d.w = q8_pack_pair(B.k[3].z, B.k[3].w, ks); dst[1] = d; }
    { v4u d; d.x = q8_pack_pair(B.v[0].x, B.v[0].y, vs); d.y = q8_pack_pair(B.v[0].z, B.v[0].w, vs); d.z = q8_pack_pair(B.v[1].x, B.v[1].y, vs); d.w = q8_pack_pair(B.v[1].z, B.v[1].w, vs); dst[2] = d; }
    { v4u d; d.x = q8_pack_pair(B.v[2].x, B.v[2].y, vs); d.y = q8_pack_pair(B.v[2].z, B.v[2].w, vs); d.z = q8_pack_pair(B.v[3].x, B.v[3].y, vs); d.w = q8_pack_pair(B.v[3].z, B.v[3].w, vs); dst[3] = d; }
    v2u sc; sc.x = __float_as_uint(km * (1.0f / 127.0f)); sc.y = __float_as_uint(vm * (1.0f / 127.0f));
    *(v2u*)(q8s + idx * 8) = sc;
}
__device__ __forceinline__ void sb_compute_bf(const SbBf& B, int t, const bf16x8 (&qf)[4], int tq, int rmask, int wmax, float slope2, bool colok, int h, f32x16 (&o)[2], float& m, float& l) {
    f32x16 S = {0.f, 0.f, 0.f, 0.f, 0.f, 0.f, 0.f, 0.f, 0.f, 0.f, 0.f, 0.f, 0.f, 0.f, 0.f, 0.f};
#pragma unroll
    for (int d0 = 0; d0 < 4; ++d0) S = MFMA32(__builtin_bit_cast(bf16x8, B.k[d0]), qf[d0], S);
    float tm = -INFINITY;
#pragma unroll
    for (int rg = 0; rg < 16; ++rg) { const int idx = sb_idx(t, 8 * (rg >> 2) + 4 * h + (rg & 3)); const int dist = tq - idx;
        const bool ok = colok && (dist >= 0) && ((dist & rmask) == 0) && (dist <= wmax);
        const float sc = ok ? (S[rg] - slope2 * (float)dist) : -INFINITY; S[rg] = sc; tm = fmaxf(tm, sc); }
    tm = fmaxf(tm, __shfl_xor(tm, 32));
    const float mn = fmaxf(m, tm), alpha = __builtin_amdgcn_exp2f(m - mn); m = mn;
    float ls = 0.f;
#pragma unroll
    for (int rg = 0; rg < 16; ++rg) { const float p = __builtin_amdgcn_exp2f(S[rg] - mn); S[rg] = p; ls += p; }
    l = l * alpha + ls;
#pragma unroll
    for (int dh = 0; dh < 2; ++dh)
#pragma unroll
        for (int rg = 0; rg < 16; ++rg) o[dh][rg] *= alpha;
#pragma unroll
    for (int s2 = 0; s2 < 2; ++s2) {
        v4u pw; pw.x = pkbf(S[8 * s2 + 0], S[8 * s2 + 1]); pw.y = pkbf(S[8 * s2 + 2], S[8 * s2 + 3]); pw.z = pkbf(S[8 * s2 + 4], S[8 * s2 + 5]); pw.w = pkbf(S[8 * s2 + 6], S[8 * s2 + 7]);
        const bf16x8 xs = __builtin_bit_cast(bf16x8, pw);
#pragma unroll
        for (int dh = 0; dh < 2; ++dh) o[dh] = MFMA32(__builtin_bit_cast(bf16x8, B.v[s2 * 2 + dh]), xs, o[dh]);
    }
}
template <int MODE>
__device__ __forceinline__ void sample_b_task(Frame& F, int b, int slot) {
    const int lane = F.lane(), rl = lane & 31, h = lane >> 5, g = rl >> 3, s = rl & 7, gq = g > 2 ? 2 : g;
    const bool colok = g < 3; const int r = (gq == 0) ? 1 : (gq == 1) ? 4 : 16; const int rmask = r - 1, wmax = 128 * r, tq = 2048 + s;
    const float slope2 = slope_of(gq * 8 + slot, 24) * LOG2E;
    const size_t qrow = (size_t)(MP + b * 8 + s);
    bf16x8 qf[4];
#pragma unroll
    for (int d0 = 0; d0 < 4; ++d0) qf[d0] = *(const bf16x8*)(F.Q + qrow * 1536 + gq * 512 + slot * 64 + 16 * d0 + 8 * h);
    const float* ok = F.out + O8; const float* ov = F.out + O9;
    f32x16 o[2]; o[0] = (f32x16){0.f, 0.f, 0.f, 0.f, 0.f, 0.f, 0.f, 0.f, 0.f, 0.f, 0.f, 0.f, 0.f, 0.f, 0.f, 0.f}; o[1] = o[0];
    float m = -1e30f, l = 0.f;
    unsigned char* q8 = (unsigned char*)F.CBK; unsigned char* q8s = (unsigned char*)F.CBV; const size_t tbase = ((size_t)(b * 8 + slot) * 41) * 64 + lane;
    if (MODE == 0) {
        SbTile TB; SbBf B; float km, vm;
        sb_load(TB, F.cbk, F.cbv, ok, ov, b, slot, 0, rl, h);
        for (int t = 0; t < 41; ++t) {
            sb_to_bf(TB, B, km, vm);
            if (t + 1 < 41) sb_load(TB, F.cbk, F.cbv, ok, ov, b, slot, t + 1, rl, h);
            sb_encode_store_bf(B, km, vm, q8, q8s, tbase + (size_t)t * 64);
            sb_compute_bf(B, t, qf, tq, rmask, wmax, slope2, colok, h, o, m, l);
        }
    } else {
        SbPacked P0, P1, P2, P3; SbTile T;
        sb_load_packed(P0, q8, q8s, tbase); sb_load_packed(P1, q8, q8s, tbase + 64); sb_load_packed(P2, q8, q8s, tbase + 128); sb_load_packed(P3, q8, q8s, tbase + 192);
        for (int t = 0; t < 41; t += 4) {
            sb_decode(T, P0); if (t + 4 < 41) sb_load_packed(P0, q8, q8s, tbase + (size_t)(t + 4) * 64); sb_compute(T, t, qf, tq, rmask, wmax, slope2, colok, h, o, m, l);
            if (t + 1 < 41) { sb_decode(T, P1); if (t + 5 < 41) sb_load_packed(P1, q8, q8s, tbase + (size_t)(t + 5) * 64); sb_compute(T, t + 1, qf, tq, rmask, wmax, slope2, colok, h, o, m, l); }
            if (t + 2 < 41) { sb_decode(T, P2); if (t + 6 < 41) sb_load_packed(P2, q8, q8s, tbase + (size_t)(t + 6) * 64); sb_compute(T, t + 2, qf, tq, rmask, wmax, slope2, colok, h, o, m, l); }
            if (t + 3 < 41) { sb_decode(T, P3); if (t + 7 < 41) sb_load_packed(P3, q8, q8s, tbase + (size_t)(t + 7) * 64); sb_compute(T, t + 3, qf, tq, rmask, wmax, slope2, colok, h, o, m, l); }
        }
    }
    l += __shfl_xor(l, 32);
    const float lse2 = colok ? (m + __builtin_amdgcn_logf(l)) : -1e30f, inv = 1.0f / l;
    const float l0 = __shfl(lse2, s + 32 * h), l1 = __shfl(lse2, 8 + s + 32 * h), l2 = __shfl(lse2, 16 + s + 32 * h);
    const float mx = fmaxf(fmaxf(l0, l1), l2); const float w0 = __builtin_amdgcn_exp2f(l0 - mx), w1 = __builtin_amdgcn_exp2f(l1 - mx), w2 = __builtin_amdgcn_exp2f(l2 - mx); const float iw = 1.0f / (w0 + w1 + w2);
    f32x16 c[2];
#pragma unroll
    for (int dh = 0; dh < 2; ++dh)
#pragma unroll
        for (int rg = 0; rg < 16; ++rg) { const float v = o[dh][rg] * inv; const float a0 = __shfl(v, s + 32 * h), a1 = __shfl(v, 8 + s + 32 * h), a2 = __shfl(v, 16 + s + 32 * h); c[dh][rg] = (w0 * a0 + w1 * a1 + w2 * a2) * iw; }
    if (rl < 8) band_store(F.ATT + qrow * 512 + slot * 64, c, 1.0f, h);
}
template <int UNR> __device__ __forceinline__ void combine_rows(Frame& F, size_t first, size_t nth) {
    const size_t total = (size_t)MP * 64;
    for (size_t it0 = first; it0 < total; it0 += nth * UNR) {
        float l0[UNR], l1[UNR], l2[UNR]; v4u a[UNR], b[UNR], c[UNR];
#pragma unroll
        for (int q = 0; q < UNR; ++q) { const size_t it = it0 + nth * q; const size_t row = it >> 6; const int c8 = (int)(it & 63), slot = c8 >> 3;
            l0[q] = F.LSE[(size_t)0 * M * 8 + row * 8 + slot]; l1[q] = F.LSE[(size_t)1 * M * 8 + row * 8 + slot]; l2[q] = F.LSE[(size_t)2 * M * 8 + row * 8 + slot];
            a[q] = *(const v4u*)(F.OG + ((size_t)0 * M + row) * 512 + c8 * 8); b[q] = *(const v4u*)(F.OG + ((size_t)1 * M + row) * 512 + c8 * 8); c[q] = *(const v4u*)(F.OG + ((size_t)2 * M + row) * 512 + c8 * 8); }
#pragma unroll
        for (int q = 0; q < UNR; ++q) { const size_t it = it0 + nth * q; const size_t row = it >> 6; const int c8 = (int)(it & 63);
            const float mx = fmaxf(fmaxf(l0[q], l1[q]), l2[q]); float w0 = __builtin_amdgcn_exp2f(l0[q] - mx), w1 = __builtin_amdgcn_exp2f(l1[q] - mx), w2 = __builtin_amdgcn_exp2f(l2[q] - mx);
            const float id = 1.0f / (w0 + w1 + w2); w0 *= id; w1 *= id; w2 *= id;
            v4u o;
            o.x = pkbf(w0 * bflo(a[q].x) + w1 * bflo(b[q].x) + w2 * bflo(c[q].x), w0 * bfhi(a[q].x) + w1 * bfhi(b[q].x) + w2 * bfhi(c[q].x));
            o.y = pkbf(w0 * bflo(a[q].y) + w1 * bflo(b[q].y) + w2 * bflo(c[q].y), w0 * bfhi(a[q].y) + w1 * bfhi(b[q].y) + w2 * bfhi(c[q].y));
            o.z = pkbf(w0 * bflo(a[q].z) + w1 * bflo(b[q].z) + w2 * bflo(c[q].z), w0 * bfhi(a[q].z) + w1 * bfhi(b[q].z) + w2 * bfhi(c[q].z));
            o.w = pkbf(w0 * bflo(a[q].w) + w1 * bflo(b[q].w) + w2 * bflo(c[q].w), w0 * bfhi(a[q].w) + w1 * bfhi(b[q].w) + w2 * bfhi(c[q].w));
            *(v4u*)(F.ATT + row * 512 + c8 * 8) = o; }
    }
}
__device__ __forceinline__ void combine_b(Frame& F) { combine_rows<1>(F, (size_t)F.vcu * NTHREADS + F.tid(), (size_t)F.G * NTHREADS); }
__device__ __forceinline__ void final_norm(Frame& F) {
    const int lane = F.lane(); const int gw = F.vcu * NWAVES + F.wave, NGW = F.G * NWAVES;
    const f32x4* gg = (const f32x4*)F.g_final + lane; f32x4 g[4];
#pragma unroll
    for (int j = 0; j < 4; ++j) g[j] = gg[64 * j];
    for (int m0 = gw * 2; m0 < M; m0 += NGW * 2) {
        f32x4 v[2][4]; float rs[2];
#pragma unroll
        for (int q = 0; q < 2; ++q) {
#ifdef RESBF16
            const v2u* xr = (const v2u*)(F.XB + (size_t)(m0 + q) * D) + lane;
#pragma unroll
            for (int j = 0; j < 4; ++j) { const v2u w = xr[64 * j]; v[q][j] = (f32x4){bflo(w.x), bfhi(w.x), bflo(w.y), bfhi(w.y)}; }
#else
            const f32x4* xr = (const f32x4*)(F.X + (size_t)(m0 + q) * D) + lane;
#pragma unroll
            for (int j = 0; j < 4; ++j) v[q][j] = xr[64 * j];
#endif
            rs[q] = rstd_row(F.SS, m0 + q); }
#pragma unroll
        for (int q = 0; q < 2; ++q) { f32x4* yo = (f32x4*)(F.out + (size_t)(m0 + q) * D) + lane;
#pragma unroll
            for (int j = 0; j < 4; ++j) { f32x4 o; o.x = v[q][j].x * rs[q] * g[j].x; o.y = v[q][j].y * rs[q] * g[j].y; o.z = v[q][j].z * rs[q] * g[j].z; o.w = v[q][j].w * rs[q] * g[j].w; yo[64 * j] = o; } }
    }
}
__device__ __forceinline__ void attn_a_phase(Frame& F, int l) {
#ifndef REP_ATTA
#define REP_ATTA 1
#endif
#ifndef REP_ATTBP
#define REP_ATTBP 1
#endif
#ifndef REP_ATTBS
#define REP_ATTBS 1
#endif
    for (int rep = 0; rep < REP_ATTA; ++rep) {
        BandRegs<0> R; BandArgs a, an;
        auto mk = [&](int u, BandArgs& x) { const int qblk = u & 127, kvh = (u >> 7) & 3, b = u >> 9; const int g = F.wave >> 1, head = kvh * 4 + g;
            x.Qp = F.Q + head * 64; x.ldq = 1024; x.Kp = F.KA + kvh * 64; x.Vp = F.VA + kvh * 64; x.ldkv = 256; x.rowbase = b * TP; x.rstride = 1; x.i0 = qblk * 64;
            x.Op = F.ATT + head * 64; x.ldo = 1024; x.lsep = nullptr; x.ldl = 0; x.slope2 = slope_of(head, 16) * LOG2E; x.sink2 = F.sinks_a[l * 16 + head] * LOG2E; };
        int u = F.vcu;
        if (u < NBP * 4 * 128) { const int tid0 = F.tid(); mk(u, a); band_fetch<0>(R, a, tid0); }
        for (; u < NBP * 4 * 128; u += F.G) {
            const int lane = F.lane(), tid = F.wave * 64 + lane;
            band_put<0>(F.lds, R, tid);
            __syncthreads();
            const bool more = (u + F.G < NBP * 4 * 128);
            if (more) { mk(u + F.G, an); band_fetch<0>(R, an, tid); }
            band_unit<0>(F.lds, a, F.wave & 1, lane, F.wave);
            __syncthreads();
            if (more) a = an;
        }
    }
    for (int rep = 0; rep < REP_ATTA; ++rep)
    for (int u = F.vcu; u < NBS * 4; u += F.G) sample_a_unit(F, l, u >> 2, u & 3);
}
__device__ __forceinline__ void attn_b_phase(Frame& F, int half) {
    for (int rep = 0; rep < REP_ATTBP; ++rep) {
        BandRegs<1> R; BandArgs a, an;
        auto mk = [&](int u, BandArgs& x) { const int grp = u >> 9, v = u & 511; const int r = (grp == 0) ? 1 : (grp == 1) ? 4 : 16; const int L = TP / r, nqb = L / 256;
            const int slot = v & 7, w = v >> 3; const int qblk = w % nqb, br = w / nqb, res = br % r, b = br / r;
            x.Qp = F.Q + grp * 512 + slot * 64; x.ldq = 1536; x.Kp = F.KB + slot * 64; x.Vp = F.VB + slot * 64; x.ldkv = 512; x.rowbase = b * TP + res; x.rstride = r; x.i0 = qblk * 256;
            x.Op = F.OG + (size_t)grp * M * 512 + slot * 64; x.ldo = 512; x.lsep = F.LSE + (size_t)grp * M * 8 + slot; x.ldl = 8; x.slope2 = slope_of(grp * 8 + slot, 24) * (float)r * LOG2E; x.sink2 = 0.f; };
        int u = F.vcu;
        if (u < 3 * 512) { const int tid0 = F.tid(); mk(u, a); band_fetch<1>(R, a, tid0); }
        for (; u < 3 * 512; u += F.G) {
            const int lane = F.lane(), tid = F.wave * 64 + lane;
            band_put<1>(F.lds, R, tid);
            __syncthreads();
            const bool more = (u + F.G < 3 * 512);
            if (more) { mk(u + F.G, an); band_fetch<1>(R, an, tid); }
            band_unit<1>(F.lds, a, F.wave, lane, F.wave);
            __syncthreads();
            if (more) a = an;
        }
    }
    if (F.fuse) { asm volatile("s_waitcnt vmcnt(0)" ::: "memory"); __syncthreads(); }
    if (F.wave < 4) {
    for (int rep = 0; rep < REP_ATTBS; ++rep)
    for (int t = F.vcu * 4 + F.wave; t < NBS * 8; t += F.G * 4) { if (half == 0 || SBFORCE0) sample_b_task<0>(F, t >> 3, t & 7); else sample_b_task<1>(F, t >> 3, t & 7); }
    } else if (F.fuse) {
        const int lane = F.lane(); const unsigned want = (unsigned)half + 1u;
        if (F.wave == 4 && lane == 0) { XcdBarrier b2; b2.bar = F.ctl + CW_BAR2; b2.x = xb_xcc_id(); b2.st = F.MISC + 8; xcd_barrier_thread(b2); F.MISC[12] = want; }
        while (F.MISC[12] != want) __builtin_amdgcn_s_sleep(2);
        combine_rows<4>(F, (size_t)F.vcu * 256 + (size_t)((F.wave - 4) * 64 + lane), (size_t)F.G * 256);
    }
}
}
namespace fk {
typedef float f32x4m __attribute__((ext_vector_type(4)));
#define MFMA16(a, b, c) __builtin_amdgcn_mfma_f32_16x16x32_bf16((a), (b), (c), 0, 0, 0)
constexpr int MINI_KC = 256, MINI_RS = 528;
constexpr int MINI_BUF = 2 * 64 * MINI_RS;
struct MiniRegs { v4u a[4], b[4]; };
__device__ __forceinline__ void mini_fetch(MiniRegs& R, const bf16* A, const bf16* Bt, int K, int row0, int col0, int kc, int tid) {
#pragma unroll
    for (int it = 0; it < 4; ++it) { const int idx = it * NTHREADS + tid, r = idx >> 5, ch = idx & 31;
        R.a[it] = *(const v4u*)(A + (size_t)(row0 + r) * K + kc + ch * 8); R.b[it] = *(const v4u*)(Bt + (size_t)(col0 + r) * K + kc + ch * 8); }
}
__device__ __forceinline__ void mini_put(LAS unsigned char* lds, const MiniRegs& R, int tid) {
#pragma unroll
    for (int it = 0; it < 4; ++it) { const int idx = it * NTHREADS + tid, r = idx >> 5, ch = idx & 31;
        *(LAS v4u*)(lds + r * MINI_RS + ch * 16) = R.a[it]; *(LAS v4u*)(lds + 64 * MINI_RS + r * MINI_RS + ch * 16) = R.b[it]; }
}
__device__ __forceinline__ void mini_gemm(Frame& F, const bf16* A, const bf16* Bt, int K, float* Xo, bf16* XBo, float* SSo) {
    const int lane = F.lane(), tid = F.wave * 64 + lane; const int tile = F.vcu; if (tile >= 256) return;
    const int xq = tile >> 5, jq = tile & 31;
    const int tr = 4 * (xq >> 1) + (jq >> 3), tc = 8 * (xq & 1) + (jq & 7); const int row0 = MP + 64 * tr, col0 = 64 * tc;
    const int nch = K / MINI_KC;
    const int lr = lane & 15, lq = lane >> 4;
    f32x4m acc[4][4];
#pragma unroll
    for (int i = 0; i < 4; ++i)
#pragma unroll
        for (int j = 0; j < 4; ++j) acc[i][j] = (f32x4m){0.f, 0.f, 0.f, 0.f};
    MiniRegs R0, R1;
    mini_fetch(R0, A, Bt, K, row0, col0, 0, tid);
    if (nch > 1) mini_fetch(R1, A, Bt, K, row0, col0, MINI_KC, tid);
    for (int c = 0; c < nch; c += 2) {
        mini_put(F.lds, R0, tid);
        __syncthreads();
        if (c + 2 < nch) mini_fetch(R0, A, Bt, K, row0, col0, (c + 2) * MINI_KC, tid);
        { bf16x8 af[4], bf[4];
#pragma unroll
          for (int i = 0; i < 4; ++i) { af[i] = *(const LAS bf16x8*)(F.lds + (16 * i + lr) * MINI_RS + 64 * F.wave + 16 * lq); bf[i] = *(const LAS bf16x8*)(F.lds + 64 * MINI_RS + (16 * i + lr) * MINI_RS + 64 * F.wave + 16 * lq); }
#pragma unroll
          for (int i = 0; i < 4; ++i)
#pragma unroll
              for (int j = 0; j < 4; ++j) acc[i][j] = MFMA16(af[i], bf[j], acc[i][j]); }
        __syncthreads();
        if (c + 1 < nch) {
            mini_put(F.lds, R1, tid);
            __syncthreads();
            if (c + 3 < nch) mini_fetch(R1, A, Bt, K, row0, col0, (c + 3) * MINI_KC, tid);
            { bf16x8 af[4], bf[4];
#pragma unroll
              for (int i = 0; i < 4; ++i) { af[i] = *(const LAS bf16x8*)(F.lds + (16 * i + lr) * MINI_RS + 64 * F.wave + 16 * lq); bf[i] = *(const LAS bf16x8*)(F.lds + 64 * MINI_RS + (16 * i + lr) * MINI_RS + 64 * F.wave + 16 * lq); }
#pragma unroll
              for (int i = 0; i < 4; ++i)
#pragma unroll
                  for (int j = 0; j < 4; ++j) acc[i][j] = MFMA16(af[i], bf[j], acc[i][j]); }
            __syncthreads();
        }
    }
    LAS float* part = (LAS float*)(F.lds) + F.wave * 4096;
#pragma unroll
    for (int i = 0; i < 4; ++i)
#pragma unroll
        for (int j = 0; j < 4; ++j)
#pragma unroll
            for (int rg = 0; rg < 4; ++rg) part[(16 * i + 4 * lq + rg) * 64 + 16 * j + lr] = acc[i][j][rg];
    __syncthreads();
    const int rr = 8 * F.wave + (lane >> 3), cc = 8 * (lane & 7);
    f32x4m s0 = {0.f, 0.f, 0.f, 0.f}, s1 = s0;
#pragma unroll
    for (int w = 0; w < 8; ++w) { const LAS float* p = (const LAS float*)(F.lds) + w * 4096 + rr * 64 + cc; s0 = s0 + *(const LAS f32x4m*)p; s1 = s1 + *(const LAS f32x4m*)(p + 4); }
    const int r = row0 + rr;
#ifdef RESBF16
    const v4u xb = *(const v4u*)(F.XB + (size_t)r * 1024 + col0 + cc);
    f32x4m x0 = {bflo(xb.x), bfhi(xb.x), bflo(xb.y), bfhi(xb.y)}, x1 = {bflo(xb.z), bfhi(xb.z), bflo(xb.w), bfhi(xb.w)}; x0 = x0 + s0; x1 = x1 + s1;
    v4u wv; wv.x = pkbf(x0[0], x0[1]); wv.y = pkbf(x0[2], x0[3]); wv.z = pkbf(x1[0], x1[1]); wv.w = pkbf(x1[2], x1[3]);
    *(v4u*)(XBo + (size_t)r * 1024 + col0 + cc) = wv;
    x0 = (f32x4m){bflo(wv.x), bfhi(wv.x), bflo(wv.y), bfhi(wv.y)}; x1 = (f32x4m){bflo(wv.z), bfhi(wv.z), bflo(wv.w), bfhi(wv.w)};
#else
    float* xp = F.X + (size_t)r * 1024 + col0 + cc;
    f32x4m x0 = *(const f32x4m*)xp, x1 = *(const f32x4m*)(xp + 4); x0 = x0 + s0; x1 = x1 + s1;
    { float* xo = Xo + (size_t)r * 1024 + col0 + cc; *(f32x4m*)xo = x0; *(f32x4m*)(xo + 4) = x1; }
    v4u wv; wv.x = pkbf(x0[0], x0[1]); wv.y = pkbf(x0[2], x0[3]); wv.z = pkbf(x1[0], x1[1]); wv.w = pkbf(x1[2], x1[3]);
    *(v4u*)(XBo + (size_t)r * 1024 + col0 + cc) = wv;
#endif
    float q = (x0[0] * x0[0] + x0[1] * x0[1]) + (x0[2] * x0[2] + x0[3] * x0[3]) + (x1[0] * x1[0] + x1[1] * x1[1]) + (x1[2] * x1[2] + x1[3] * x1[3]);
    q += __shfl_xor(q, 1); q += __shfl_xor(q, 2); q += __shfl_xor(q, 4);
    if ((lane & 7) == 0) SSo[(size_t)r * 16 + tc] = q;
    __syncthreads();
}
}
namespace fk {
constexpr int NPHASE = 24;
struct Args { const float* in[18]; float* out; unsigned char* ws; int ph_lo, ph_hi; };
__global__ void __launch_bounds__(NTHREADS, 2) yoco_fwd(Args args) {
    extern __shared__ __attribute__((aligned(16))) unsigned char lds[];
    Frame F;
    F.lds = (LAS unsigned char*)lds; F.MISC = (volatile LAS unsigned*)(F.lds + MISC_OFF);
    F.wave = __builtin_amdgcn_readfirstlane((int)threadIdx.x >> 6); F.cps = 0;
    F.G = gridDim.x; { const int bx = blockIdx.x; F.vcu = (F.G % 8 == 0) ? (bx % 8) * (F.G / 8) + bx / 8 : bx; }
    unsigned char* ws = args.ws; F.ctl = (unsigned*)(ws + WS_CTL);
    F.xp = args.in[0]; F.xs = args.in[1]; F.cak = args.in[2]; F.cav = args.in[3]; F.cbk = args.in[4]; F.cbv = args.in[5]; F.g_attn = args.in[6]; F.g_ffn = args.in[7]; F.w_qkv_a = args.in[8];
    F.sinks_a = args.in[9]; F.w_o_a = args.in[10]; F.g_kv = args.in[11]; F.w_kv_s = args.in[12]; F.w_q_b = args.in[13]; F.w_o_b = args.in[14]; F.w_gu = args.in[15]; F.w_dn = args.in[16]; F.g_final = args.in[17];
    F.out = args.out;
    F.WqkvA = (bf16*)(ws + WS_WQKVA); F.WoA = (bf16*)(ws + WS_WOA); F.Wb2 = (bf16*)(ws + WS_WB2); F.Wb3 = (bf16*)(ws + WS_WB3); F.WoB = (bf16*)(ws + WS_WOB); F.Wgu = (bf16*)(ws + WS_WGU); F.Wd = (bf16*)(ws + WS_WD);
    F.X = (float*)(ws + WS_X); F.XB = (bf16*)(ws + WS_XB); F.SS = (float*)(ws + WS_SS);
    F.Q = (bf16*)(ws + WS_Q); F.KA = (bf16*)(ws + WS_KA); F.VA = (bf16*)(ws + WS_VA); F.KB = (bf16*)(ws + WS_KB); F.VB = (bf16*)(ws + WS_VB); F.ATT = (bf16*)(ws + WS_ATT);
    F.OG = (bf16*)(ws + WS_OG); F.LSE = (float*)(ws + WS_LSE); F.H = (bf16*)(ws + WS_H); F.CBK = (bf16*)(ws + WS_CBK); F.CBV = (bf16*)(ws + WS_CBV);
    for (int u = threadIdx.x; u < (LDS_BYTES - RING_BYTES) / 4; u += NTHREADS) ((LAS unsigned*)(F.lds + RING_BYTES))[u] = 0u;
    __syncthreads();
    const int lo = args.ph_lo, hi = args.ph_hi;
    XcdBarrier bar; bar.bar = (unsigned*)(F.ctl + CW_BAR); bar.x = 0; bar.st = nullptr;
    if (hi - lo > 1) bar = xcd_barrier_post((unsigned*)(F.ctl + CW_BAR), F.MISC + 8);
    F.fuse = (hi - lo > 1) ? 1 : 0;
#ifdef NO_ATTN_A
#define ATTN_A(F, l)
#else
#define ATTN_A(F, l) attn_a_phase(F, l)
#endif
#ifdef NO_ATTN_B
#define ATTN_B(F, half)
#else
#define ATTN_B(F, half) attn_b_phase(F, half)
#endif
#ifdef STREAM_FAKE
#define CS_DECL int fake_ = 0; CSTYPE CS{cp_src(F), cp_dst(F), fake_, 1}
#else
#ifndef CSTYPE
#define CSTYPE pg8::CopyStreamT<2>
#endif
#define CS_DECL CSTYPE CS{cp_src(F), cp_dst(F), F.cps, CP_NCHUNKS}
#endif
#ifndef PG8_ALIGN
#define PG8_ALIGN true
#endif
#ifndef REP_MINI
#define REP_MINI 0
#endif
#ifndef REP_RES
#define REP_RES 0
#endif
#define DRY_RES(Aptr, Bptr, Kk) do { for (int rep_ = 0; rep_ < REP_RES; ++rep_) { pg8::Gemm g{(const pg8::bf16_t*)(Aptr), (const pg8::bf16_t*)(Bptr), M, 1024, (Kk)}; pg8::StaticOrder S; S.init(M, 1024, F.G, (int)blockIdx.x); \
        pg8::EpiRes E{F.X, (pg8::bf16_t*)(ws + WS_CBK + 128 * MiB), (float*)(ws + WS_CBK + 200 * MiB), (float*)(ws + WS_CBK)}; pg8::gemm_phase<pg8::EpiRes, pg8::StaticOrder, true, true>(F.lds, g, S, E); } } while (0)
#define IN(k) (lo <= (k) && (k) < hi)
#ifndef REP_BAR
#define REP_BAR 1
#endif
#ifndef TMUL
#define TMUL 1
#endif
#ifdef TSEL
#define STAMP(k) do { if (blockIdx.x == 0 && threadIdx.x == 0) { ((unsigned long long*)(F.ctl + 8192))[(k)] = __builtin_amdgcn_s_memrealtime(); } } while (0)
#else
#define STAMP(k) do { } while (0)
#endif
#if REP_BAR == 2
#define SEAM(k) do { if (IN(k) && IN((k) + 1)) { xcd_barrier(bar); xcd_barrier(bar); } } while (0)
#else
#define SEAM(k) do { if (IN(k) && IN((k) + 1)) xcd_barrier(bar); STAMP((k) + 1); } while (0)
#endif
#define GEMM_PHASE(WIN, EpiT, Aptr, Bptr, Nn, Kk, ...) do { pg8::Gemm g{(const pg8::bf16_t*)(Aptr), (const pg8::bf16_t*)(Bptr), M, (Nn), (Kk)}; pg8::StaticOrder S; S.init(M, (Nn), F.G, (int)blockIdx.x); \
        EpiT E{__VA_ARGS__}; CS_DECL; for (int rep_ = 0; rep_ < (EpiT::REPS); ++rep_) pg8::gemm_phase<EpiT, pg8::StaticOrder, PG8_ALIGN, true, CSTYPE>(F.lds, g, S, E, CS); } while (0)

    #ifndef REP_P0W
#define REP_P0W 1
#endif
    STAMP(0);
#define GEMM_PHASE_NC(WIN, EpiT, Aptr, Bptr, Nn, Kk, ...) do { pg8::Gemm g{(const pg8::bf16_t*)(Aptr), (const pg8::bf16_t*)(Bptr), M, (Nn), (Kk)}; pg8::StaticOrder S; S.init(M, (Nn), F.G, (int)blockIdx.x); \
        EpiT E{__VA_ARGS__}; for (int rep_ = 0; rep_ < (EpiT::REPS); ++rep_) pg8::gemm_phase<EpiT, pg8::StaticOrder, PG8_ALIGN, true>(F.lds, g, S, E); conv_window<WIN>(F, (M / 256) * ((Nn) / 256)); } while (0)
#ifndef CSTYPE_RES
#define CSTYPE_RES pg8::CopyStreamT<2>
#endif
#ifndef CSTYPE_GU
#define CSTYPE_GU pg8::CopyStreamT<2>
#endif
#ifdef GU_NOCOPY
#define GEMM_PHASE_GU GEMM_PHASE_NC
#else
#define GEMM_PHASE_GU(WIN, EpiT, Aptr, Bptr, Nn, Kk, ...) do { pg8::Gemm g{(const pg8::bf16_t*)(Aptr), (const pg8::bf16_t*)(Bptr), M, (Nn), (Kk)}; pg8::StaticOrder S; S.init(M, (Nn), F.G, (int)blockIdx.x); \
        EpiT E{__VA_ARGS__}; CSTYPE_GU CS{cp_src(F), cp_dst(F), F.cps, CP_NCHUNKS}; for (int rep_ = 0; rep_ < (EpiT::REPS); ++rep_) pg8::gemm_phase<EpiT, pg8::StaticOrder, PG8_ALIGN, true, CSTYPE_GU>(F.lds, g, S, E, CS); conv_window<WIN>(F, (M / 256) * ((Nn) / 256)); } while (0)
#endif
#define RES_PHASE(WIN, Aptr, Bptr, Kk) do { { pg8::Gemm g{(const pg8::bf16_t*)(Aptr), (const pg8::bf16_t*)(Bptr), MP, 1024, (Kk)}; pg8::StaticOrder S; S.init(MP, 1024, F.G, (int)blockIdx.x); \
        pg8::EpiRes E{F.X, F.XB, F.SS, F.X}; CSTYPE_RES CS{cp_src(F), cp_dst(F), F.cps, CP_NCHUNKS}; pg8::gemm_phase<pg8::EpiRes, pg8::StaticOrder, true, true, CSTYPE_RES>(F.lds, g, S, E, CS); } for (int rm_ = 0; rm_ < REP_MINI; ++rm_) mini_gemm(F, (Aptr), (Bptr), (Kk), (float*)(ws + WS_CBK), (bf16*)(ws + WS_CBK + 128 * MiB), (float*)(ws + WS_CBK + 200 * MiB)); mini_gemm(F, (Aptr), (Bptr), (Kk), F.X, F.XB, F.SS); } while (0)
    if (IN(0)) { for (int rep = 0; rep < REP_P0W; ++rep) p0_weights(F); STAMP(30); p0_x(F); STAMP(31);
#ifdef STREAM_FAKE
        bg_copy_rows(F, 0, BG_ROWS, F.vcu, F.G);
#endif
    } SEAM(0);
#define A_LAYER(l) do { const int pb = 1 + 5 * (l); \
    if (IN(pb)) GEMM_PHASE_NC(4 * (l) + 0, pg8::EpiProj<0>, F.XB, F.WqkvA + (size_t)(l) * 1536 * 1024, 1536, 1024, F.SS, F.Q, F.KA, F.VA, F.out + O2 + (size_t)(l) * 2 * 128 * 256, F.out + O3 + (size_t)(l) * 2 * 128 * 256, F.out + O6 + (size_t)(l) * 128 * 128 * 256, F.out + O7 + (size_t)(l) * 128 * 128 * 256); \
    SEAM(pb); \
    if (IN(pb + 1)) { ATTN_A(F, (l)); } SEAM(pb + 1); \
    if (IN(pb + 2)) DRY_RES(F.ATT, F.WoA + (size_t)(l) * 1024 * 1024, 1024); if (IN(pb + 2)) RES_PHASE(4 * (l) + 1, F.ATT, F.WoA + (size_t)(l) * 1024 * 1024, 1024); SEAM(pb + 2); \
    if (IN(pb + 3)) GEMM_PHASE_GU(4 * (l) + 2, pg8::EpiGlu, F.XB, F.Wgu + (size_t)(l) * NGU * 1024, NGU, 1024, F.SS, F.H); SEAM(pb + 3); \
    if (IN(pb + 4)) DRY_RES(F.H, F.Wd + (size_t)(l) * 1024 * DFF, DFF); if (IN(pb + 4)) RES_PHASE(4 * (l) + 3, F.H, F.Wd + (size_t)(l) * 1024 * DFF, DFF); SEAM(pb + 4); } while (0)
    A_LAYER(0);
    A_LAYER(1);
    if (IN(11)) GEMM_PHASE_NC(8, pg8::EpiProj<1>, F.XB, F.Wb2, 2560, 1024, F.SS, F.Q, F.KB, F.VB, F.out + O4, F.out + O5, F.out + O8, F.out + O9); SEAM(11);
    if (IN(12)) { ATTN_B(F, 0); } SEAM(12);
    if (!F.fuse) { if (IN(13)) combine_b(F); SEAM(13); } else STAMP(14);
    if (IN(14)) RES_PHASE(9, F.ATT, F.WoB, 512); SEAM(14);
    if (IN(15)) GEMM_PHASE_GU(10, pg8::EpiGlu, F.XB, F.Wgu + (size_t)2 * NGU * 1024, NGU, 1024, F.SS, F.H); SEAM(15);
    if (IN(16)) RES_PHASE(11, F.H, F.Wd + (size_t)2 * 1024 * DFF, DFF); SEAM(16);
    if (IN(17)) GEMM_PHASE_NC(12, pg8::EpiProj<2>, F.XB, F.Wb3, 1536, 1024, F.SS, F.Q, nullptr, nullptr, nullptr, nullptr, nullptr, nullptr); SEAM(17);
    if (IN(18)) { ATTN_B(F, 1); } SEAM(18);
    if (!F.fuse) { if (IN(19)) combine_b(F); SEAM(19); } else STAMP(20);
    if (IN(20)) RES_PHASE(13, F.ATT, F.WoB + (size_t)1024 * 512, 512); SEAM(20);
    if (IN(21)) GEMM_PHASE_GU(14, pg8::EpiGlu, F.XB, F.Wgu + (size_t)3 * NGU * 1024, NGU, 1024, F.SS, F.H); SEAM(21);
    if (IN(22)) RES_PHASE(15, F.H, F.Wd + (size_t)3 * 1024 * DFF, DFF); SEAM(22);
#ifdef STREAM_FAKE
    if (IN(23)) final_norm(F);
#else
    if (IN(23)) { cp_finish(F); final_norm(F); }
#endif
#ifdef TSEL
    asm volatile("s_waitcnt vmcnt(0)" ::: "memory"); __syncthreads();
    if (blockIdx.x == 0 && threadIdx.x == 0) {
        STAMP(24); asm volatile("s_waitcnt vmcnt(0)" ::: "memory");
        const volatile unsigned long long* ts = (const volatile unsigned long long*)(F.ctl + 8192);
        constexpr unsigned long long CATS = 0x4376154321543210ull;
        constexpr unsigned CATS2 = 0x75437615u;
        unsigned long long tsel = 0;
#pragma unroll
        for (int k = 0; k < 24; ++k) { const int c = (k < 16) ? (int)((CATS >> (4 * k)) & 15ull) : (int)((CATS2 >> (4 * (k - 16))) & 15u); if (c == (TSEL)) tsel += ts[k + 1] - ts[k]; }
        if ((TSEL) >= 100) tsel = ts[(TSEL) - 100 + 1] - ts[(TSEL) - 100];
        if ((TSEL) == 11) tsel = ts[24] - ts[23]; if ((TSEL) == 12) tsel = (ts[14] - ts[13]) + (ts[20] - ts[19]); if ((TSEL) == 8) tsel = ts[30] - ts[0]; if ((TSEL) == 9) tsel = ts[31] - ts[30]; if ((TSEL) == 10) tsel = ts[1] - ts[31];
        const unsigned long long t0 = __builtin_amdgcn_s_memrealtime(); while (__builtin_amdgcn_s_memrealtime() - t0 < (TMUL) * tsel) __builtin_amdgcn_s_sleep(8);
    }
#endif
#undef IN
#undef SEAM
#undef GEMM_PHASE
#undef A_LAYER
}
static int g_grid = 0;
static bool setup() {
    if (g_grid) return g_grid > 0;
    int dev = 0, cus = 0;
    if (hipGetDevice(&dev) != hipSuccess || hipDeviceGetAttribute(&cus, hipDeviceAttributeMultiprocessorCount, dev) != hipSuccess) { g_grid = -1; return false; }
    if (hipFuncSetAttribute((const void*)yoco_fwd, hipFuncAttributeMaxDynamicSharedMemorySize, LDS_BYTES) != hipSuccess) { fprintf(stderr, "hipFuncSetAttribute failed\n"); g_grid = -1; return false; }
    int per_cu = 0; (void)hipOccupancyMaxActiveBlocksPerMultiprocessor(&per_cu, (const void*)yoco_fwd, NTHREADS, LDS_BYTES); (void)hipGetLastError();
    if (per_cu < 1) fprintf(stderr, "occupancy query says %d blocks/CU\n", per_cu);
    if (cus < 256) { fprintf(stderr, "this kernel is built for the 256 CUs of an MI355X (found %d): nothing launched\n", cus); g_grid = -1; return false; }
    g_grid = 256;
    return true;
}
static void launch(void* const* d_in, float* out, void* ws, int lo, int hi, hipStream_t st) {
    Args a{}; for (int i = 0; i < 18; ++i) a.in[i] = (const float*)d_in[i]; a.out = out; a.ws = (unsigned char*)ws; a.ph_lo = lo; a.ph_hi = hi;
    hipLaunchKernelGGL(yoco_fwd, dim3(g_grid), dim3(NTHREADS), LDS_BYTES, st, a);
}
}
extern "C" void kernel_launch(void* const* d_in, const int* in_sizes, int n_in, void* d_out, int out_size, void* d_ws, size_t ws_size, hipStream_t stream) {
    if (!fk::setup()) return;
    if (ws_size < fk::WS_END) { fprintf(stderr, "ws too small\n"); return; }
    (void)hipMemsetAsync((char*)d_ws + fk::WS_CTL, 0, fk::CTL_ZERO_BYTES, stream);
    fk::launch(d_in, (float*)d_out, d_ws, 0, fk::NPHASE, stream);
}
```

```cpp
#define RESBF16 1
#define SB_TS0 26
#define SB_TS1 33
#include <hip/hip_runtime.h>
#include <cstdint>
#include <cstdio>
#include <cmath>
namespace fk {
constexpr int D = 1024, TP = 8192, NBP = 2, MP = NBP * TP, NBS = 128, SS_ = 8, MS = NBS * SS_, M = MP + MS;
constexpr int DFF = 2816, NGU = 2 * DFF, HD = 64;
constexpr int NWAVES = 8, NTHREADS = 512;
constexpr float LOG2E = 1.4426950408889634f, C2 = 0.125f * LOG2E, EPS = 1e-6f;
constexpr size_t MiB = 1u << 20;
constexpr size_t WS_CTL = 0, CTL_ZERO_BYTES = 1 * MiB;
constexpr size_t WS_WQKVA = 1 * MiB;
constexpr size_t WS_WOA = WS_WQKVA + 6 * MiB;
constexpr size_t WS_WB2 = WS_WOA + 4 * MiB;
constexpr size_t WS_WB3 = WS_WB2 + 5 * MiB;
constexpr size_t WS_WOB = WS_WB3 + 3 * MiB;
constexpr size_t WS_WGU = WS_WOB + 2 * MiB;
constexpr size_t WS_WD = WS_WGU + 44 * MiB;
constexpr size_t WS_X = WS_WD + 22 * MiB;
constexpr size_t WS_XB = WS_X + 68 * MiB;
constexpr size_t WS_SS = WS_XB + 34 * MiB;
constexpr size_t WS_Q = WS_SS + 2 * MiB;
constexpr size_t WS_KA = WS_Q + 51 * MiB;
constexpr size_t WS_VA = WS_KA + 9 * MiB;
constexpr size_t WS_KB = WS_VA + 9 * MiB;
constexpr size_t WS_VB = WS_KB + 17 * MiB;
constexpr size_t WS_ATT = WS_VB + 17 * MiB;
constexpr size_t WS_OG = WS_ATT + 34 * MiB;
constexpr size_t WS_LSE = WS_OG + 51 * MiB;
constexpr size_t WS_H = WS_LSE + 2 * MiB;
constexpr size_t WS_CBK = WS_H + 94 * MiB;
constexpr size_t WS_CBV = WS_CBK + 256 * MiB;
constexpr size_t WS_END = WS_CBV + 256 * MiB;
static_assert(WS_END <= 1024 * MiB, "fast workspace must fit below 1 GiB");
constexpr size_t O0 = 0, O1 = 16777216ull, O2 = O1 + 1048576ull, O3 = O2 + 131072ull, O4 = O3 + 131072ull, O5 = O4 + 2097152ull,
                 O6 = O5 + 2097152ull, O7 = O6 + 8388608ull, O8 = O7 + 8388608ull, O9 = O8 + 134217728ull;
constexpr int CW_BAR = 4096;
constexpr int CW_BAR2 = 12288;
constexpr int RING_BYTES = 131072, MISC_OFF = RING_BYTES + 320, LDS_BYTES = 147456;

#define GAS __attribute__((address_space(1)))
#define LAS __attribute__((address_space(3)))
typedef unsigned short bf16;
typedef unsigned v4u __attribute__((ext_vector_type(4)));
typedef unsigned v2u __attribute__((ext_vector_type(2)));
typedef float f32x4 __attribute__((ext_vector_type(4)));
typedef float f32x16 __attribute__((ext_vector_type(16)));
typedef short bf16x8 __attribute__((ext_vector_type(8)));
typedef short s16x4 __attribute__((ext_vector_type(4)));
typedef float f32x2_t __attribute__((ext_vector_type(2)));
typedef __bf16 bf16x2_t __attribute__((ext_vector_type(2)));
__device__ __forceinline__ unsigned pkbf(float lo, float hi) { f32x2_t v = {lo, hi}; bf16x2_t b = __builtin_convertvector(v, bf16x2_t); return __builtin_bit_cast(unsigned, b); }
__device__ __forceinline__ float bflo(unsigned u) { return __uint_as_float(u << 16); }
__device__ __forceinline__ float bfhi(unsigned u) { return __uint_as_float(u & 0xffff0000u); }
__device__ __forceinline__ float wave_sum(float v) {
#pragma unroll
    for (int o = 1; o < 64; o <<= 1) v += __shfl_xor(v, o);
    return v;
}
__device__ __forceinline__ float rstd_row(const float* ss, int row) {
    const f32x4* p = (const f32x4*)(ss + (size_t)row * 16); const f32x4 a = p[0], b = p[1], c = p[2], d = p[3];
    const float s = ((a.x + a.y) + (a.z + a.w)) + ((b.x + b.y) + (b.z + b.w)) + ((c.x + c.y) + (c.z + c.w)) + ((d.x + d.y) + (d.z + d.w));
    return 1.0f / sqrtf(s * (1.0f / 1024.0f) + EPS);
}
__device__ __forceinline__ float slope_of(int idx, int n) { return exp2f(-8.0f * (float)(idx + 1) / (float)n); }
}
namespace pg8 {
#define PG8_LAS __attribute__((address_space(3)))
typedef unsigned short bf16_t;
typedef short bf16x8 __attribute__((ext_vector_type(8)));
typedef float f32x4 __attribute__((ext_vector_type(4)));
typedef unsigned u32x4 __attribute__((ext_vector_type(4)));
constexpr int BM = 256, BK = 64, HALF = 128, HTB = HALF * BK * 2  , STAGE_BYTES = 8 * HTB, NXCD = 8, WGM = 8;

__host__ __device__ __forceinline__ int lds_byte(int r, int c) { const int st = (r >> 4) * 2 + (c >> 5), rr = r & 15, cc = c & 31, ob = rr * 64 + cc * 2; return st * 1024 + (ob ^ (((ob >> 9) & 1) << 5)); }
__host__ __device__ __forceinline__ void stage_rc(int b, int& R, int& C) { const int st = b / 1024, sb = b % 1024, swz = sb ^ (((sb >> 9) & 1) << 5); R = (st >> 1) * 16 + swz / 64; C = (st & 1) * 32 + (swz % 64) / 2; }
__host__ __device__ __forceinline__ int perm32(int rho) { const int n = rho >> 4, i = rho & 15; return 8 * (i >> 2) + 4 * n + (i & 3); }

struct Unit { int pm, pn; };
struct Gemm { const bf16_t* A; const bf16_t* Bt; int M, N, K; };

struct StaticOrder {
    int nM, nN, nwg, G, c;
    __host__ __device__ void init(int M, int N, int G_, int c_) { nM = M / BM; nN = N / BM; nwg = nM * nN; G = G_; c = c_; }
    __host__ __device__ bool next(int i, Unit& u) const {
        const long L = (long)i * G + c; if (L >= nwg) return false;
        int wgid = (int)L; { const int q = nwg / NXCD, r = nwg % NXCD, xcd = wgid % NXCD, off = wgid / NXCD; wgid = (xcd < r ? xcd * (q + 1) : r * (q + 1) + (xcd - r) * q) + off; }
        const int nig = WGM * nN, gid = wgid / nig, fm = gid * WGM, gsz = (nM - fm) < WGM ? (nM - fm) : WGM;
        u.pm = fm + ((wgid % nig) % gsz); u.pn = (wgid % nig) / gsz; return true;
    }
    __device__ __forceinline__ void a_ready(const Unit&) const {}
    __device__ __forceinline__ void done(const Unit&) const {}
};

__device__ __forceinline__ unsigned cvt_pk_bf16(float lo, float hi) { unsigned r; asm volatile("v_cvt_pk_bf16_f32 %0, %1, %2" : "=v"(r) : "v"(lo), "v"(hi)); return r; }
typedef float f32x2 __attribute__((ext_vector_type(2)));
#ifndef REP_PROJ
#define REP_PROJ 1
#endif
#ifndef REP_GLU
#define REP_GLU 1
#endif
template <int KIND> struct EpiProj {
    static constexpr bool PERM = true, AFTER_DRAIN = false; static constexpr int REPS = REP_PROJ;
    const float* ss; bf16_t* Q; bf16_t* K; bf16_t* V; float* outKp; float* outVp; float* outKs; float* outVs;
    __device__ __forceinline__ void operator()(const f32x4 (&acc)[2][2][4][2], const Unit& u, int wr, int wc, int fr, int fq) const {
        const int row0 = u.pm * BM + wr * 64 + fr; const int pn = u.pn;
        bf16_t* dst; int ld, col; float sc = 1.0f; float* o32p = nullptr; float* o32s = nullptr; int kvw = 0;
        if (KIND == 0) { if (pn < 4) { dst = Q; ld = 1024; col = pn * 256; sc = fk::C2; } else if (pn == 4) { dst = K; ld = 256; col = 0; o32p = outKp; o32s = outKs; kvw = 256; } else { dst = V; ld = 256; col = 0; o32p = outVp; o32s = outVs; kvw = 256; } }
        else if (KIND == 1) { if (pn < 6) { dst = Q; ld = 1536; col = pn * 256; sc = fk::C2; } else if (pn < 8) { dst = K; ld = 512; col = (pn - 6) * 256; o32p = outKp; o32s = outKs; kvw = 512; } else { dst = V; ld = 512; col = (pn - 8) * 256; o32p = outVp; o32s = outVs; kvw = 512; } }
        else { dst = Q; ld = 1536; col = pn * 256; sc = fk::C2; }
        const int cl = col + wc * 32 + 8 * fq;
        float rsv[2][4];
#pragma unroll
        for (int ai = 0; ai < 2; ++ai)
#pragma unroll
            for (int m = 0; m < 4; ++m) { const f32x4 v = *(const f32x4*)(ss + (size_t)(row0 + ai * HALF + m * 16) * 16 + 4 * fq); rsv[ai][m] = (v[0] + v[1]) + (v[2] + v[3]); }
#pragma unroll
        for (int ai = 0; ai < 2; ++ai)
#pragma unroll
            for (int m = 0; m < 4; ++m) { float s = rsv[ai][m]; s += __shfl_xor(s, 16); s += __shfl_xor(s, 32); rsv[ai][m] = (1.0f / sqrtf(s * (1.0f / 1024.0f) + fk::EPS)) * sc; }
#pragma unroll
        for (int ai = 0; ai < 2; ++ai)
#pragma unroll
            for (int m = 0; m < 4; ++m) {
                const int r = row0 + ai * HALF + m * 16; const float rs = rsv[ai][m];
                float* o32 = nullptr;
                if (KIND != 2 && kvw) {
                    if (r < fk::MP) { const int b = r >> 13, t = r & 8191; const int W = (KIND == 0) ? 128 : 2048; if (t >= 8192 - W) o32 = o32p + ((size_t)b * W + (t - (8192 - W))) * kvw; }
                    else { const int rsx = r - fk::MP, b = rsx >> 3, s = rsx & 7; const int W = (KIND == 0) ? 128 : 2048; o32 = o32s + ((size_t)b * W + (W - 8) + s) * kvw; }
                }
#pragma unroll
                for (int bj = 0; bj < 2; ++bj) {
                    const f32x4 v0 = acc[ai][bj][m][0] * rs, v1 = acc[ai][bj][m][1] * rs;
                    u32x4 w; w.x = fk::pkbf(v0[0], v0[1]); w.y = fk::pkbf(v0[2], v0[3]); w.z = fk::pkbf(v1[0], v1[1]); w.w = fk::pkbf(v1[2], v1[3]);
                    *(u32x4*)(dst + (size_t)r * ld + cl + bj * HALF) = w;
                    if (KIND != 2) { if (o32) { *(f32x4*)(o32 + cl + bj * HALF) = v0; *(f32x4*)(o32 + cl + bj * HALF + 4) = v1; } }
                }
            }
    }
};
struct EpiRes {
    static constexpr bool PERM = true, AFTER_DRAIN = false; static constexpr int REPS = 1;
    float* X; bf16_t* XB; float* SS; float* Xo;
    __device__ __forceinline__ void operator()(const f32x4 (&acc)[2][2][4][2], const Unit& u, int wr, int wc, int fr, int fq) const {
        const int row0 = u.pm * BM + wr * 64 + fr; const int cl = u.pn * BM + wc * 32 + 8 * fq;
#ifdef RESBF16
#pragma unroll
        for (int ai = 0; ai < 2; ++ai) {
            u32x4 xin[4][2];
#pragma unroll
            for (int m = 0; m < 4; ++m)
#pragma unroll
                for (int bj = 0; bj < 2; ++bj) xin[m][bj] = *(const u32x4*)(XB + (size_t)(row0 + ai * HALF + m * 16) * 1024 + cl + bj * HALF);
#pragma unroll
            for (int m = 0; m < 4; ++m) {
                const int r = row0 + ai * HALF + m * 16; float q = 0.f;
#pragma unroll
                for (int bj = 0; bj < 2; ++bj) {
                    const u32x4 xb = xin[m][bj];
                    f32x4 x0 = {fk::bflo(xb.x), fk::bfhi(xb.x), fk::bflo(xb.y), fk::bfhi(xb.y)}, x1 = {fk::bflo(xb.z), fk::bfhi(xb.z), fk::bflo(xb.w), fk::bfhi(xb.w)};
                    x0 = x0 + acc[ai][bj][m][0]; x1 = x1 + acc[ai][bj][m][1];
                    u32x4 w; w.x = fk::pkbf(x0[0], x0[1]); w.y = fk::pkbf(x0[2], x0[3]); w.z = fk::pkbf(x1[0], x1[1]); w.w = fk::pkbf(x1[2], x1[3]);
                    *(u32x4*)(XB + (size_t)r * 1024 + cl + bj * HALF) = w;
                    const float r0 = fk::bflo(w.x), r1 = fk::bfhi(w.x), r2 = fk::bflo(w.y), r3 = fk::bfhi(w.y), r4 = fk::bflo(w.z), r5 = fk::bfhi(w.z), r6 = fk::bflo(w.w), r7 = fk::bfhi(w.w);
                    q += (r0 * r0 + r1 * r1) + (r2 * r2 + r3 * r3) + (r4 * r4 + r5 * r5) + (r6 * r6 + r7 * r7);
                }
                q += __shfl_xor(q, 16); q += __shfl_xor(q, 32);
                if (fq == 0) SS[(size_t)r * 16 + u.pn * 4 + wc] = q;
            }
        }
#else
#pragma unroll
        for (int ai = 0; ai < 2; ++ai) {
            f32x4 xin[4][2][2];
#pragma unroll
            for (int m = 0; m < 4; ++m)
#pragma unroll
                for (int bj = 0; bj < 2; ++bj) { const float* xp = X + (size_t)(row0 + ai * HALF + m * 16) * 1024 + cl + bj * HALF; xin[m][bj][0] = *(const f32x4*)xp; xin[m][bj][1] = *(const f32x4*)(xp + 4); }
#pragma unroll
            for (int m = 0; m < 4; ++m) {
                const int r = row0 + ai * HALF + m * 16; float q = 0.f;
#pragma unroll
                for (int bj = 0; bj < 2; ++bj) {
                    const f32x4 x0 = xin[m][bj][0] + acc[ai][bj][m][0], x1 = xin[m][bj][1] + acc[ai][bj][m][1];
                    { float* xo = Xo + (size_t)r * 1024 + cl + bj * HALF; *(f32x4*)xo = x0; *(f32x4*)(xo + 4) = x1; }
                    q += (x0[0] * x0[0] + x0[1] * x0[1]) + (x0[2] * x0[2] + x0[3] * x0[3]) + (x1[0] * x1[0] + x1[1] * x1[1]) + (x1[2] * x1[2] + x1[3] * x1[3]);
                    u32x4 w; w.x = fk::pkbf(x0[0], x0[1]); w.y = fk::pkbf(x0[2], x0[3]); w.z = fk::pkbf(x1[0], x1[1]); w.w = fk::pkbf(x1[2], x1[3]);
                    *(u32x4*)(XB + (size_t)r * 1024 + cl + bj * HALF) = w;
                }
                q += __shfl_xor(q, 16); q += __shfl_xor(q, 32);
                if (fq == 0) SS[(size_t)r * 16 + u.pn * 4 + wc] = q;
            }
        }
#endif
    }
};
struct EpiGlu {
    static constexpr bool PERM = true, AFTER_DRAIN = false; static constexpr int REPS = REP_GLU;
    const float* ss; bf16_t* H;
    __device__ __forceinline__ void operator()(const f32x4 (&acc)[2][2][4][2], const Unit& u, int wr, int wc, int fr, int fq) const {
        const int row0 = u.pm * BM + wr * 64 + fr; const int cl = u.pn * HALF + wc * 32 + 8 * fq;
        float rsv[2][4];
#pragma unroll
        for (int ai = 0; ai < 2; ++ai)
#pragma unroll
            for (int m = 0; m < 4; ++m) { const f32x4 v = *(const f32x4*)(ss + (size_t)(row0 + ai * HALF + m * 16) * 16 + 4 * fq); rsv[ai][m] = (v[0] + v[1]) + (v[2] + v[3]); }
#pragma unroll
        for (int ai = 0; ai < 2; ++ai)
#pragma unroll
            for (int m = 0; m < 4; ++m) { float s = rsv[ai][m]; s += __shfl_xor(s, 16); s += __shfl_xor(s, 32); rsv[ai][m] = 1.0f / sqrtf(s * (1.0f / 1024.0f) + fk::EPS); }
#pragma unroll
        for (int ai = 0; ai < 2; ++ai)
#pragma unroll
            for (int m = 0; m < 4; ++m) {
                const int r = row0 + ai * HALF + m * 16; const float rs = rsv[ai][m];
                float h[8];
#pragma unroll
                for (int n = 0; n < 2; ++n)
#pragma unroll
                    for (int e = 0; e < 4; ++e) { const float g = acc[ai][0][m][n][e] * rs, up = acc[ai][1][m][n][e] * rs;
                        const float sg = __builtin_amdgcn_rcpf(1.0f + __builtin_amdgcn_exp2f(-g * fk::LOG2E)); h[n * 4 + e] = g * sg * up; }
                u32x4 w; w.x = fk::pkbf(h[0], h[1]); w.y = fk::pkbf(h[2], h[3]); w.z = fk::pkbf(h[4], h[5]); w.w = fk::pkbf(h[6], h[7]);
                *(u32x4*)(H + (size_t)r * fk::DFF + cl) = w;
            }
    }
};
struct NoCopy { static constexpr bool ON = false; static constexpr int NP = 0; };
template <int NP_> struct CopyStreamT { static constexpr bool ON = true; static constexpr int NP = NP_; const char* src; char* dst; int& step; int nchunks; };
typedef CopyStreamT<2> CopyStream;
typedef unsigned cp_v4u __attribute__((ext_vector_type(4)));
template <class Epi, class Sched, bool ALIGN_EPI = false, bool SP2 = false, class CP = NoCopy>
__device__ __forceinline__ void gemm_phase(PG8_LAS unsigned char* lds, const Gemm g, const Sched& S, const Epi& E, const CP& cp = CP()) {
    const int tid = threadIdx.x, wid = __builtin_amdgcn_readfirstlane(tid >> 6), lane = tid & 63, wr = wid >> 2, wc = wid & 3, fr = lane & 15, fq = lane >> 4;
    const int K = g.K, nt = K / BK;
    unsigned voffA[2], voffB[2];
#pragma unroll
    for (int i = 0; i < 2; ++i) { int R, C; stage_rc(tid * 16 + i * 8192, R, C); const int Rb = Epi::PERM ? ((R & ~31) + perm32(R & 31)) : R;
        voffA[i] = (unsigned)(R * K + C) * 2u; voffB[i] = (unsigned)(Rb * K + C) * 2u; }
    const size_t kstep = (size_t)(BK * 2);
    const size_t hstep = (size_t)HALF * K * 2;
    const size_t tstep = 2 * hstep;
    const unsigned ldsw = (unsigned)wid * 1024u;
    const int aoff = lds_byte(wr * 64 + fr, fq * 8), boff = lds_byte(wc * 32 + fr, fq * 8);
#define PG8_SA(b, h) (((b) * 2 + (h)) * HTB)
#define PG8_SB(b, h) ((4 + (b) * 2 + (h)) * HTB)
#define PG8_STAGE(bufoff, gbase, voff) do { _Pragma("unroll") for (int _i = 0; _i < 2; ++_i) \
        __builtin_amdgcn_global_load_lds((const unsigned*)((const char*)(gbase) + (voff)[_i]), (PG8_LAS unsigned*)(lds + (bufoff) + ldsw + _i * 8192), 16, 0, 0); } while (0)
#define PG8_LDA(dst, b, h) do { _Pragma("unroll") for (int m = 0; m < 4; ++m) _Pragma("unroll") for (int k = 0; k < 2; ++k) dst[m][k] = *(const PG8_LAS bf16x8*)(lds + PG8_SA(b, h) + aoff + m * 2048 + k * 1024); } while (0)
#define PG8_LDB(dst, b, h) do { _Pragma("unroll") for (int n = 0; n < 2; ++n) _Pragma("unroll") for (int k = 0; k < 2; ++k) dst[n][k] = *(const PG8_LAS bf16x8*)(lds + PG8_SB(b, h) + boff + n * 2048 + k * 1024); } while (0)
#define PG8_MMA(ai, bj, At, Bt) do { __builtin_amdgcn_s_setprio(1); _Pragma("unroll") for (int m = 0; m < 4; ++m) _Pragma("unroll") for (int n = 0; n < 2; ++n) _Pragma("unroll") for (int k = 0; k < 2; ++k) \
        acc[ai][bj][m][n] = __builtin_amdgcn_mfma_f32_16x16x32_bf16(Bt[n][k], At[m][k], acc[ai][bj][m][n], 0, 0, 0); __builtin_amdgcn_s_setprio(0); } while (0)
#define PG8_WAIT_V(n) asm volatile("s_waitcnt vmcnt(" #n ")" ::: "memory")
#define PG8_WAIT_L(n) asm volatile("s_waitcnt lgkmcnt(" #n ")" ::: "memory")
#define PG8_BAR __builtin_amdgcn_s_barrier()
#define PG8_SCHED __builtin_amdgcn_sched_barrier(0)
    Unit cur, nxt; int ui = 0;
    if (!S.next(0, cur)) return;
    int cpstep = 0; unsigned cpoff = 0u; cp_v4u cpA = {0u, 0u, 0u, 0u}, cpB = {0u, 0u, 0u, 0u}, cpC = {0u, 0u, 0u, 0u}, cpD = {0u, 0u, 0u, 0u}; int cA_ = 0, cB_ = 0, cC_ = 0, cD_ = 0;
    if constexpr (CP::ON) { static_assert(SP2, "CopyStream rides the SP2 loop"); cpstep = cp.step; cpoff = (unsigned)wid * 1024u + (unsigned)lane * 16u; }
#define PG8_CPLOAD(buf, c) do { if constexpr (CP::ON) { const char* p_ = cp.src + (size_t)(c) * 8192 + cpoff; asm volatile("global_load_dwordx4 %0, %1, off nt" : "=v"(buf) : "v"(p_) : "memory"); } } while (0)
#define PG8_CPSTORE(buf, c) do { if constexpr (CP::ON) { char* p_ = cp.dst + (size_t)(c) * 8192 + cpoff; \
        if constexpr (CP::NP == 1) asm volatile("s_waitcnt vmcnt(8)\n\tglobal_store_dwordx4 %1, %0, off nt\n\ts_nop 1" : "+v"(buf) : "v"(p_) : "memory"); \
        else if constexpr (CP::NP == 2) asm volatile("s_waitcnt vmcnt(9)\n\tglobal_store_dwordx4 %1, %0, off nt\n\ts_nop 1" : "+v"(buf) : "v"(p_) : "memory"); \
        else if constexpr (CP::NP == 3) asm volatile("s_waitcnt vmcnt(10)\n\tglobal_store_dwordx4 %1, %0, off nt\n\ts_nop 1" : "+v"(buf) : "v"(p_) : "memory"); \
        else asm volatile("s_waitcnt vmcnt(11)\n\tglobal_store_dwordx4 %1, %0, off nt\n\ts_nop 1" : "+v"(buf) : "v"(p_) : "memory"); } } while (0)
#define PG8_CPBEGIN() do { if constexpr (CP::ON) { const int l_ = cp.nchunks - 1; cA_ = cpstep < l_ ? cpstep : l_; cB_ = cpstep + 1 < l_ ? cpstep + 1 : l_; cC_ = cpstep + 2 < l_ ? cpstep + 2 : l_; cD_ = cpstep + 3 < l_ ? cpstep + 3 : l_; cpstep = cpstep + CP::NP < cp.nchunks ? cpstep + CP::NP : cp.nchunks; } } while (0)
#define PG8_WAIT_VL() do { if constexpr (CP::NP == 4) { PG8_WAIT_V(12); } else if constexpr (CP::NP == 3) { PG8_WAIT_V(11); } else if constexpr (CP::NP == 2) { PG8_WAIT_V(10); } else if constexpr (CP::NP == 1) { PG8_WAIT_V(9); } else { PG8_WAIT_V(8); } } while (0)
    f32x4 acc[2][2][4][2];
#pragma unroll
    for (int a = 0; a < 2; ++a)
#pragma unroll
        for (int b = 0; b < 2; ++b)
#pragma unroll
            for (int m = 0; m < 4; ++m)
#pragma unroll
                for (int n = 0; n < 2; ++n) acc[a][b][m][n] = (f32x4){0.f, 0.f, 0.f, 0.f};
    bf16x8 At[4][2], B0[2][2], B1[2][2];
    const char* cA = (const char*)g.A + (size_t)cur.pm * tstep; const char* cB = (const char*)g.Bt + (size_t)cur.pn * tstep;
    S.a_ready(cur);
    if constexpr (SP2) {
        PG8_STAGE(PG8_SB(0, 0), cB, voffB); PG8_STAGE(PG8_SB(0, 1), cB + hstep, voffB); PG8_STAGE(PG8_SA(0, 0), cA, voffA); PG8_STAGE(PG8_SA(0, 1), cA + hstep, voffA);
        if (wr == 1) PG8_BAR;
        PG8_WAIT_V(2); PG8_BAR;
        PG8_STAGE(PG8_SB(1, 0), cB + kstep, voffB); PG8_STAGE(PG8_SA(1, 0), cA + kstep, voffA); PG8_STAGE(PG8_SB(1, 1), cB + hstep + kstep, voffB);
        PG8_WAIT_V(6); PG8_BAR;
    } else {
        PG8_STAGE(PG8_SB(0, 0), cB, voffB); PG8_STAGE(PG8_SA(0, 0), cA, voffA); PG8_STAGE(PG8_SB(0, 1), cB + hstep, voffB); PG8_STAGE(PG8_SA(0, 1), cA + hstep, voffA);
        if (wr == 1) PG8_BAR;
        PG8_WAIT_V(4); PG8_BAR;
        PG8_STAGE(PG8_SB(1, 0), cB + kstep, voffB); PG8_STAGE(PG8_SA(1, 0), cA + kstep, voffA); PG8_STAGE(PG8_SB(1, 1), cB + hstep + kstep, voffB);
        PG8_WAIT_V(6); PG8_BAR;
    }
    for (;;) {
        const bool has_next = S.next(ui + 1, nxt);
        const char* nA = has_next ? (const char*)g.A + (size_t)nxt.pm * tstep : cA; const char* nB = has_next ? (const char*)g.Bt + (size_t)nxt.pn * tstep : cB;
        for (int t = 0; t < nt; t += 2) {
            const bool last = (t == nt - 2);
            const char* a1 = cA + (size_t)(t + 1) * kstep;
            const char* a2 = last ? nA : cA + (size_t)(t + 2) * kstep; const char* b2 = last ? nB : cB + (size_t)(t + 2) * kstep;
            const char* a3 = a2 + kstep; const char* b3 = b2 + kstep;
            if (last && has_next) S.a_ready(nxt);
            if constexpr (SP2) {
            PG8_LDB(B0, 0, 0); PG8_LDB(B1, 0, 1); PG8_SCHED; PG8_LDA(At, 0, 0); PG8_STAGE(PG8_SA(1, 1), a1 + hstep, voffA); PG8_CPBEGIN(); PG8_CPLOAD(cpA, cA_); if constexpr (CP::NP >= 2) { PG8_CPLOAD(cpB, cB_); } if constexpr (CP::NP >= 3) { PG8_CPLOAD(cpC, cC_); } if constexpr (CP::NP >= 4) { PG8_CPLOAD(cpD, cD_); }
            PG8_WAIT_VL(); PG8_WAIT_L(0); PG8_BAR; PG8_MMA(0, 0, At, B0); PG8_MMA(0, 1, At, B1); PG8_BAR; PG8_SCHED;
            PG8_LDA(At, 0, 1); PG8_STAGE(PG8_SB(0, 0), b2, voffB); PG8_STAGE(PG8_SB(0, 1), b2 + hstep, voffB); PG8_STAGE(PG8_SA(0, 0), a2, voffA);
            PG8_WAIT_VL(); PG8_WAIT_L(0); PG8_BAR; PG8_MMA(1, 0, At, B0); PG8_MMA(1, 1, At, B1); PG8_BAR; PG8_SCHED;
            PG8_LDB(B0, 1, 0); PG8_LDB(B1, 1, 1); PG8_SCHED; PG8_LDA(At, 1, 0); PG8_STAGE(PG8_SA(0, 1), a2 + hstep, voffA); PG8_CPSTORE(cpA, cA_); if constexpr (CP::NP >= 2) { PG8_CPSTORE(cpB, cB_); } if constexpr (CP::NP >= 3) { PG8_CPSTORE(cpC, cC_); } if constexpr (CP::NP >= 4) { PG8_CPSTORE(cpD, cD_); }
            PG8_WAIT_VL(); PG8_WAIT_L(0); PG8_BAR; PG8_MMA(0, 0, At, B0); PG8_MMA(0, 1, At, B1); PG8_BAR; PG8_SCHED;
            PG8_LDA(At, 1, 1); PG8_STAGE(PG8_SB(1, 0), b3, voffB); PG8_STAGE(PG8_SB(1, 1), b3 + hstep, voffB); PG8_STAGE(PG8_SA(1, 0), a3, voffA);
            PG8_WAIT_VL(); PG8_WAIT_L(0); PG8_BAR; PG8_MMA(1, 0, At, B0); PG8_MMA(1, 1, At, B1); PG8_BAR; PG8_SCHED;
            } else {
            PG8_LDB(B0, 0, 0); PG8_SCHED; PG8_LDA(At, 0, 0); PG8_STAGE(PG8_SA(1, 1), a1 + hstep, voffA);
            PG8_WAIT_L(8); PG8_BAR; PG8_WAIT_L(0); PG8_MMA(0, 0, At, B0); PG8_BAR; PG8_SCHED;
            PG8_LDB(B1, 0, 1); PG8_STAGE(PG8_SB(0, 0), b2, voffB);
            PG8_BAR; PG8_WAIT_L(0); PG8_MMA(0, 1, At, B1); PG8_BAR;
            PG8_LDA(At, 0, 1); PG8_STAGE(PG8_SA(0, 0), a2, voffA);
            PG8_BAR; PG8_WAIT_L(0); PG8_MMA(1, 0, At, B0); PG8_BAR; PG8_SCHED;
            PG8_STAGE(PG8_SB(0, 1), b2 + hstep, voffB);
            PG8_WAIT_V(6); PG8_BAR; PG8_MMA(1, 1, At, B1); PG8_BAR;
            PG8_LDB(B0, 1, 0); PG8_SCHED; PG8_LDA(At, 1, 0); PG8_STAGE(PG8_SA(0, 1), a2 + hstep, voffA);
            PG8_WAIT_L(8); PG8_BAR; PG8_WAIT_L(0); PG8_MMA(0, 0, At, B0); PG8_BAR; PG8_SCHED;
            PG8_LDB(B1, 1, 1); PG8_STAGE(PG8_SB(1, 0), b3, voffB);
            PG8_BAR; PG8_WAIT_L(0); PG8_MMA(0, 1, At, B1); PG8_BAR;
            PG8_LDA(At, 1, 1); PG8_STAGE(PG8_SA(1, 0), a3, voffA);
            PG8_BAR; PG8_WAIT_L(0); PG8_MMA(1, 0, At, B0); PG8_BAR; PG8_SCHED;
            PG8_STAGE(PG8_SB(1, 1), b3 + hstep, voffB);
            PG8_WAIT_V(6); PG8_BAR; PG8_MMA(1, 1, At, B1); PG8_BAR;
            }
        }
        if constexpr (ALIGN_EPI) { if (wr == 0) PG8_BAR; }
        if constexpr (!Epi::AFTER_DRAIN) { E(acc, cur, wr, wc, fr, fq); S.done(cur); }
        if (!has_next) break;
#pragma unroll
        for (int a = 0; a < 2; ++a)
#pragma unroll
            for (int b = 0; b < 2; ++b)
#pragma unroll
                for (int m = 0; m < 4; ++m)
#pragma unroll
                    for (int n = 0; n < 2; ++n) acc[a][b][m][n] = (f32x4){0.f, 0.f, 0.f, 0.f};
        cur = nxt; cA = nA; cB = nB; ++ui;
        if constexpr (ALIGN_EPI) { if (wr == 1) PG8_BAR; }
    }
    if constexpr (CP::ON) cp.step = cpstep;
    PG8_WAIT_V(0);
    if constexpr (!ALIGN_EPI) { if (wr == 0) PG8_BAR; }
    PG8_BAR;
    if constexpr (Epi::AFTER_DRAIN) { E.fused(acc, cur, wr, wc, fr, fq, lds, wid, lane); S.done(cur); }
#undef PG8_SA
#undef PG8_SB
#undef PG8_STAGE
#undef PG8_LDA
#undef PG8_LDB
#undef PG8_MMA
#undef PG8_WAIT_V
#undef PG8_WAIT_L
#undef PG8_BAR
#undef PG8_SCHED
#undef PG8_CPLOAD
#undef PG8_CPSTORE
#undef PG8_CPBEGIN
#undef PG8_WAIT_VL
}
}
#define XB_TMO      128
#define XB_XCNT(j)  (256  + 64 * (j))
#define XB_XSUB(j)  (1280 + 64 * (j))
#define XB_XGEN(j)  (2304 + 64 * (j))
#define XB_TOP      3328
#define XB_TOPGEN   3392
#define XCD_BAR_WORDS 3456
#define XB_SPIN_CAP (1u << 18)

__device__ __forceinline__ unsigned xb_ld(unsigned* p)              { return __hip_atomic_load(p, __ATOMIC_RELAXED, __HIP_MEMORY_SCOPE_AGENT); }
__device__ __forceinline__ unsigned xb_add(unsigned* p, unsigned v) { return __hip_atomic_fetch_add(p, v, __ATOMIC_RELAXED, __HIP_MEMORY_SCOPE_AGENT); }
__device__ __forceinline__ unsigned xb_xcc_id() { return (unsigned)__builtin_amdgcn_s_getreg((3 << 11) | 20) & 0xFu; }
#define XB_SPIN(cond, bar) do { unsigned _sp = 0; while (cond) { __builtin_amdgcn_s_sleep(1); \
    if ((++_sp & 255u) == 0u) { if (xb_ld(&(bar)[XB_TMO])) break; if (_sp > XB_SPIN_CAP) { atomicAdd(&(bar)[XB_TMO], 1u); break; } } } } while (0)

struct XcdBarrier {
    unsigned* bar; unsigned x;
    volatile LAS unsigned* st;
};

__device__ __forceinline__ XcdBarrier xcd_barrier_post(unsigned* bar, volatile LAS unsigned* st) {
    XcdBarrier b; b.bar = bar; b.x = xb_xcc_id(); b.st = st;
    if (threadIdx.x == 0) (void)xb_add(&bar[XB_XCNT(b.x)], 1u);
    return b;
}
__device__ __forceinline__ void xcd_barrier_complete(unsigned* bar, unsigned x, unsigned& nloc, unsigned& nx) {
    const unsigned G = gridDim.x * gridDim.y * gridDim.z;
    unsigned sum, cnt, mine, sp = 0u;
    for (;;) {
        sum = 0u; cnt = 0u; mine = 0u;
#pragma unroll
        for (unsigned j = 0; j < 16; ++j) { const unsigned c = xb_ld(&bar[XB_XCNT(j)]); sum += c; cnt += (c > 0u) ? 1u : 0u; mine = (j == x) ? c : mine; }
        if (sum == G) break;
        __builtin_amdgcn_s_sleep(1);
        if ((++sp & 255u) == 0u) { if (xb_ld(&bar[XB_TMO])) break; if (sp > XB_SPIN_CAP) { atomicAdd(&bar[XB_TMO], 1u); break; } }
    }
    nloc = mine > 0u ? mine : 1u; nx = cnt > 0u ? cnt : 1u;
}

__device__ __forceinline__ void xcd_barrier_thread(const XcdBarrier& b) {
    {
        unsigned* bar = b.bar;
        __builtin_amdgcn_s_waitcnt(0);
        unsigned nloc = b.st[0], nx = b.st[1];
        if (nloc == 0u) { xcd_barrier_complete(bar, b.x, nloc, nx); b.st[0] = nloc; b.st[1] = nx; }
        const unsigned old = xb_add(&bar[XB_XSUB(b.x)], 1u);
        const unsigned gen = old / nloc;
        if (old + 1u == (gen + 1u) * nloc) {
            __builtin_amdgcn_fence(__ATOMIC_RELEASE, "agent");
            asm volatile("s_waitcnt vmcnt(0)" ::: "memory");
            const unsigned og = xb_add(&bar[XB_TOP], 1u);
            const unsigned tg = og / nx;
            if (og + 1u == (tg + 1u) * nx) xb_add(&bar[XB_TOPGEN], 1u);
            else XB_SPIN(xb_ld(&bar[XB_TOPGEN]) == tg, bar);
            __builtin_amdgcn_fence(__ATOMIC_ACQUIRE, "agent");
            xb_add(&bar[XB_XGEN(b.x)], 1u);
            asm volatile("s_waitcnt vmcnt(0)" ::: "memory");
        } else {
            XB_SPIN(xb_ld(&bar[XB_XGEN(b.x)]) == gen, bar);
            __builtin_amdgcn_fence(__ATOMIC_ACQUIRE, "agent");
            asm volatile("s_waitcnt vmcnt(0)" ::: "memory");
        }
    }
}
__device__ __forceinline__ void xcd_barrier(const XcdBarrier& b) {
    asm volatile("s_waitcnt vmcnt(0)" ::: "memory");
    __syncthreads();
    if (threadIdx.x == 0) xcd_barrier_thread(b);
    __syncthreads();
}
namespace fk {
struct Frame {
    LAS unsigned char* lds; volatile LAS unsigned* MISC; unsigned* ctl;
    int wave, vcu, G;
    int fuse;
    int cps;
    __device__ __forceinline__ int lane() const { int l; asm volatile("v_mbcnt_lo_u32_b32 %0, -1, 0\n\tv_mbcnt_hi_u32_b32 %0, -1, %0" : "=v"(l)); return l; }
    __device__ __forceinline__ int tid() const { return wave * 64 + lane(); }
    const float *xp, *xs, *cak, *cav, *cbk, *cbv, *g_attn, *g_ffn, *w_qkv_a, *sinks_a, *w_o_a, *g_kv, *w_kv_s, *w_q_b, *w_o_b, *w_gu, *w_dn, *g_final;
    float* out;
    bf16 *WqkvA, *WoA, *Wb2, *Wb3, *WoB, *Wgu, *Wd;
    float* X; bf16* XB; float* SS;
    bf16 *Q, *KA, *VA, *KB, *VB, *ATT, *OG, *H, *CBK, *CBV; float* LSE;
};
__device__ __forceinline__ void transpose_item(const float* W, int ldw, int K, const float* gain, bf16* WT, int n0dst, int csrc, int k0, LAS float* scr, int lane) {
    f32x4 v[16];
#pragma unroll
    for (int i = 0; i < 16; ++i) { const int kk = 2 * i + (lane >> 5); v[i] = *(const f32x4*)(W + (size_t)(k0 + kk) * ldw + csrc + 4 * (lane & 31)); }
#pragma unroll
    for (int i = 0; i < 16; ++i) { const int kk = 2 * i + (lane >> 5); f32x4 x = v[i]; if (gain) { const float g = gain[k0 + kk]; x = x * g; } *(LAS f32x4*)(scr + kk * 128 + 4 * (lane & 31)) = x; }
    asm volatile("s_waitcnt lgkmcnt(0)" ::: "memory");
    const int kc = lane & 3;
#pragma unroll
    for (int j = 0; j < 8; ++j) { const int n = (lane >> 2) + 16 * j; const LAS float* s = scr + (8 * kc) * 128 + n;
        v4u o; o.x = pkbf(s[0 * 128], s[1 * 128]); o.y = pkbf(s[2 * 128], s[3 * 128]); o.z = pkbf(s[4 * 128], s[5 * 128]); o.w = pkbf(s[6 * 128], s[7 * 128]);
        *(v4u*)(WT + (size_t)(n0dst + n) * K + k0 + 8 * kc) = o; }
    asm volatile("s_waitcnt lgkmcnt(0)" ::: "memory");
}
template <bool GU> __device__ __forceinline__ void transpose_matrix(const float* W, int K, int N, const float* gain, bf16* WT, int rowoff, LAS float* scr, int lane, int item) {
    const int nblk = N / 128, kb = item / nblk, nb = item % nblk; const int n0 = nb * 128; int csrc = n0;
    if (GU) { const int pn = n0 >> 8, j = n0 & 255; csrc = (j < 128) ? (128 * pn) : (DFF + 128 * pn); }
    transpose_item(W, N, K, gain, WT, rowoff + n0, csrc, kb * 32, scr, lane);
}
constexpr int CV_QKV = (1024 / 32) * (1536 / 128), CV_SQ = (1024 / 32) * (1024 / 128), CV_OB = (512 / 32) * (1024 / 128), CV_GU = (1024 / 32) * (NGU / 128), CV_DN = (DFF / 32) * (1024 / 128);
constexpr int CV_A = CV_QKV + CV_SQ + CV_GU + CV_DN, CV_B0 = CV_QKV + CV_SQ + CV_OB + CV_GU + CV_DN, CV_B1 = CV_QKV + CV_OB + CV_GU + CV_DN, CV_ALL = 2 * CV_A + CV_B0 + CV_B1;
static_assert(CV_ALL == 11008, "conversion item count");
constexpr int CONV_P0 = 1200;
constexpr int CONV_WIN[17] = {1200, 3200, 3200, 3900, 3900, 5900, 5900, 6600, 6600, 8300, 8300, 9000, 9000, 10400, 10400, 11008, 11008};
__device__ __forceinline__ void conv_item(Frame& F, LAS float* scr, int lane, int it) {
    int r = it;
    if (r < 2 * CV_A) { const int l = r / CV_A; r -= l * CV_A;
        if (r < CV_QKV) { transpose_matrix<false>(F.w_qkv_a + (size_t)l * 1024 * 1536, 1024, 1536, F.g_attn + l * 1024, F.WqkvA + (size_t)l * 1536 * 1024, 0, scr, lane, r); return; } r -= CV_QKV;
        if (r < CV_SQ) { transpose_matrix<false>(F.w_o_a + (size_t)l * 1024 * 1024, 1024, 1024, nullptr, F.WoA + (size_t)l * 1024 * 1024, 0, scr, lane, r); return; } r -= CV_SQ;
        if (r < CV_GU) { transpose_matrix<true>(F.w_gu + (size_t)l * 1024 * NGU, 1024, NGU, F.g_ffn + l * 1024, F.Wgu + (size_t)l * NGU * 1024, 0, scr, lane, r); return; } r -= CV_GU;
        transpose_matrix<false>(F.w_dn + (size_t)l * DFF * 1024, DFF, 1024, nullptr, F.Wd + (size_t)l * 1024 * DFF, 0, scr, lane, r); return; }
    r -= 2 * CV_A;
    if (r < CV_B0) {
        if (r < CV_QKV) { transpose_matrix<false>(F.w_q_b, 1024, 1536, F.g_attn + 2 * 1024, F.Wb2, 0, scr, lane, r); return; } r -= CV_QKV;
        if (r < CV_SQ) { transpose_matrix<false>(F.w_kv_s, 1024, 1024, F.g_kv, F.Wb2, 1536, scr, lane, r); return; } r -= CV_SQ;
        if (r < CV_OB) { transpose_matrix<false>(F.w_o_b, 512, 1024, nullptr, F.WoB, 0, scr, lane, r); return; } r -= CV_OB;
        if (r < CV_GU) { transpose_matrix<true>(F.w_gu + (size_t)2 * 1024 * NGU, 1024, NGU, F.g_ffn + 2 * 1024, F.Wgu + (size_t)2 * NGU * 1024, 0, scr, lane, r); return; } r -= CV_GU;
        transpose_matrix<false>(F.w_dn + (size_t)2 * DFF * 1024, DFF, 1024, nullptr, F.Wd + (size_t)2 * 1024 * DFF, 0, scr, lane, r); return; }
    r -= CV_B0;
    if (r < CV_QKV) { transpose_matrix<false>(F.w_q_b + (size_t)1024 * 1536, 1024, 1536, F.g_attn + 3 * 1024, F.Wb3, 0, scr, lane, r); return; } r -= CV_QKV;
    if (r < CV_OB) { transpose_matrix<false>(F.w_o_b + (size_t)512 * 1024, 512, 1024, nullptr, F.WoB + (size_t)1024 * 512, 0, scr, lane, r); return; } r -= CV_OB;
    if (r < CV_GU) { transpose_matrix<true>(F.w_gu + (size_t)3 * 1024 * NGU, 1024, NGU, F.g_ffn + 3 * 1024, F.Wgu + (size_t)3 * NGU * 1024, 0, scr, lane, r); return; } r -= CV_GU;
    transpose_matrix<false>(F.w_dn + (size_t)3 * DFF * 1024, DFF, 1024, nullptr, F.Wd + (size_t)3 * 1024 * DFF, 0, scr, lane, r);
}
__device__ __forceinline__ void conv_items(Frame& F, int lo, int hi, int j, int n) {
    LAS float* scr = (LAS float*)(F.lds + F.wave * 16384); const int lane = F.lane();
    for (int it = lo + j * NWAVES + F.wave; it < hi; it += n * NWAVES) conv_item(F, scr, lane, it);
}
__device__ __forceinline__ void p0_weights(Frame& F) { conv_items(F, 0, CONV_P0, F.vcu, F.G); }
template <int WIN> __device__ __forceinline__ void conv_window(Frame& F, int nwg) {
    const int rem = nwg % F.G; if (rem == 0) return; const int c = (int)blockIdx.x; if (c < rem) return;
    if (CONV_WIN[WIN] < CONV_WIN[WIN + 1]) conv_items(F, CONV_WIN[WIN], CONV_WIN[WIN + 1], c - rem, F.G - rem);
}
__device__ __forceinline__ void p0_x(Frame& F) {
    const int lane = F.lane(); const int gw = F.vcu * NWAVES + F.wave, NGW = F.G * NWAVES;
    for (int m0 = gw * 2; m0 < M; m0 += NGW * 2) {
        f32x4 v[2][4]; float s[2];
#pragma unroll
        for (int q = 0; q < 2; ++q) { const int m = m0 + q; const float* src = (m < MP) ? F.xp + (size_t)m * D : F.xs + (size_t)(m - MP) * D; const f32x4* xr = (const f32x4*)src + lane;
#pragma unroll
            for (int j = 0; j < 4; ++j) v[q][j] = xr[64 * j]; }
#ifdef RESBF16
#pragma unroll
        for (int q = 0; q < 2; ++q) { float a = 0.f; const int m = m0 + q; v2u* bo = (v2u*)(F.XB + (size_t)m * D) + lane;
#pragma unroll
            for (int j = 0; j < 4; ++j) { v2u w; w.x = pkbf(v[q][j].x, v[q][j].y); w.y = pkbf(v[q][j].z, v[q][j].w); bo[64 * j] = w;
                const float r0 = bflo(w.x), r1 = bfhi(w.x), r2 = bflo(w.y), r3 = bfhi(w.y); a += (r0 * r0 + r1 * r1) + (r2 * r2 + r3 * r3); }
            s[q] = wave_sum(a); if (lane < 16) F.SS[(size_t)m * 16 + lane] = (lane == 0) ? s[q] : 0.f; }
#else
#pragma unroll
        for (int q = 0; q < 2; ++q) { float a = 0.f;
#pragma unroll
            for (int j = 0; j < 4; ++j) a += (v[q][j].x * v[q][j].x + v[q][j].y * v[q][j].y) + (v[q][j].z * v[q][j].z + v[q][j].w * v[q][j].w);
            s[q] = wave_sum(a); }
#pragma unroll
        for (int q = 0; q < 2; ++q) { const int m = m0 + q; f32x4* xo = (f32x4*)(F.X + (size_t)m * D) + lane; v2u* bo = (v2u*)(F.XB + (size_t)m * D) + lane;
#pragma unroll
            for (int j = 0; j < 4; ++j) { xo[64 * j] = v[q][j]; v2u w; w.x = pkbf(v[q][j].x, v[q][j].y); w.y = pkbf(v[q][j].z, v[q][j].w); bo[64 * j] = w; }
            if (lane < 16) F.SS[(size_t)m * 16 + lane] = (lane == 0) ? s[q] : 0.f; }
#endif
    }
}
constexpr int BG_ROWS = 2 * NBS * 2040;
constexpr int BG_NWIN = 16;
constexpr int BG_W[BG_NWIN + 1] = {124, 0, 48, 0, 124, 0, 48, 0, 105, 0, 48, 0, 124, 0, 48, 0, 4100};
constexpr int bg_wsum(int n) { int s = 0; for (int i = 0; i < n; ++i) s += BG_W[i]; return s; }
constexpr int bg_row0(int w) { return (int)((long long)BG_ROWS * bg_wsum(w) / bg_wsum(BG_NWIN + 1)); }
__device__ __forceinline__ void bg_copy_rows(Frame& F, int r0, int r1, int j, int n) {
    const int lane = F.lane(); const int nwv = n * NWAVES;
    for (int r = r0 + (j * NWAVES + F.wave) * 4; r < r1; r += nwv * 4) {
        f32x4 a[4], c[4]; float* dst[4];
#pragma unroll
        for (int q = 0; q < 4; ++q) { const int rid = (r + q < r1) ? (r + q) : (r1 - 1); const int kv = rid / (NBS * 2040), rem = rid - kv * (NBS * 2040), b = rem / 2040, i = rem - b * 2040;
            const float* src = (kv ? F.cbv : F.cbk) + ((size_t)b * 2048 + i + 8) * 512; dst[q] = F.out + (kv ? O9 : O8) + ((size_t)b * 2048 + i) * 512;
            a[q] = ((const f32x4*)src)[lane]; c[q] = ((const f32x4*)src)[lane + 64]; }
#pragma unroll
        for (int q = 0; q < 4; ++q) { ((f32x4*)dst[q])[lane] = a[q]; ((f32x4*)dst[q])[lane + 64] = c[q]; }
    }
}
template <int WIN> __device__ __forceinline__ void bg_window(Frame& F, int nwg) {
    const int rem = nwg % F.G; if (rem == 0) return; const int c = (int)blockIdx.x; if (c < rem) return;
#ifndef REP_BG
#define REP_BG 1
#endif
    for (int rep = 0; rep < REP_BG; ++rep) bg_copy_rows(F, bg_row0(WIN), bg_row0(WIN + 1), c - rem, F.G - rem);
}
constexpr int CP_NCHUNKS = 510;
__device__ __forceinline__ const char* cp_src(Frame& F) { const int c = (int)blockIdx.x, kv = (c >> 7) & 1, b = c & 127; return (const char*)((kv ? F.cbv : F.cbk) + ((size_t)b * 2048 + 8) * 512); }
__device__ __forceinline__ char* cp_dst(Frame& F) { const int c = (int)blockIdx.x, kv = (c >> 7) & 1, b = c & 127; return (char*)(F.out + (kv ? O9 : O8) + (size_t)b * 2048 * 512); }
__device__ __forceinline__ void cp_finish(Frame& F) {
    const int lane = F.lane(); const unsigned off = (unsigned)F.wave * 1024u + (unsigned)lane * 16u; const char* s = cp_src(F); char* d = cp_dst(F);
    for (int c = F.cps; c < CP_NCHUNKS; c += 4) { v4u v[4];
#pragma unroll
        for (int q = 0; q < 4; ++q) { const int cc = (c + q < CP_NCHUNKS) ? c + q : CP_NCHUNKS - 1; v[q] = *(const v4u*)(s + (size_t)cc * 8192 + off); }
#pragma unroll
        for (int q = 0; q < 4; ++q) { const int cc = (c + q < CP_NCHUNKS) ? c + q : CP_NCHUNKS - 1; *(v4u*)(d + (size_t)cc * 8192 + off) = v[q]; } }
    F.cps = CP_NCHUNKS;
}
#define MFMA32(a, b, c) __builtin_amdgcn_mfma_f32_32x32x16_bf16((a), (b), (c), 0, 0, 0)
__device__ __forceinline__ int crow(int reg, int h) { return (reg & 3) + 8 * (reg >> 2) + 4 * h; }
struct BandArgs {
    const bf16* Qp; int ldq;
    const bf16* Kp; const bf16* Vp; int ldkv;
    int rowbase; int rstride;
    int i0;
    bf16* Op; int ldo;
    float* lsep; int ldl;
    float slope2; float sink2;
};
template <int MODE> struct BandRegs { static constexpr int QB = (MODE == 0) ? 64 : 256, NK = QB + 128, NIT = NK * 8 / NTHREADS; v4u k[NIT], v[NIT]; };
template <int MODE> __device__ __forceinline__ void band_fetch(BandRegs<MODE>& R, const BandArgs& a, int tid) {
    constexpr int NIT = BandRegs<MODE>::NIT;
#pragma unroll
    for (int it = 0; it < NIT; ++it) {
        const int c = it * NTHREADS + tid, kk = c >> 3, ch = c & 7; const int i = a.i0 - 128 + kk;
        R.k[it] = (v4u){0u, 0u, 0u, 0u}; R.v[it] = (v4u){0u, 0u, 0u, 0u};
        if (i >= 0) { const size_t row = (size_t)(a.rowbase + i * a.rstride); R.k[it] = *(const v4u*)(a.Kp + row * a.ldkv + ch * 8); R.v[it] = *(const v4u*)(a.Vp + row * a.ldkv + ch * 8); }
    }
}
template <int MODE> __device__ __forceinline__ void band_put(LAS unsigned char* lds, const BandRegs<MODE>& R, int tid) {
    constexpr int NK = BandRegs<MODE>::NK, NIT = BandRegs<MODE>::NIT, VSTR = 2 * NK + 8;
    LAS unsigned char* Kl = lds; LAS unsigned char* Vt = lds + NK * 144;
#pragma unroll
    for (int it = 0; it < NIT; ++it) {
        const int c = it * NTHREADS + tid, kk = c >> 3, ch = c & 7; const v4u kq = R.k[it], vq = R.v[it];
        *(LAS v4u*)(Kl + kk * 144 + ch * 16) = kq;
        LAS unsigned char* vt = Vt + (ch * 8) * VSTR + kk * 2;
        *(LAS unsigned short*)(vt) = (unsigned short)(vq.x & 0xffffu); *(LAS unsigned short*)(vt + 1 * VSTR) = (unsigned short)(vq.x >> 16);
        *(LAS unsigned short*)(vt + 2 * VSTR) = (unsigned short)(vq.y & 0xffffu); *(LAS unsigned short*)(vt + 3 * VSTR) = (unsigned short)(vq.y >> 16);
        *(LAS unsigned short*)(vt + 4 * VSTR) = (unsigned short)(vq.z & 0xffffu); *(LAS unsigned short*)(vt + 5 * VSTR) = (unsigned short)(vq.z >> 16);
        *(LAS unsigned short*)(vt + 6 * VSTR) = (unsigned short)(vq.w & 0xffffu); *(LAS unsigned short*)(vt + 7 * VSTR) = (unsigned short)(vq.w >> 16);
    }
}
template <int NK, int MAXD, bool SINK>
__device__ __forceinline__ void band_compute(LAS unsigned char* Kl, LAS unsigned char* Vt, int kk0, const bf16x8 (&qf)[4], int distbase, int keyidx0, float slope2, float sink2, int lane, f32x16 (&o)[2], float& m_out, float& l_out) {
    constexpr int VSTR = 2 * NK + 8; const int rl = lane & 31, h = lane >> 5;
    f32x16 S[5];
#pragma unroll
    for (int kt = 0; kt < 5; ++kt) {
        f32x16 accs = {0.f, 0.f, 0.f, 0.f, 0.f, 0.f, 0.f, 0.f, 0.f, 0.f, 0.f, 0.f, 0.f, 0.f, 0.f, 0.f};
#pragma unroll
        for (int d0 = 0; d0 < 4; ++d0) { const bf16x8 kf = *(const LAS bf16x8*)(Kl + (kk0 + 32 * kt + rl) * 144 + (16 * d0 + 8 * h) * 2); accs = MFMA32(kf, qf[d0], accs); }
        S[kt] = accs;
    }
    float mx = -INFINITY;
    const int d0i = distbase + rl - 4 * h, qi = distbase + rl + keyidx0; const unsigned lim = (unsigned)(qi < MAXD ? qi : MAXD); const float nsl = -slope2;
#pragma unroll
    for (int kt = 0; kt < 5; ++kt)
#pragma unroll
        for (int rg = 0; rg < 16; ++rg) { const int dist = d0i - (32 * kt + (rg & 3) + 8 * (rg >> 2)); const bool ok = (unsigned)dist <= lim;
            const float s = ok ? __builtin_fmaf(nsl, (float)dist, S[kt][rg]) : -INFINITY; S[kt][rg] = s; mx = fmaxf(mx, s); }
    mx = fmaxf(mx, __shfl_xor(mx, 32)); if (SINK) mx = fmaxf(mx, sink2);
    float l = 0.f;
#pragma unroll
    for (int kt = 0; kt < 5; ++kt)
#pragma unroll
        for (int rg = 0; rg < 16; ++rg) { const float p = __builtin_amdgcn_exp2f(S[kt][rg] - mx); S[kt][rg] = p; l += p; }
    l += __shfl_xor(l, 32); if (SINK) l += __builtin_amdgcn_exp2f(sink2 - mx);
    o[0] = (f32x16){0.f, 0.f, 0.f, 0.f, 0.f, 0.f, 0.f, 0.f, 0.f, 0.f, 0.f, 0.f, 0.f, 0.f, 0.f, 0.f}; o[1] = o[0];
#pragma unroll
    for (int kt = 0; kt < 5; ++kt)
#pragma unroll
        for (int s2 = 0; s2 < 2; ++s2) {
            v4u pw; pw.x = pkbf(S[kt][8 * s2 + 0], S[kt][8 * s2 + 1]); pw.y = pkbf(S[kt][8 * s2 + 2], S[kt][8 * s2 + 3]); pw.z = pkbf(S[kt][8 * s2 + 4], S[kt][8 * s2 + 5]); pw.w = pkbf(S[kt][8 * s2 + 6], S[kt][8 * s2 + 7]);
            const bf16x8 xs = __builtin_bit_cast(bf16x8, pw);
#pragma unroll
            for (int dh = 0; dh < 2; ++dh) {
                const LAS unsigned char* vp = Vt + (32 * dh + rl) * VSTR + (kk0 + 32 * kt + 16 * s2 + 4 * h) * 2;
                const s16x4 lo = *(const LAS s16x4*)vp, hi = *(const LAS s16x4*)(vp + 16);
                const bf16x8 va = __builtin_shufflevector(lo, hi, 0, 1, 2, 3, 4, 5, 6, 7);
                o[dh] = MFMA32(va, xs, o[dh]);
            }
        }
    m_out = mx; l_out = l;
}
__device__ __forceinline__ void band_store(bf16* orow, const f32x16 (&o)[2], float inv, int h) {
#pragma unroll
    for (int dh = 0; dh < 2; ++dh)
#pragma unroll
        for (int g4 = 0; g4 < 4; ++g4) { v2u w; w.x = pkbf(o[dh][4 * g4 + 0] * inv, o[dh][4 * g4 + 1] * inv); w.y = pkbf(o[dh][4 * g4 + 2] * inv, o[dh][4 * g4 + 3] * inv);
            *(v2u*)(orow + 32 * dh + 8 * g4 + 4 * h) = w; }
}
__device__ __forceinline__ void band_store_lds(LAS unsigned char* ost, const f32x16 (&o)[2], float inv, int lane, bf16* Op, size_t row0, int rstride, int ldo) {
    const int rl = lane & 31, h = lane >> 5;
#pragma unroll
    for (int p = 0; p < 2; ++p) {
        if ((rl >> 4) == p) {
#pragma unroll
            for (int dh = 0; dh < 2; ++dh)
#pragma unroll
                for (int g4 = 0; g4 < 4; ++g4) { v2u w; w.x = pkbf(o[dh][4 * g4 + 0] * inv, o[dh][4 * g4 + 1] * inv); w.y = pkbf(o[dh][4 * g4 + 2] * inv, o[dh][4 * g4 + 3] * inv);
                    *(LAS v2u*)(ost + (rl & 15) * 144 + (32 * dh + 8 * g4 + 4 * h) * 2) = w; }
        }
        asm volatile("s_waitcnt lgkmcnt(0)" ::: "memory");
#pragma unroll
        for (int j = 0; j < 2; ++j) { const int idx = lane + 64 * j, row = idx >> 3, c8 = idx & 7; const v4u v = *(const LAS v4u*)(ost + row * 144 + c8 * 16);
            *(v4u*)(Op + (row0 + (size_t)(16 * p + row) * rstride) * ldo + c8 * 8) = v; }
        asm volatile("s_waitcnt lgkmcnt(0)" ::: "memory");
    }
}
template <int MODE> __device__ __forceinline__ void band_unit(LAS unsigned char* lds, const BandArgs& a, int sb, int lane, int wave) {
    constexpr int QB = (MODE == 0) ? 64 : 256, NK = QB + 128, VSTR = 2 * NK + 8, OST = NK * 144 + 64 * VSTR;
    LAS unsigned char* Kl = lds; LAS unsigned char* Vt = lds + NK * 144;
    const int rl = lane & 31, h = lane >> 5;
    const int iq = a.i0 + 32 * sb + rl; const size_t qrow = (size_t)(a.rowbase + iq * a.rstride);
    bf16x8 qf[4];
#pragma unroll
    for (int d0 = 0; d0 < 4; ++d0) qf[d0] = *(const bf16x8*)(a.Qp + qrow * a.ldq + 16 * d0 + 8 * h);
    f32x16 o[2]; float m, l;
    band_compute<NK, (MODE == 0) ? 127 : 128, MODE == 0>(Kl, Vt, 32 * sb, qf, 128, a.i0 - 128 + 32 * sb, a.slope2, a.sink2, lane, o, m, l);
    const float inv = 1.0f / l;
    band_store_lds(lds + OST + wave * 2304, o, inv, lane, a.Op, (size_t)(a.rowbase + (a.i0 + 32 * sb) * a.rstride), a.rstride, a.ldo);
    if (MODE == 1) { if (h == 0) a.lsep[qrow * a.ldl] = m + __builtin_amdgcn_logf(l); }
}
}
namespace fk {
__device__ __forceinline__ void sample_a_unit(Frame& F, int l, int b, int kvh) {
    constexpr int NK = 160, VSTR = 2 * NK + 8; const int lane = F.lane(), tid = F.wave * 64 + lane;
    LAS unsigned char* Kl = F.lds; LAS unsigned char* Vt = F.lds + NK * 144;
    const float* ck = F.cak + (((size_t)l * NBS + b) * 128) * 256 + kvh * 64; const float* cv = F.cav + (((size_t)l * NBS + b) * 128) * 256 + kvh * 64;
    float* ok = F.out + O6 + (((size_t)l * NBS + b) * 128) * 256 + kvh * 64; float* ov = F.out + O7 + (((size_t)l * NBS + b) * 128) * 256 + kvh * 64;
#pragma unroll
    for (int c0 = 0; c0 < 2048; c0 += NTHREADS) {
        const int c = c0 + tid, kk = c >> 4, ch = c & 15;
        const f32x4 kq = *(const f32x4*)(ck + (size_t)kk * 256 + ch * 4), vq = *(const f32x4*)(cv + (size_t)kk * 256 + ch * 4);
        if (kk >= 8) { *(f32x4*)(ok + (size_t)(kk - 8) * 256 + ch * 4) = kq; *(f32x4*)(ov + (size_t)(kk - 8) * 256 + ch * 4) = vq; }
        v2u kw; kw.x = pkbf(kq.x, kq.y); kw.y = pkbf(kq.z, kq.w);
        *(LAS v2u*)(Kl + kk * 144 + ch * 8) = kw;
        const unsigned v01 = pkbf(vq.x, vq.y), v23 = pkbf(vq.z, vq.w);
        LAS unsigned char* vt = Vt + (ch * 4) * VSTR + kk * 2;
        *(LAS unsigned short*)(vt) = (unsigned short)(v01 & 0xffffu); *(LAS unsigned short*)(vt + VSTR) = (unsigned short)(v01 >> 16);
        *(LAS unsigned short*)(vt + 2 * VSTR) = (unsigned short)(v23 & 0xffffu); *(LAS unsigned short*)(vt + 3 * VSTR) = (unsigned short)(v23 >> 16);
    }
    if (tid < 256) {
        const int kk = 128 + (tid >> 3), ch = tid & 7; v4u kq = {0u, 0u, 0u, 0u}, vq = {0u, 0u, 0u, 0u};
        if (kk < 136) { const size_t row = (size_t)(MP + b * 8 + (kk - 128)); kq = *(const v4u*)(F.KA + row * 256 + kvh * 64 + ch * 8); vq = *(const v4u*)(F.VA + row * 256 + kvh * 64 + ch * 8); }
        *(LAS v4u*)(Kl + kk * 144 + ch * 16) = kq;
        LAS unsigned char* vt = Vt + (ch * 8) * VSTR + kk * 2;
        *(LAS unsigned short*)(vt) = (unsigned short)(vq.x & 0xffffu); *(LAS unsigned short*)(vt + 1 * VSTR) = (unsigned short)(vq.x >> 16);
        *(LAS unsigned short*)(vt + 2 * VSTR) = (unsigned short)(vq.y & 0xffffu); *(LAS unsigned short*)(vt + 3 * VSTR) = (unsigned short)(vq.y >> 16);
        *(LAS unsigned short*)(vt + 4 * VSTR) = (unsigned short)(vq.z & 0xffffu); *(LAS unsigned short*)(vt + 5 * VSTR) = (unsigned short)(vq.z >> 16);
        *(LAS unsigned short*)(vt + 6 * VSTR) = (unsigned short)(vq.w & 0xffffu); *(LAS unsigned short*)(vt + 7 * VSTR) = (unsigned short)(vq.w >> 16);
    }
    __syncthreads();
    if (F.wave == 0) {
        const int rl = lane & 31, h = lane >> 5, g = rl >> 3, s = rl & 7, head = kvh * 4 + g;
        const size_t qrow = (size_t)(MP + b * 8 + s);
        bf16x8 qf[4];
#pragma unroll
        for (int d0 = 0; d0 < 4; ++d0) qf[d0] = *(const bf16x8*)(F.Q + qrow * 1024 + head * 64 + 16 * d0 + 8 * h);
        const float slope2 = slope_of(head, 16) * LOG2E, sink2 = F.sinks_a[l * 16 + head] * LOG2E;
        f32x16 o[2]; float m, lsum;
        band_compute<NK, 127, true>(Kl, Vt, 0, qf, 128 + s - rl, 0, slope2, sink2, lane, o, m, lsum);
        band_store(F.ATT + qrow * 1024 + head * 64, o, 1.0f / lsum, h);
    }
    __syncthreads();
}
struct SbTile { f32x4 k[8]; float v[32]; };
__device__ __forceinline__ int sb_idx(int t, int ioff) { return (t < 24) ? (16 * (4 * t + (ioff >> 3)) + (ioff & 7)) : (32 * t + ioff + 768); }
__device__ __forceinline__ const float* sb_rowptr(const float* cache, const float* outc, int b, int idx, int col) {
    const int ic = idx > 2055 ? 2055 : idx;
    return (ic < 2048) ? cache + ((size_t)b * 2048 + ic) * 512 + col : outc + ((size_t)b * 2048 + (ic - 8)) * 512 + col;
}
__device__ __forceinline__ void sb_load(SbTile& T, const float* ck, const float* cv, const float* ok, const float* ov, int b, int slot, int t, int rl, int h) {
    const float* kp = sb_rowptr(ck, ok, b, sb_idx(t, rl), slot * 64 + 8 * h);
#pragma unroll
    for (int d0 = 0; d0 < 4; ++d0) { T.k[2 * d0] = *(const f32x4*)(kp + 16 * d0); T.k[2 * d0 + 1] = *(const f32x4*)(kp + 16 * d0 + 4); }
#pragma unroll
    for (int s2 = 0; s2 < 2; ++s2)
#pragma unroll
        for (int jj = 0; jj < 2; ++jj)
#pragma unroll
            for (int e = 0; e < 4; ++e) { const float* vp = sb_rowptr(cv, ov, b, sb_idx(t, 16 * s2 + 8 * jj + 4 * h + e), slot * 64 + rl);
                T.v[(s2 * 2 + 0) * 8 + jj * 4 + e] = vp[0]; T.v[(s2 * 2 + 1) * 8 + jj * 4 + e] = vp[32]; }
}
__device__ __forceinline__ void sb_compute(const SbTile& T, int t, const bf16x8 (&qf)[4], int tq, int rmask, int wmax, float slope2, bool colok, int h, f32x16 (&o)[2], float& m, float& l) {
    f32x16 S = {0.f, 0.f, 0.f, 0.f, 0.f, 0.f, 0.f, 0.f, 0.f, 0.f, 0.f, 0.f, 0.f, 0.f, 0.f, 0.f};
#pragma unroll
    for (int d0 = 0; d0 < 4; ++d0) { const f32x4 a = T.k[2 * d0], c = T.k[2 * d0 + 1]; v4u w; w.x = pkbf(a.x, a.y); w.y = pkbf(a.z, a.w); w.z = pkbf(c.x, c.y); w.w = pkbf(c.z, c.w);
        S = MFMA32(__builtin_bit_cast(bf16x8, w), qf[d0], S); }
    float tm = -INFINITY;
#pragma unroll
    for (int rg = 0; rg < 16; ++rg) { const int idx = sb_idx(t, 8 * (rg >> 2) + 4 * h + (rg & 3)); const int dist = tq - idx;
        const bool ok = colok && (dist >= 0) && ((dist & rmask) == 0) && (dist <= wmax);
        const float sc = ok ? (S[rg] - slope2 * (float)dist) : -INFINITY; S[rg] = sc; tm = fmaxf(tm, sc); }
    tm = fmaxf(tm, __shfl_xor(tm, 32));
    const float mn = fmaxf(m, tm), alpha = __builtin_amdgcn_exp2f(m - mn); m = mn;
    float ls = 0.f;
#pragma unroll
    for (int rg = 0; rg < 16; ++rg) { const float p = __builtin_amdgcn_exp2f(S[rg] - mn); S[rg] = p; ls += p; }
    l = l * alpha + ls;
#pragma unroll
    for (int dh = 0; dh < 2; ++dh)
#pragma unroll
        for (int rg = 0; rg < 16; ++rg) o[dh][rg] *= alpha;
#pragma unroll
    for (int s2 = 0; s2 < 2; ++s2) {
        v4u pw; pw.x = pkbf(S[8 * s2 + 0], S[8 * s2 + 1]); pw.y = pkbf(S[8 * s2 + 2], S[8 * s2 + 3]); pw.z = pkbf(S[8 * s2 + 4], S[8 * s2 + 5]); pw.w = pkbf(S[8 * s2 + 6], S[8 * s2 + 7]);
        const bf16x8 xs = __builtin_bit_cast(bf16x8, pw);
#pragma unroll
        for (int dh = 0; dh < 2; ++dh) { const float* vv = &T.v[(s2 * 2 + dh) * 8];
            v4u vw; vw.x = pkbf(vv[0], vv[1]); vw.y = pkbf(vv[2], vv[3]); vw.z = pkbf(vv[4], vv[5]); vw.w = pkbf(vv[6], vv[7]);
            o[dh] = MFMA32(__builtin_bit_cast(bf16x8, vw), xs, o[dh]); }
    }
}
#ifndef SBFORCE0
#define SBFORCE0 0
#endif
struct SbPacked { v4u d[4]; v2u sc; };
__device__ __forceinline__ unsigned q8_pack4(float a, float b, float c, float d, float s) {
    unsigned u = 0u;
    u = __builtin_amdgcn_cvt_pk_u8_f32(__builtin_rintf(__builtin_fmaf(a, s, 128.0f)), 0, u); u = __builtin_amdgcn_cvt_pk_u8_f32(__builtin_rintf(__builtin_fmaf(b, s, 128.0f)), 1, u);
    u = __builtin_amdgcn_cvt_pk_u8_f32(__builtin_rintf(__builtin_fmaf(c, s, 128.0f)), 2, u); u = __builtin_amdgcn_cvt_pk_u8_f32(__builtin_rintf(__builtin_fmaf(d, s, 128.0f)), 3, u);
    return u;
}
__device__ __forceinline__ void q8_unpack4(unsigned w, float s, float& a, float& b, float& c, float& d) {
    a = ((float)(w & 255u) - 128.0f) * s; b = ((float)((w >> 8) & 255u) - 128.0f) * s; c = ((float)((w >> 16) & 255u) - 128.0f) * s; d = ((float)(w >> 24) - 128.0f) * s;
}
__device__ __forceinline__ void sb_encode_store(const SbTile& T, unsigned char* q8, unsigned char* q8s, size_t idx) {
    float km = 0.f, vm = 0.f;
#pragma unroll
    for (int i = 0; i < 8; ++i) km = fmaxf(fmaxf(km, fmaxf(fabsf(T.k[i][0]), fabsf(T.k[i][1]))), fmaxf(fabsf(T.k[i][2]), fabsf(T.k[i][3])));
#pragma unroll
    for (int i = 0; i < 32; ++i) vm = fmaxf(vm, fabsf(T.v[i]));
    const float ks = km > 0.f ? 127.0f / km : 0.f, vs = vm > 0.f ? 127.0f / vm : 0.f;
    v4u* dst = (v4u*)(q8 + idx * 64);
    { v4u d; d.x = q8_pack4(T.k[0][0], T.k[0][1], T.k[0][2], T.k[0][3], ks); d.y = q8_pack4(T.k[1][0], T.k[1][1], T.k[1][2], T.k[1][3], ks); d.z = q8_pack4(T.k[2][0], T.k[2][1], T.k[2][2], T.k[2][3], ks); d.w = q8_pack4(T.k[3][0], T.k[3][1], T.k[3][2], T.k[3][3], ks); dst[0] = d; }
    asm volatile("" ::: "memory");
    { v4u d; d.x = q8_pack4(T.k[4][0], T.k[4][1], T.k[4][2], T.k[4][3], ks); d.y = q8_pack4(T.k[5][0], T.k[5][1], T.k[5][2], T.k[5][3], ks); d.z = q8_pack4(T.k[6][0], T.k[6][1], T.k[6][2], T.k[6][3], ks); d.w = q8_pack4(T.k[7][0], T.k[7][1], T.k[7][2], T.k[7][3], ks); dst[1] = d; }
    asm volatile("" ::: "memory");
    { v4u d; d.x = q8_pack4(T.v[0], T.v[1], T.v[2], T.v[3], vs); d.y = q8_pack4(T.v[4], T.v[5], T.v[6], T.v[7], vs); d.z = q8_pack4(T.v[8], T.v[9], T.v[10], T.v[11], vs); d.w = q8_pack4(T.v[12], T.v[13], T.v[14], T.v[15], vs); dst[2] = d; }
    asm volatile("" ::: "memory");
    { v4u d; d.x = q8_pack4(T.v[16], T.v[17], T.v[18], T.v[19], vs); d.y = q8_pack4(T.v[20], T.v[21], T.v[22], T.v[23], vs); d.z = q8_pack4(T.v[24], T.v[25], T.v[26], T.v[27], vs); d.w = q8_pack4(T.v[28], T.v[29], T.v[30], T.v[31], vs); dst[3] = d; }
    v2u sc; sc.x = __float_as_uint(km * (1.0f / 127.0f)); sc.y = __float_as_uint(vm * (1.0f / 127.0f));
    *(v2u*)(q8s + idx * 8) = sc;
}
__device__ __forceinline__ void sb_load_packed(SbPacked& P, const unsigned char* q8, const unsigned char* q8s, size_t idx) {
    const v4u* src = (const v4u*)(q8 + idx * 64);
#pragma unroll
    for (int i = 0; i < 4; ++i) P.d[i] = src[i];
    P.sc = *(const v2u*)(q8s + idx * 8);
}
__device__ __forceinline__ void sb_decode(SbTile& T, const SbPacked& P) {
    const float ks = __uint_as_float(P.sc.x), vs = __uint_as_float(P.sc.y);
#pragma unroll
    for (int i = 0; i < 8; ++i) { float a, b, c, d; q8_unpack4(P.d[i >> 2][i & 3], ks, a, b, c, d); T.k[i] = (f32x4){a, b, c, d}; }
#pragma unroll
    for (int i = 0; i < 8; ++i) { float a, b, c, d; q8_unpack4(P.d[2 + (i >> 2)][i & 3], vs, a, b, c, d); T.v[4 * i] = a; T.v[4 * i + 1] = b; T.v[4 * i + 2] = c; T.v[4 * i + 3] = d; }
}
struct SbBf { v4u k[4], v[4]; };
__device__ __forceinline__ void sb_to_bf(const SbTile& T, SbBf& B, float& km, float& vm) {
    km = 0.f; vm = 0.f;
#pragma unroll
    for (int d0 = 0; d0 < 4; ++d0) { const f32x4 a = T.k[2 * d0], c = T.k[2 * d0 + 1]; v4u w; w.x = pkbf(a.x, a.y); w.y = pkbf(a.z, a.w); w.z = pkbf(c.x, c.y); w.w = pkbf(c.z, c.w); B.k[d0] = w;
        km = fmaxf(km, fmaxf(fmaxf(fmaxf(fabsf(a.x), fabsf(a.y)), fmaxf(fabsf(a.z), fabsf(a.w))), fmaxf(fmaxf(fabsf(c.x), fabsf(c.y)), fmaxf(fabsf(c.z), fabsf(c.w))))); }
#pragma unroll
    for (int i = 0; i < 4; ++i) { const float* vv = &T.v[i * 8]; v4u w; w.x = pkbf(vv[0], vv[1]); w.y = pkbf(vv[2], vv[3]); w.z = pkbf(vv[4], vv[5]); w.w = pkbf(vv[6], vv[7]); B.v[i] = w;
        vm = fmaxf(vm, fmaxf(fmaxf(fmaxf(fabsf(vv[0]), fabsf(vv[1])), fmaxf(fabsf(vv[2]), fabsf(vv[3]))), fmaxf(fmaxf(fabsf(vv[4]), fabsf(vv[5])), fmaxf(fabsf(vv[6]), fabsf(vv[7]))))); }
}
__device__ __forceinline__ unsigned q8_pack_pair(unsigned w0, unsigned w1, float s) {
    return q8_pack4(bflo(w0), bfhi(w0), bflo(w1), bfhi(w1), s);
}
__device__ __forceinline__ void sb_encode_store_bf(const SbBf& B, float km, float vm, unsigned char* q8, unsigned char* q8s, size_t idx) {
    const float ks = km > 0.f ? 127.0f / km : 0.f, vs = vm > 0.f ? 127.0f / vm : 0.f;
    v4u* dst = (v4u*)(q8 + idx * 64);
    { v4u d; d.x = q8_pack_pair(B.k[0].x, B.k[0].y, ks); d.y = q8_pack_pair(B.k[0].z, B.k[0].w, ks); d.z = q8_pack_pair(B.k[1].x, B.k[1].y, ks); d.w = q8_pack_pair(B.k[1].z, B.k[1].w, ks); dst[0] = d; }
    { v4u d; d.x = q8_pack_pair(B.k[2].x, B.k[2].y, ks); d.y = q8_pack_pair(B.k[2].z, B.k[2].w, ks); d.z = q8_pack_pair(B.k[3].x, B.k[3].y, ks); d.w = q8_pack_pair(B.k[3].z, B.k[3].w, ks); dst[1] = d; }
    { v4u d; d.x = q8_pack_pair(B.v[0].x, B.v[0].y, vs); d.y = q8_pack_pair(B.v[0].z, B.v[0].w, vs); d.z = q8_pack_pair(B.v[1].x, B.v[1].y, vs); d.w = q8_pack_pair(B.v[1].z, B.v[1].w, vs); dst[2] = d; }
    { v4u d; d.x = q8_pack_pair(B.v[2].x, B.v[2].y, vs); d.y = q8_pack_pair(B.v[2].z, B.v[2].w, vs); d.z = q8_pack_pair(B.v[3].x, B.v[3].y, vs); d.w = q8_pack_pair(B.v[3].z, B.v[3].w, vs); dst[3] = d; }
    v2u sc; sc.x = __float_as_uint(km * (1.0f / 127.0f)); sc.y = __float_as_uint(vm * (1.0f / 127.0f));
    *(v2u*)(q8s + idx * 8) = sc;
}
__device__ __forceinline__ void sb_compute_bf(const SbBf& B, int t, const bf16x8 (&qf)[4], int tq, int rmask, int wmax, float slope2, bool colok, int h, f32x16 (&o)[2], float& m, float& l) {
    f32x16 S = {0.f, 0.f, 0.f, 0.f, 0.f, 0.f, 0.f, 0.f, 0.f, 0.f, 0.f, 0.f, 0.f, 0.f, 0.f, 0.f};
#pragma unroll
    for (int d0 = 0; d0 < 4; ++d0) S = MFMA32(__builtin_bit_cast(bf16x8, B.k[d0]), qf[d0], S);
    float tm = -INFINITY;
#pragma unroll
    for (int rg = 0; rg < 16; ++rg) { const int idx = sb_idx(t, 8 * (rg >> 2) + 4 * h + (rg & 3)); const int dist = tq - idx;
        const bool ok = colok && (dist >= 0) && ((dist & rmask) == 0) && (dist <= wmax);
        const float sc = ok ? (S[rg] - slope2 * (float)dist) : -INFINITY; S[rg] = sc; tm = fmaxf(tm, sc); }
    tm = fmaxf(tm, __shfl_xor(tm, 32));
    const float mn = fmaxf(m, tm), alpha = __builtin_amdgcn_exp2f(m - mn); m = mn;
    float ls = 0.f;
#pragma unroll
    for (int rg = 0; rg < 16; ++rg) { const float p = __builtin_amdgcn_exp2f(S[rg] - mn); S[rg] = p; ls += p; }
    l = l * alpha + ls;
#pragma unroll
    for (int dh = 0; dh < 2; ++dh)
#pragma unroll
        for (int rg = 0; rg < 16; ++rg) o[dh][rg] *= alpha;
#pragma unroll
    for (int s2 = 0; s2 < 2; ++s2) {
        v4u pw; pw.x = pkbf(S[8 * s2 + 0], S[8 * s2 + 1]); pw.y = pkbf(S[8 * s2 + 2], S[8 * s2 + 3]); pw.z = pkbf(S[8 * s2 + 4], S[8 * s2 + 5]); pw.w = pkbf(S[8 * s2 + 6], S[8 * s2 + 7]);
        const bf16x8 xs = __builtin_bit_cast(bf16x8, pw);
#pragma unroll
        for (int dh = 0; dh < 2; ++dh) o[dh] = MFMA32(__builtin_bit_cast(bf16x8, B.v[s2 * 2 + dh]), xs, o[dh]);
    }
}
#ifndef SB_TS0
#define SB_TS0 24
#endif
#ifndef SB_TS1
#define SB_TS1 31
#endif
template <int MODE>
__device__ __forceinline__ void sample_b_task(Frame& F, int b, int slot, int role) {
    const int TS = MODE == 0 ? SB_TS0 : SB_TS1; const int t0 = role ? TS : 0, t1 = role ? 41 : TS;
    const int lane = F.lane(), rl = lane & 31, h = lane >> 5, g = rl >> 3, s = rl & 7, gq = g > 2 ? 2 : g;
    const bool colok = g < 3; const int r = (gq == 0) ? 1 : (gq == 1) ? 4 : 16; const int rmask = r - 1, wmax = 128 * r, tq = 2048 + s;
    const float slope2 = slope_of(gq * 8 + slot, 24) * LOG2E;
    const size_t qrow = (size_t)(MP + b * 8 + s);
    bf16x8 qf[4];
#pragma unroll
    for (int d0 = 0; d0 < 4; ++d0) qf[d0] = *(const bf16x8*)(F.Q + qrow * 1536 + gq * 512 + slot * 64 + 16 * d0 + 8 * h);
    const float* ok = F.out + O8; const float* ov = F.out + O9;
    f32x16 o[2]; o[0] = (f32x16){0.f, 0.f, 0.f, 0.f, 0.f, 0.f, 0.f, 0.f, 0.f, 0.f, 0.f, 0.f, 0.f, 0.f, 0.f, 0.f}; o[1] = o[0];
    float m = -1e30f, l = 0.f;
    unsigned char* q8 = (unsigned char*)F.CBK; unsigned char* q8s = (unsigned char*)F.CBV; const size_t tbase = ((size_t)(b * 8 + slot) * 41) * 64 + lane;
    if (MODE == 0) {
        SbTile TB; SbBf B; float km, vm;
        sb_load(TB, F.cbk, F.cbv, ok, ov, b, slot, t0, rl, h);
        for (int t = t0; t < t1; ++t) {
            sb_to_bf(TB, B, km, vm);
            if (t + 1 < t1) sb_load(TB, F.cbk, F.cbv, ok, ov, b, slot, t + 1, rl, h);
            sb_encode_store_bf(B, km, vm, q8, q8s, tbase + (size_t)t * 64);
            sb_compute_bf(B, t, qf, tq, rmask, wmax, slope2, colok, h, o, m, l);
        }
    } else {
        SbPacked P0, P1, P2, P3; SbTile T;
        sb_load_packed(P0, q8, q8s, tbase + (size_t)t0 * 64); if (t0 + 1 < t1) sb_load_packed(P1, q8, q8s, tbase + (size_t)(t0 + 1) * 64);
        if (t0 + 2 < t1) sb_load_packed(P2, q8, q8s, tbase + (size_t)(t0 + 2) * 64); if (t0 + 3 < t1) sb_load_packed(P3, q8, q8s, tbase + (size_t)(t0 + 3) * 64);
        for (int t = t0; t < t1; t += 4) {
            sb_decode(T, P0); if (t + 4 < t1) sb_load_packed(P0, q8, q8s, tbase + (size_t)(t + 4) * 64); sb_compute(T, t, qf, tq, rmask, wmax, slope2, colok, h, o, m, l);
            if (t + 1 < t1) { sb_decode(T, P1); if (t + 5 < t1) sb_load_packed(P1, q8, q8s, tbase + (size_t)(t + 5) * 64); sb_compute(T, t + 1, qf, tq, rmask, wmax, slope2, colok, h, o, m, l); }
            if (t + 2 < t1) { sb_decode(T, P2); if (t + 6 < t1) sb_load_packed(P2, q8, q8s, tbase + (size_t)(t + 6) * 64); sb_compute(T, t + 2, qf, tq, rmask, wmax, slope2, colok, h, o, m, l); }
            if (t + 3 < t1) { sb_decode(T, P3); if (t + 7 < t1) sb_load_packed(P3, q8, q8s, tbase + (size_t)(t + 7) * 64); sb_compute(T, t + 3, qf, tq, rmask, wmax, slope2, colok, h, o, m, l); }
        }
    }
    {
        LAS float* st = (LAS float*)(F.lds + (F.wave & 3) * 9216) + lane;
        if (role) {
#pragma unroll
            for (int e = 0; e < 16; ++e) { st[e * 64] = o[0][e]; st[(16 + e) * 64] = o[1][e]; }
            st[32 * 64] = m; st[33 * 64] = l;
        }
        asm volatile("s_waitcnt lgkmcnt(0)" ::: "memory"); __syncthreads();
        if (!role) {
            const float mB = st[32 * 64], lB = st[33 * 64]; const float mn = fmaxf(m, mB), fa = __builtin_amdgcn_exp2f(m - mn), fb = __builtin_amdgcn_exp2f(mB - mn);
            l = l * fa + lB * fb; m = mn;
#pragma unroll
            for (int e = 0; e < 16; ++e) { o[0][e] = o[0][e] * fa + st[e * 64] * fb; o[1][e] = o[1][e] * fa + st[(16 + e) * 64] * fb; }
        }
        asm volatile("s_waitcnt lgkmcnt(0)" ::: "memory"); __syncthreads();
        if (role) return;
    }
    l += __shfl_xor(l, 32);
    const float lse2 = colok ? (m + __builtin_amdgcn_logf(l)) : -1e30f, inv = 1.0f / l;
    const float l0 = __shfl(lse2, s + 32 * h), l1 = __shfl(lse2, 8 + s + 32 * h), l2 = __shfl(lse2, 16 + s + 32 * h);
    const float mx = fmaxf(fmaxf(l0, l1), l2); const float w0 = __builtin_amdgcn_exp2f(l0 - mx), w1 = __builtin_amdgcn_exp2f(l1 - mx), w2 = __builtin_amdgcn_exp2f(l2 - mx); const float iw = 1.0f / (w0 + w1 + w2);
    f32x16 c[2];
#pragma unroll
    for (int dh = 0; dh < 2; ++dh)
#pragma unroll
        for (int rg = 0; rg < 16; ++rg) { const float v = o[dh][rg] * inv; const float a0 = __shfl(v, s + 32 * h), a1 = __shfl(v, 8 + s + 32 * h), a2 = __shfl(v, 16 + s + 32 * h); c[dh][rg] = (w0 * a0 + w1 * a1 + w2 * a2) * iw; }
    if (rl < 8) band_store(F.ATT + qrow * 512 + slot * 64, c, 1.0f, h);
}
template <int UNR> __device__ __forceinline__ void combine_rows(Frame& F, size_t first, size_t nth) {
    const size_t total = (size_t)MP * 64;
    for (size_t it0 = first; it0 < total; it0 += nth * UNR) {
        float l0[UNR], l1[UNR], l2[UNR]; v4u a[UNR], b[UNR], c[UNR];
#pragma unroll
        for (int q = 0; q < UNR; ++q) { const size_t it = it0 + nth * q; const size_t row = it >> 6; const int c8 = (int)(it & 63), slot = c8 >> 3;
            l0[q] = F.LSE[(size_t)0 * M * 8 + row * 8 + slot]; l1[q] = F.LSE[(size_t)1 * M * 8 + row * 8 + slot]; l2[q] = F.LSE[(size_t)2 * M * 8 + row * 8 + slot];
            a[q] = *(const v4u*)(F.OG + ((size_t)0 * M + row) * 512 + c8 * 8); b[q] = *(const v4u*)(F.OG + ((size_t)1 * M + row) * 512 + c8 * 8); c[q] = *(const v4u*)(F.OG + ((size_t)2 * M + row) * 512 + c8 * 8); }
#pragma unroll
        for (int q = 0; q < UNR; ++q) { const size_t it = it0 + nth * q; const size_t row = it >> 6; const int c8 = (int)(it & 63);
            const float mx = fmaxf(fmaxf(l0[q], l1[q]), l2[q]); float w0 = __builtin_amdgcn_exp2f(l0[q] - mx), w1 = __builtin_amdgcn_exp2f(l1[q] - mx), w2 = __builtin_amdgcn_exp2f(l2[q] - mx);
            const float id = 1.0f / (w0 + w1 + w2); w0 *= id; w1 *= id; w2 *= id;
            v4u o;
            o.x = pkbf(w0 * bflo(a[q].x) + w1 * bflo(b[q].x) + w2 * bflo(c[q].x), w0 * bfhi(a[q].x) + w1 * bfhi(b[q].x) + w2 * bfhi(c[q].x));
            o.y = pkbf(w0 * bflo(a[q].y) + w1 * bflo(b[q].y) + w2 * bflo(c[q].y), w0 * bfhi(a[q].y) + w1 * bfhi(b[q].y) + w2 * bfhi(c[q].y));
            o.z = pkbf(w0 * bflo(a[q].z) + w1 * bflo(b[q].z) + w2 * bflo(c[q].z), w0 * bfhi(a[q].z) + w1 * bfhi(b[q].z) + w2 * bfhi(c[q].z));
            o.w = pkbf(w0 * bflo(a[q].w) + w1 * bflo(b[q].w) + w2 * bflo(c[q].w), w0 * bfhi(a[q].w) + w1 * bfhi(b[q].w) + w2 * bfhi(c[q].w));
            *(v4u*)(F.ATT + row * 512 + c8 * 8) = o; }
    }
}
__device__ __forceinline__ void combine_b(Frame& F) { combine_rows<1>(F, (size_t)F.vcu * NTHREADS + F.tid(), (size_t)F.G * NTHREADS); }
__device__ __forceinline__ void final_norm(Frame& F) {
    const int lane = F.lane(); const int gw = F.vcu * NWAVES + F.wave, NGW = F.G * NWAVES;
    const f32x4* gg = (const f32x4*)F.g_final + lane; f32x4 g[4];
#pragma unroll
    for (int j = 0; j < 4; ++j) g[j] = gg[64 * j];
    for (int m0 = gw * 2; m0 < M; m0 += NGW * 2) {
        f32x4 v[2][4]; float rs[2];
#pragma unroll
        for (int q = 0; q < 2; ++q) {
#ifdef RESBF16
            const v2u* xr = (const v2u*)(F.XB + (size_t)(m0 + q) * D) + lane;
#pragma unroll
            for (int j = 0; j < 4; ++j) { const v2u w = xr[64 * j]; v[q][j] = (f32x4){bflo(w.x), bfhi(w.x), bflo(w.y), bfhi(w.y)}; }
#else
            const f32x4* xr = (const f32x4*)(F.X + (size_t)(m0 + q) * D) + lane;
#pragma unroll
            for (int j = 0; j < 4; ++j) v[q][j] = xr[64 * j];
#endif
            rs[q] = rstd_row(F.SS, m0 + q); }
#pragma unroll
        for (int q = 0; q < 2; ++q) { f32x4* yo = (f32x4*)(F.out + (size_t)(m0 + q) * D) + lane;
#pragma unroll
            for (int j = 0; j < 4; ++j) { f32x4 o; o.x = v[q][j].x * rs[q] * g[j].x; o.y = v[q][j].y * rs[q] * g[j].y; o.z = v[q][j].z * rs[q] * g[j].z; o.w = v[q][j].w * rs[q] * g[j].w; yo[64 * j] = o; } }
    }
}
__device__ __forceinline__ void attn_a_phase(Frame& F, int l) {
#ifndef REP_ATTA
#define REP_ATTA 1
#endif
#ifndef REP_ATTBP
#define REP_ATTBP 1
#endif
#ifndef REP_ATTBS
#define REP_ATTBS 1
#endif
    for (int rep = 0; rep < REP_ATTA; ++rep) {
        BandRegs<0> R; BandArgs a, an;
        auto mk = [&](int u, BandArgs& x) { const int qblk = u & 127, kvh = (u >> 7) & 3, b = u >> 9; const int g = F.wave >> 1, head = kvh * 4 + g;
            x.Qp = F.Q + head * 64; x.ldq = 1024; x.Kp = F.KA + kvh * 64; x.Vp = F.VA + kvh * 64; x.ldkv = 256; x.rowbase = b * TP; x.rstride = 1; x.i0 = qblk * 64;
            x.Op = F.ATT + head * 64; x.ldo = 1024; x.lsep = nullptr; x.ldl = 0; x.slope2 = slope_of(head, 16) * LOG2E; x.sink2 = F.sinks_a[l * 16 + head] * LOG2E; };
        int u = F.vcu;
        if (u < NBP * 4 * 128) { const int tid0 = F.tid(); mk(u, a); band_fetch<0>(R, a, tid0); }
        for (; u < NBP * 4 * 128; u += F.G) {
            const int lane = F.lane(), tid = F.wave * 64 + lane;
            band_put<0>(F.lds, R, tid);
            __syncthreads();
            const bool more = (u + F.G < NBP * 4 * 128);
            if (more) { mk(u + F.G, an); band_fetch<0>(R, an, tid); }
            band_unit<0>(F.lds, a, F.wave & 1, lane, F.wave);
            __syncthreads();
            if (more) a = an;
        }
    }
    for (int rep = 0; rep < REP_ATTA; ++rep)
    for (int u = F.vcu; u < NBS * 4; u += F.G) sample_a_unit(F, l, u >> 2, u & 3);
}
__device__ __forceinline__ void attn_b_phase(Frame& F, int half) {
    for (int rep = 0; rep < REP_ATTBP; ++rep) {
        BandRegs<1> R; BandArgs a, an;
        auto mk = [&](int u, BandArgs& x) { const int grp = u >> 9, v = u & 511; const int r = (grp == 0) ? 1 : (grp == 1) ? 4 : 16; const int L = TP / r, nqb = L / 256;
            const int slot = v & 7, w = v >> 3; const int qblk = w % nqb, br = w / nqb, res = br % r, b = br / r;
            x.Qp = F.Q + grp * 512 + slot * 64; x.ldq = 1536; x.Kp = F.KB + slot * 64; x.Vp = F.VB + slot * 64; x.ldkv = 512; x.rowbase = b * TP + res; x.rstride = r; x.i0 = qblk * 256;
            x.Op = F.OG + (size_t)grp * M * 512 + slot * 64; x.ldo = 512; x.lsep = F.LSE + (size_t)grp * M * 8 + slot; x.ldl = 8; x.slope2 = slope_of(grp * 8 + slot, 24) * (float)r * LOG2E; x.sink2 = 0.f; };
        int u = F.vcu;
        if (u < 3 * 512) { const int tid0 = F.tid(); mk(u, a); band_fetch<1>(R, a, tid0); }
        for (; u < 3 * 512; u += F.G) {
            const int lane = F.lane(), tid = F.wave * 64 + lane;
            band_put<1>(F.lds, R, tid);
            __syncthreads();
            const bool more = (u + F.G < 3 * 512);
            if (more) { mk(u + F.G, an); band_fetch<1>(R, an, tid); }
            band_unit<1>(F.lds, a, F.wave, lane, F.wave);
            __syncthreads();
            if (more) a = an;
        }
    }
    if (F.fuse) { asm volatile("s_waitcnt vmcnt(0)" ::: "memory"); __syncthreads(); }
    if (F.fuse && F.wave >= 4) {
        const int lane = F.lane(); const unsigned want = (unsigned)half + 1u;
        if (F.wave == 4 && lane == 0) { XcdBarrier b2; b2.bar = F.ctl + CW_BAR2; b2.x = xb_xcc_id(); b2.st = F.MISC + 8; xcd_barrier_thread(b2); F.MISC[12] = want; }
        while (F.MISC[12] != want) __builtin_amdgcn_s_sleep(2);
        combine_rows<4>(F, (size_t)F.vcu * 256 + (size_t)((F.wave - 4) * 64 + lane), (size_t)F.G * 256);
    }
    for (int rep = 0; rep < REP_ATTBS; ++rep)
    for (int t = F.vcu * 4 + (F.wave & 3); t < NBS * 8; t += F.G * 4) { if (half == 0 || SBFORCE0) sample_b_task<0>(F, t >> 3, t & 7, F.wave >> 2); else sample_b_task<1>(F, t >> 3, t & 7, F.wave >> 2); }
}
}
namespace fk {
typedef float f32x4m __attribute__((ext_vector_type(4)));
#define MFMA16(a, b, c) __builtin_amdgcn_mfma_f32_16x16x32_bf16((a), (b), (c), 0, 0, 0)
constexpr int MINI_KC = 256, MINI_RS = 528;
constexpr int MINI_BUF = 2 * 64 * MINI_RS;
struct MiniRegs { v4u a[4], b[4]; };
__device__ __forceinline__ void mini_fetch(MiniRegs& R, const bf16* A, const bf16* Bt, int K, int row0, int col0, int kc, int tid) {
#pragma unroll
    for (int it = 0; it < 4; ++it) { const int idx = it * NTHREADS + tid, r = idx >> 5, ch = idx & 31;
        R.a[it] = *(const v4u*)(A + (size_t)(row0 + r) * K + kc + ch * 8); R.b[it] = *(const v4u*)(Bt + (size_t)(col0 + r) * K + kc + ch * 8); }
}
__device__ __forceinline__ void mini_put(LAS unsigned char* lds, const MiniRegs& R, int tid) {
#pragma unroll
    for (int it = 0; it < 4; ++it) { const int idx = it * NTHREADS + tid, r = idx >> 5, ch = idx & 31;
        *(LAS v4u*)(lds + r * MINI_RS + ch * 16) = R.a[it]; *(LAS v4u*)(lds + 64 * MINI_RS + r * MINI_RS + ch * 16) = R.b[it]; }
}
__device__ __forceinline__ void mini_gemm(Frame& F, const bf16* A, const bf16* Bt, int K, float* Xo, bf16* XBo, float* SSo) {
    const int lane = F.lane(), tid = F.wave * 64 + lane; const int tile = F.vcu; if (tile >= 256) return;
    const int xq = tile >> 5, jq = tile & 31;
    const int tr = 4 * (xq >> 1) + (jq >> 3), tc = 8 * (xq & 1) + (jq & 7); const int row0 = MP + 64 * tr, col0 = 64 * tc;
    const int nch = K / MINI_KC;
    const int lr = lane & 15, lq = lane >> 4;
    f32x4m acc[4][4];
#pragma unroll
    for (int i = 0; i < 4; ++i)
#pragma unroll
        for (int j = 0; j < 4; ++j) acc[i][j] = (f32x4m){0.f, 0.f, 0.f, 0.f};
    MiniRegs R0, R1;
    mini_fetch(R0, A, Bt, K, row0, col0, 0, tid);
    if (nch > 1) mini_fetch(R1, A, Bt, K, row0, col0, MINI_KC, tid);
    for (int c = 0; c < nch; c += 2) {
        mini_put(F.lds, R0, tid);
        __syncthreads();
        if (c + 2 < nch) mini_fetch(R0, A, Bt, K, row0, col0, (c + 2) * MINI_KC, tid);
        { bf16x8 af[4], bf[4];
#pragma unroll
          for (int i = 0; i < 4; ++i) { af[i] = *(const LAS bf16x8*)(F.lds + (16 * i + lr) * MINI_RS + 64 * F.wave + 16 * lq); bf[i] = *(const LAS bf16x8*)(F.lds + 64 * MINI_RS + (16 * i + lr) * MINI_RS + 64 * F.wave + 16 * lq); }
#pragma unroll
          for (int i = 0; i < 4; ++i)
#pragma unroll
              for (int j = 0; j < 4; ++j) acc[i][j] = MFMA16(af[i], bf[j], acc[i][j]); }
        __syncthreads();
        if (c + 1 < nch) {
            mini_put(F.lds, R1, tid);
            __syncthreads();
            if (c + 3 < nch) mini_fetch(R1, A, Bt, K, row0, col0, (c + 3) * MINI_KC, tid);
            { bf16x8 af[4], bf[4];
#pragma unroll
              for (int i = 0; i < 4; ++i) { af[i] = *(const LAS bf16x8*)(F.lds + (16 * i + lr) * MINI_RS + 64 * F.wave + 16 * lq); bf[i] = *(const LAS bf16x8*)(F.lds + 64 * MINI_RS + (16 * i + lr) * MINI_RS + 64 * F.wave + 16 * lq); }
#pragma unroll
              for (int i = 0; i < 4; ++i)
#pragma unroll
                  for (int j = 0; j < 4; ++j) acc[i][j] = MFMA16(af[i], bf[j], acc[i][j]); }
            __syncthreads();
        }
    }
    LAS float* part = (LAS float*)(F.lds) + F.wave * 4096;
#pragma unroll
    for (int i = 0; i < 4; ++i)
#pragma unroll
        for (int j = 0; j < 4; ++j)
#pragma unroll
            for (int rg = 0; rg < 4; ++rg) part[(16 * i + 4 * lq + rg) * 64 + 16 * j + lr] = acc[i][j][rg];
    __syncthreads();
    const int rr = 8 * F.wave + (lane >> 3), cc = 8 * (lane & 7);
    f32x4m s0 = {0.f, 0.f, 0.f, 0.f}, s1 = s0;
#pragma unroll
    for (int w = 0; w < 8; ++w) { const LAS float* p = (const LAS float*)(F.lds) + w * 4096 + rr * 64 + cc; s0 = s0 + *(const LAS f32x4m*)p; s1 = s1 + *(const LAS f32x4m*)(p + 4); }
    const int r = row0 + rr;
#ifdef RESBF16
    const v4u xb = *(const v4u*)(F.XB + (size_t)r * 1024 + col0 + cc);
    f32x4m x0 = {bflo(xb.x), bfhi(xb.x), bflo(xb.y), bfhi(xb.y)}, x1 = {bflo(xb.z), bfhi(xb.z), bflo(xb.w), bfhi(xb.w)}; x0 = x0 + s0; x1 = x1 + s1;
    v4u wv; wv.x = pkbf(x0[0], x0[1]); wv.y = pkbf(x0[2], x0[3]); wv.z = pkbf(x1[0], x1[1]); wv.w = pkbf(x1[2], x1[3]);
    *(v4u*)(XBo + (size_t)r * 1024 + col0 + cc) = wv;
    x0 = (f32x4m){bflo(wv.x), bfhi(wv.x), bflo(wv.y), bfhi(wv.y)}; x1 = (f32x4m){bflo(wv.z), bfhi(wv.z), bflo(wv.w), bfhi(wv.w)};
#else
    float* xp = F.X + (size_t)r * 1024 + col0 + cc;
    f32x4m x0 = *(const f32x4m*)xp, x1 = *(const f32x4m*)(xp + 4); x0 = x0 + s0; x1 = x1 + s1;
    { float* xo = Xo + (size_t)r * 1024 + col0 + cc; *(f32x4m*)xo = x0; *(f32x4m*)(xo + 4) = x1; }
    v4u wv; wv.x = pkbf(x0[0], x0[1]); wv.y = pkbf(x0[2], x0[3]); wv.z = pkbf(x1[0], x1[1]); wv.w = pkbf(x1[2], x1[3]);
    *(v4u*)(XBo + (size_t)r * 1024 + col0 + cc) = wv;
#endif
    float q = (x0[0] * x0[0] + x0[1] * x0[1]) + (x0[2] * x0[2] + x0[3] * x0[3]) + (x1[0] * x1[0] + x1[1] * x1[1]) + (x1[2] * x1[2] + x1[3] * x1[3]);
    q += __shfl_xor(q, 1); q += __shfl_xor(q, 2); q += __shfl_xor(q, 4);
    if ((lane & 7) == 0) SSo[(size_t)r * 16 + tc] = q;
    __syncthreads();
}
}
namespace fk {
constexpr int NPHASE = 24;
struct Args { const float* in[18]; float* out; unsigned char* ws; int ph_lo, ph_hi; };
__global__ void __launch_bounds__(NTHREADS, 2) yoco_fwd(Args args) {
    extern __shared__ __attribute__((aligned(16))) unsigned char lds[];
    Frame F;
    F.lds = (LAS unsigned char*)lds; F.MISC = (volatile LAS unsigned*)(F.lds + MISC_OFF);
    F.wave = __builtin_amdgcn_readfirstlane((int)threadIdx.x >> 6); F.cps = 0;
    F.G = gridDim.x; { const int bx = blockIdx.x; F.vcu = (F.G % 8 == 0) ? (bx % 8) * (F.G / 8) + bx / 8 : bx; }
    unsigned char* ws = args.ws; F.ctl = (unsigned*)(ws + WS_CTL);
    F.xp = args.in[0]; F.xs = args.in[1]; F.cak = args.in[2]; F.cav = args.in[3]; F.cbk = args.in[4]; F.cbv = args.in[5]; F.g_attn = args.in[6]; F.g_ffn = args.in[7]; F.w_qkv_a = args.in[8];
    F.sinks_a = args.in[9]; F.w_o_a = args.in[10]; F.g_kv = args.in[11]; F.w_kv_s = args.in[12]; F.w_q_b = args.in[13]; F.w_o_b = args.in[14]; F.w_gu = args.in[15]; F.w_dn = args.in[16]; F.g_final = args.in[17];
    F.out = args.out;
    F.WqkvA = (bf16*)(ws + WS_WQKVA); F.WoA = (bf16*)(ws + WS_WOA); F.Wb2 = (bf16*)(ws + WS_WB2); F.Wb3 = (bf16*)(ws + WS_WB3); F.WoB = (bf16*)(ws + WS_WOB); F.Wgu = (bf16*)(ws + WS_WGU); F.Wd = (bf16*)(ws + WS_WD);
    F.X = (float*)(ws + WS_X); F.XB = (bf16*)(ws + WS_XB); F.SS = (float*)(ws + WS_SS);
    F.Q = (bf16*)(ws + WS_Q); F.KA = (bf16*)(ws + WS_KA); F.VA = (bf16*)(ws + WS_VA); F.KB = (bf16*)(ws + WS_KB); F.VB = (bf16*)(ws + WS_VB); F.ATT = (bf16*)(ws + WS_ATT);
    F.OG = (bf16*)(ws + WS_OG); F.LSE = (float*)(ws + WS_LSE); F.H = (bf16*)(ws + WS_H); F.CBK = (bf16*)(ws + WS_CBK); F.CBV = (bf16*)(ws + WS_CBV);
    for (int u = threadIdx.x; u < (LDS_BYTES - RING_BYTES) / 4; u += NTHREADS) ((LAS unsigned*)(F.lds + RING_BYTES))[u] = 0u;
    __syncthreads();
    const int lo = args.ph_lo, hi = args.ph_hi;
    XcdBarrier bar; bar.bar = (unsigned*)(F.ctl + CW_BAR); bar.x = 0; bar.st = nullptr;
    if (hi - lo > 1) bar = xcd_barrier_post((unsigned*)(F.ctl + CW_BAR), F.MISC + 8);
    F.fuse = (hi - lo > 1) ? 1 : 0;
#ifdef NO_ATTN_A
#define ATTN_A(F, l)
#else
#define ATTN_A(F, l) attn_a_phase(F, l)
#endif
#ifdef NO_ATTN_B
#define ATTN_B(F, half)
#else
#define ATTN_B(F, half) attn_b_phase(F, half)
#endif
#ifdef STREAM_FAKE
#define CS_DECL int fake_ = 0; CSTYPE CS{cp_src(F), cp_dst(F), fake_, 1}
#else
#ifndef CSTYPE
#define CSTYPE pg8::CopyStreamT<2>
#endif
#define CS_DECL CSTYPE CS{cp_src(F), cp_dst(F), F.cps, CP_NCHUNKS}
#endif
#ifndef PG8_ALIGN
#define PG8_ALIGN true
#endif
#ifndef REP_MINI
#define REP_MINI 0
#endif
#ifndef REP_RES
#define REP_RES 0
#endif
#define DRY_RES(Aptr, Bptr, Kk) do { for (int rep_ = 0; rep_ < REP_RES; ++rep_) { pg8::Gemm g{(const pg8::bf16_t*)(Aptr), (const pg8::bf16_t*)(Bptr), M, 1024, (Kk)}; pg8::StaticOrder S; S.init(M, 1024, F.G, (int)blockIdx.x); \
        pg8::EpiRes E{F.X, (pg8::bf16_t*)(ws + WS_CBK + 128 * MiB), (float*)(ws + WS_CBK + 200 * MiB), (float*)(ws + WS_CBK)}; pg8::gemm_phase<pg8::EpiRes, pg8::StaticOrder, true, true>(F.lds, g, S, E); } } while (0)
#define IN(k) (lo <= (k) && (k) < hi)
#ifndef REP_BAR
#define REP_BAR 1
#endif
#ifndef TMUL
#define TMUL 1
#endif
#ifdef TSEL
#define STAMP(k) do { if (blockIdx.x == 0 && threadIdx.x == 0) { ((unsigned long long*)(F.ctl + 8192))[(k)] = __builtin_amdgcn_s_memrealtime(); } } while (0)
#else
#define STAMP(k) do { } while (0)
#endif
#if REP_BAR == 2
#define SEAM(k) do { if (IN(k) && IN((k) + 1)) { xcd_barrier(bar); xcd_barrier(bar); } } while (0)
#else
#define SEAM(k) do { if (IN(k) && IN((k) + 1)) xcd_barrier(bar); STAMP((k) + 1); } while (0)
#endif
#define GEMM_PHASE(WIN, EpiT, Aptr, Bptr, Nn, Kk, ...) do { pg8::Gemm g{(const pg8::bf16_t*)(Aptr), (const pg8::bf16_t*)(Bptr), M, (Nn), (Kk)}; pg8::StaticOrder S; S.init(M, (Nn), F.G, (int)blockIdx.x); \
        EpiT E{__VA_ARGS__}; CS_DECL; for (int rep_ = 0; rep_ < (EpiT::REPS); ++rep_) pg8::gemm_phase<EpiT, pg8::StaticOrder, PG8_ALIGN, true, CSTYPE>(F.lds, g, S, E, CS); } while (0)

    #ifndef REP_P0W
#define REP_P0W 1
#endif
    STAMP(0);
#define GEMM_PHASE_NC(WIN, EpiT, Aptr, Bptr, Nn, Kk, ...) do { pg8::Gemm g{(const pg8::bf16_t*)(Aptr), (const pg8::bf16_t*)(Bptr), M, (Nn), (Kk)}; pg8::StaticOrder S; S.init(M, (Nn), F.G, (int)blockIdx.x); \
        EpiT E{__VA_ARGS__}; for (int rep_ = 0; rep_ < (EpiT::REPS); ++rep_) pg8::gemm_phase<EpiT, pg8::StaticOrder, PG8_ALIGN, true>(F.lds, g, S, E); conv_window<WIN>(F, (M / 256) * ((Nn) / 256)); } while (0)
#ifndef CSTYPE_RES
#define CSTYPE_RES pg8::CopyStreamT<2>
#endif
#ifndef CSTYPE_GU
#define CSTYPE_GU pg8::CopyStreamT<2>
#endif
#ifdef GU_NOCOPY
#define GEMM_PHASE_GU GEMM_PHASE_NC
#else
#define GEMM_PHASE_GU(WIN, EpiT, Aptr, Bptr, Nn, Kk, ...) do { pg8::Gemm g{(const pg8::bf16_t*)(Aptr), (const pg8::bf16_t*)(Bptr), M, (Nn), (Kk)}; pg8::StaticOrder S; S.init(M, (Nn), F.G, (int)blockIdx.x); \
        EpiT E{__VA_ARGS__}; CSTYPE_GU CS{cp_src(F), cp_dst(F), F.cps, CP_NCHUNKS}; for (int rep_ = 0; rep_ < (EpiT::REPS); ++rep_) pg8::gemm_phase<EpiT, pg8::StaticOrder, PG8_ALIGN, true, CSTYPE_GU>(F.lds, g, S, E, CS); conv_window<WIN>(F, (M / 256) * ((Nn) / 256)); } while (0)
#endif
#define RES_PHASE(WIN, Aptr, Bptr, Kk) do { { pg8::Gemm g{(const pg8::bf16_t*)(Aptr), (const pg8::bf16_t*)(Bptr), MP, 1024, (Kk)}; pg8::StaticOrder S; S.init(MP, 1024, F.G, (int)blockIdx.x); \
        pg8::EpiRes E{F.X, F.XB, F.SS, F.X}; CSTYPE_RES CS{cp_src(F), cp_dst(F), F.cps, CP_NCHUNKS}; pg8::gemm_phase<pg8::EpiRes, pg8::StaticOrder, true, true, CSTYPE_RES>(F.lds, g, S, E, CS); } for (int rm_ = 0; rm_ < REP_MINI; ++rm_) mini_gemm(F, (Aptr), (Bptr), (Kk), (float*)(ws + WS_CBK), (bf16*)(ws + WS_CBK + 128 * MiB), (float*)(ws + WS_CBK + 200 * MiB)); mini_gemm(F, (Aptr), (Bptr), (Kk), F.X, F.XB, F.SS); } while (0)
    if (IN(0)) { for (int rep = 0; rep < REP_P0W; ++rep) p0_weights(F); STAMP(30); p0_x(F); STAMP(31);
#ifdef STREAM_FAKE
        bg_copy_rows(F, 0, BG_ROWS, F.vcu, F.G);
#endif
    } SEAM(0);
#define A_LAYER(l) do { const int pb = 1 + 5 * (l); \
    if (IN(pb)) GEMM_PHASE_NC(4 * (l) + 0, pg8::EpiProj<0>, F.XB, F.WqkvA + (size_t)(l) * 1536 * 1024, 1536, 1024, F.SS, F.Q, F.KA, F.VA, F.out + O2 + (size_t)(l) * 2 * 128 * 256, F.out + O3 + (size_t)(l) * 2 * 128 * 256, F.out + O6 + (size_t)(l) * 128 * 128 * 256, F.out + O7 + (size_t)(l) * 128 * 128 * 256); \
    SEAM(pb); \
    if (IN(pb + 1)) { ATTN_A(F, (l)); } SEAM(pb + 1); \
    if (IN(pb + 2)) DRY_RES(F.ATT, F.WoA + (size_t)(l) * 1024 * 1024, 1024); if (IN(pb + 2)) RES_PHASE(4 * (l) + 1, F.ATT, F.WoA + (size_t)(l) * 1024 * 1024, 1024); SEAM(pb + 2); \
    if (IN(pb + 3)) GEMM_PHASE_GU(4 * (l) + 2, pg8::EpiGlu, F.XB, F.Wgu + (size_t)(l) * NGU * 1024, NGU, 1024, F.SS, F.H); SEAM(pb + 3); \
    if (IN(pb + 4)) DRY_RES(F.H, F.Wd + (size_t)(l) * 1024 * DFF, DFF); if (IN(pb + 4)) RES_PHASE(4 * (l) + 3, F.H, F.Wd + (size_t)(l) * 1024 * DFF, DFF); SEAM(pb + 4); } while (0)
    A_LAYER(0);
    A_LAYER(1);
    if (IN(11)) GEMM_PHASE_NC(8, pg8::EpiProj<1>, F.XB, F.Wb2, 2560, 1024, F.SS, F.Q, F.KB, F.VB, F.out + O4, F.out + O5, F.out + O8, F.out + O9); SEAM(11);
    if (IN(12)) { ATTN_B(F, 0); } SEAM(12);
    if (!F.fuse) { if (IN(13)) combine_b(F); SEAM(13); } else STAMP(14);
    if (IN(14)) RES_PHASE(9, F.ATT, F.WoB, 512); SEAM(14);
    if (IN(15)) GEMM_PHASE_GU(10, pg8::EpiGlu, F.XB, F.Wgu + (size_t)2 * NGU * 1024, NGU, 1024, F.SS, F.H); SEAM(15);
    if (IN(16)) RES_PHASE(11, F.H, F.Wd + (size_t)2 * 1024 * DFF, DFF); SEAM(16);
    if (IN(17)) GEMM_PHASE_NC(12, pg8::EpiProj<2>, F.XB, F.Wb3, 1536, 1024, F.SS, F.Q, nullptr, nullptr, nullptr, nullptr, nullptr, nullptr); SEAM(17);
    if (IN(18)) { ATTN_B(F, 1); } SEAM(18);
    if (!F.fuse) { if (IN(19)) combine_b(F); SEAM(19); } else STAMP(20);
    if (IN(20)) RES_PHASE(13, F.ATT, F.WoB + (size_t)1024 * 512, 512); SEAM(20);
    if (IN(21)) GEMM_PHASE_GU(14, pg8::EpiGlu, F.XB, F.Wgu + (size_t)3 * NGU * 1024, NGU, 1024, F.SS, F.H); SEAM(21);
    if (IN(22)) RES_PHASE(15, F.H, F.Wd + (size_t)3 * 1024 * DFF, DFF); SEAM(22);
#ifdef STREAM_FAKE
    if (IN(23)) final_norm(F);
#else
    if (IN(23)) { cp_finish(F); final_norm(F); }
#endif
#ifdef TSEL
    asm volatile("s_waitcnt vmcnt(0)" ::: "memory"); __syncthreads();
    if (blockIdx.x == 0 && threadIdx.x == 0) {
        STAMP(24); asm volatile("s_waitcnt vmcnt(0)" ::: "memory");
        const volatile unsigned long long* ts = (const volatile unsigned long long*)(F.ctl + 8192);
        constexpr unsigned long long CATS = 0x4376154321543210ull;
        constexpr unsigned CATS2 = 0x75437615u;
        unsigned long long tsel = 0;
#pragma unroll
        for (int k = 0; k < 24; ++k) { const int c = (k < 16) ? (int)((CATS >> (4 * k)) & 15ull) : (int)((CATS2 >> (4 * (k - 16))) & 15u); if (c == (TSEL)) tsel += ts[k + 1] - ts[k]; }
        if ((TSEL) >= 100) tsel = ts[(TSEL) - 100 + 1] - ts[(TSEL) - 100];
        if ((TSEL) == 11) tsel = ts[24] - ts[23]; if ((TSEL) == 12) tsel = (ts[14] - ts[13]) + (ts[20] - ts[19]); if ((TSEL) == 8) tsel = ts[30] - ts[0]; if ((TSEL) == 9) tsel = ts[31] - ts[30]; if ((TSEL) == 10) tsel = ts[1] - ts[31];
        const unsigned long long t0 = __builtin_amdgcn_s_memrealtime(); while (__builtin_amdgcn_s_memrealtime() - t0 < (TMUL) * tsel) __builtin_amdgcn_s_sleep(8);
    }
#endif
#undef IN
#undef SEAM
#undef GEMM_PHASE
#undef A_LAYER
}
static int g_grid = 0;
static bool setup() {
    if (g_grid) return g_grid > 0;
    int dev = 0, cus = 0;
    if (hipGetDevice(&dev) != hipSuccess || hipDeviceGetAttribute(&cus, hipDeviceAttributeMultiprocessorCount, dev) != hipSuccess) { g_grid = -1; return false; }
    if (hipFuncSetAttribute((const void*)yoco_fwd, hipFuncAttributeMaxDynamicSharedMemorySize, LDS_BYTES) != hipSuccess) { fprintf(stderr, "hipFuncSetAttribute failed\n"); g_grid = -1; return false; }
    int per_cu = 0; (void)hipOccupancyMaxActiveBlocksPerMultiprocessor(&per_cu, (const void*)yoco_fwd, NTHREADS, LDS_BYTES); (void)hipGetLastError();
    if (per_cu < 1) fprintf(stderr, "occupancy query says %d blocks/CU\n", per_cu);
    if (cus < 256) { fprintf(stderr, "this kernel is built for the 256 CUs of an MI355X (found %d): nothing launched\n", cus); g_grid = -1; return false; }
    g_grid = 256;
    return true;
}
static void launch(void* const* d_in, float* out, void* ws, int lo, int hi, hipStream_t st) {
    Args a{}; for (int i = 0; i < 18; ++i) a.in[i] = (const float*)d_in[i]; a.out = out; a.ws = (unsigned char*)ws; a.ph_lo = lo; a.ph_hi = hi;
    hipLaunchKernelGGL(yoco_fwd, dim3(g_grid), dim3(NTHREADS), LDS_BYTES, st, a);
}
}
extern "C" void kernel_launch(void* const* d_in, const int* in_sizes, int n_in, void* d_out, int out_size, void* d_ws, size_t ws_size, hipStream_t stream) {
    if (!fk::setup()) return;
    if (ws_size < fk::WS_END) { fprintf(stderr, "ws too small\n"); return; }
    (void)hipMemsetAsync((char*)d_ws + fk::WS_CTL, 0, fk::CTL_ZERO_BYTES, stream);
    fk::launch(d_in, (float*)d_out, d_ws, 0, fk::NPHASE, stream);
}
```

```cpp
#define RESBF16 1
#include <hip/hip_runtime.h>
#include <cstdint>
#include <cstdio>
#include <cmath>
namespace fk {
constexpr int D = 1024, TP = 8192, NBP = 2, MP = NBP * TP, NBS = 128, SS_ = 8, MS = NBS * SS_, M = MP + MS;
constexpr int DFF = 2816, NGU = 2 * DFF, HD = 64;
constexpr int NWAVES = 8, NTHREADS = 512;
constexpr float LOG2E = 1.4426950408889634f, C2 = 0.125f * LOG2E, EPS = 1e-6f;
constexpr size_t MiB = 1u << 20;
constexpr size_t WS_CTL = 0, CTL_ZERO_BYTES = 1 * MiB;
constexpr size_t WS_WQKVA = 1 * MiB;
constexpr size_t WS_WOA = WS_WQKVA + 6 * MiB;
constexpr size_t WS_WB2 = WS_WOA + 4 * MiB;
constexpr size_t WS_WB3 = WS_WB2 + 5 * MiB;
constexpr size_t WS_WOB = WS_WB3 + 3 * MiB;
constexpr size_t WS_WGU = WS_WOB + 2 * MiB;
constexpr size_t WS_WD = WS_WGU + 44 * MiB;
constexpr size_t WS_X = WS_WD + 22 * MiB;
constexpr size_t WS_XB = WS_X + 68 * MiB;
constexpr size_t WS_SS = WS_XB + 34 * MiB;
constexpr size_t WS_Q = WS_SS + 2 * MiB;
constexpr size_t WS_KA = WS_Q + 51 * MiB;
constexpr size_t WS_VA = WS_KA + 9 * MiB;
constexpr size_t WS_KB = WS_VA + 9 * MiB;
constexpr size_t WS_VB = WS_KB + 17 * MiB;
constexpr size_t WS_ATT = WS_VB + 17 * MiB;
constexpr size_t WS_OG = WS_ATT + 34 * MiB;
constexpr size_t WS_LSE = WS_OG + 51 * MiB;
constexpr size_t WS_H = WS_LSE + 2 * MiB;
constexpr size_t WS_CBK = WS_H + 94 * MiB;
constexpr size_t WS_CBV = WS_CBK + 256 * MiB;
constexpr size_t WS_END = WS_CBV + 256 * MiB;
static_assert(WS_END <= 1024 * MiB, "fast workspace must fit below 1 GiB");
constexpr size_t O0 = 0, O1 = 16777216ull, O2 = O1 + 1048576ull, O3 = O2 + 131072ull, O4 = O3 + 131072ull, O5 = O4 + 2097152ull,
                 O6 = O5 + 2097152ull, O7 = O6 + 8388608ull, O8 = O7 + 8388608ull, O9 = O8 + 134217728ull;
constexpr int CW_BAR = 4096;
constexpr int CW_BAR2 = 12288;
constexpr int RING_BYTES = 131072, MISC_OFF = RING_BYTES + 320, LDS_BYTES = 147456;

#define GAS __attribute__((address_space(1)))
#define LAS __attribute__((address_space(3)))
typedef unsigned short bf16;
typedef unsigned v4u __attribute__((ext_vector_type(4)));
typedef unsigned v2u __attribute__((ext_vector_type(2)));
typedef float f32x4 __attribute__((ext_vector_type(4)));
typedef float f32x16 __attribute__((ext_vector_type(16)));
typedef short bf16x8 __attribute__((ext_vector_type(8)));
typedef short s16x4 __attribute__((ext_vector_type(4)));
typedef float f32x2_t __attribute__((ext_vector_type(2)));
typedef __bf16 bf16x2_t __attribute__((ext_vector_type(2)));
__device__ __forceinline__ unsigned pkbf(float lo, float hi) { f32x2_t v = {lo, hi}; bf16x2_t b = __builtin_convertvector(v, bf16x2_t); return __builtin_bit_cast(unsigned, b); }
__device__ __forceinline__ float bflo(unsigned u) { return __uint_as_float(u << 16); }
__device__ __forceinline__ float bfhi(unsigned u) { return __uint_as_float(u & 0xffff0000u); }
__device__ __forceinline__ float wave_sum(float v) {
#pragma unroll
    for (int o = 1; o < 64; o <<= 1) v += __shfl_xor(v, o);
    return v;
}
__device__ __forceinline__ float rstd_row(const float* ss, int row) {
    const f32x4* p = (const f32x4*)(ss + (size_t)row * 16); const f32x4 a = p[0], b = p[1], c = p[2], d = p[3];
    const float s = ((a.x + a.y) + (a.z + a.w)) + ((b.x + b.y) + (b.z + b.w)) + ((c.x + c.y) + (c.z + c.w)) + ((d.x + d.y) + (d.z + d.w));
    return 1.0f / sqrtf(s * (1.0f / 1024.0f) + EPS);
}
__device__ __forceinline__ float slope_of(int idx, int n) { return exp2f(-8.0f * (float)(idx + 1) / (float)n); }
}
namespace pg8 {
#define PG8_LAS __attribute__((address_space(3)))
typedef unsigned short bf16_t;
typedef short bf16x8 __attribute__((ext_vector_type(8)));
typedef float f32x4 __attribute__((ext_vector_type(4)));
typedef unsigned u32x4 __attribute__((ext_vector_type(4)));
constexpr int BM = 256, BK = 64, HALF = 128, HTB = HALF * BK * 2  , STAGE_BYTES = 8 * HTB, NXCD = 8, WGM = 8;

__host__ __device__ __forceinline__ int lds_byte(int r, int c) { const int st = (r >> 4) * 2 + (c >> 5), rr = r & 15, cc = c & 31, ob = rr * 64 + cc * 2; return st * 1024 + (ob ^ (((ob >> 9) & 1) << 5)); }
__host__ __device__ __forceinline__ void stage_rc(int b, int& R, int& C) { const int st = b / 1024, sb = b % 1024, swz = sb ^ (((sb >> 9) & 1) << 5); R = (st >> 1) * 16 + swz / 64; C = (st & 1) * 32 + (swz % 64) / 2; }
__host__ __device__ __forceinline__ int perm32(int rho) { const int n = rho >> 4, i = rho & 15; return 8 * (i >> 2) + 4 * n + (i & 3); }

struct Unit { int pm, pn; };
struct Gemm { const bf16_t* A; const bf16_t* Bt; int M, N, K; };

struct StaticOrder {
    int nM, nN, nwg, G, c;
    __host__ __device__ void init(int M, int N, int G_, int c_) { nM = M / BM; nN = N / BM; nwg = nM * nN; G = G_; c = c_; }
    __host__ __device__ bool next(int i, Unit& u) const {
        const long L = (long)i * G + c; if (L >= nwg) return false;
        int wgid = (int)L; { const int q = nwg / NXCD, r = nwg % NXCD, xcd = wgid % NXCD, off = wgid / NXCD; wgid = (xcd < r ? xcd * (q + 1) : r * (q + 1) + (xcd - r) * q) + off; }
        const int nig = WGM * nN, gid = wgid / nig, fm = gid * WGM, gsz = (nM - fm) < WGM ? (nM - fm) : WGM;
        u.pm = fm + ((wgid % nig) % gsz); u.pn = (wgid % nig) / gsz; return true;
    }
    __device__ __forceinline__ void a_ready(const Unit&) const {}
    __device__ __forceinline__ void done(const Unit&) const {}
};

__device__ __forceinline__ unsigned cvt_pk_bf16(float lo, float hi) { unsigned r; asm volatile("v_cvt_pk_bf16_f32 %0, %1, %2" : "=v"(r) : "v"(lo), "v"(hi)); return r; }
typedef float f32x2 __attribute__((ext_vector_type(2)));
#ifndef REP_PROJ
#define REP_PROJ 1
#endif
#ifndef REP_GLU
#define REP_GLU 1
#endif
template <int KIND> struct EpiProj {
    static constexpr bool PERM = true, AFTER_DRAIN = false; static constexpr int REPS = REP_PROJ;
    const float* ss; bf16_t* Q; bf16_t* K; bf16_t* V; float* outKp; float* outVp; float* outKs; float* outVs;
    __device__ __forceinline__ void operator()(const f32x4 (&acc)[2][2][4][2], const Unit& u, int wr, int wc, int fr, int fq) const {
        const int row0 = u.pm * BM + wr * 64 + fr; const int pn = u.pn;
        bf16_t* dst; int ld, col; float sc = 1.0f; float* o32p = nullptr; float* o32s = nullptr; int kvw = 0;
        if (KIND == 0) { if (pn < 4) { dst = Q; ld = 1024; col = pn * 256; sc = fk::C2; } else if (pn == 4) { dst = K; ld = 256; col = 0; o32p = outKp; o32s = outKs; kvw = 256; } else { dst = V; ld = 256; col = 0; o32p = outVp; o32s = outVs; kvw = 256; } }
        else if (KIND == 1) { if (pn < 6) { dst = Q; ld = 1536; col = pn * 256; sc = fk::C2; } else if (pn < 8) { dst = K; ld = 512; col = (pn - 6) * 256; o32p = outKp; o32s = outKs; kvw = 512; } else { dst = V; ld = 512; col = (pn - 8) * 256; o32p = outVp; o32s = outVs; kvw = 512; } }
        else { dst = Q; ld = 1536; col = pn * 256; sc = fk::C2; }
        const int cl = col + wc * 32 + 8 * fq;
        float rsv[2][4];
#pragma unroll
        for (int ai = 0; ai < 2; ++ai)
#pragma unroll
            for (int m = 0; m < 4; ++m) { const f32x4 v = *(const f32x4*)(ss + (size_t)(row0 + ai * HALF + m * 16) * 16 + 4 * fq); rsv[ai][m] = (v[0] + v[1]) + (v[2] + v[3]); }
#pragma unroll
        for (int ai = 0; ai < 2; ++ai)
#pragma unroll
            for (int m = 0; m < 4; ++m) { float s = rsv[ai][m]; s += __shfl_xor(s, 16); s += __shfl_xor(s, 32); rsv[ai][m] = (1.0f / sqrtf(s * (1.0f / 1024.0f) + fk::EPS)) * sc; }
#pragma unroll
        for (int ai = 0; ai < 2; ++ai)
#pragma unroll
            for (int m = 0; m < 4; ++m) {
                const int r = row0 + ai * HALF + m * 16; const float rs = rsv[ai][m];
                float* o32 = nullptr;
                if (KIND != 2 && kvw) {
                    if (r < fk::MP) { const int b = r >> 13, t = r & 8191; const int W = (KIND == 0) ? 128 : 2048; if (t >= 8192 - W) o32 = o32p + ((size_t)b * W + (t - (8192 - W))) * kvw; }
                    else { const int rsx = r - fk::MP, b = rsx >> 3, s = rsx & 7; const int W = (KIND == 0) ? 128 : 2048; o32 = o32s + ((size_t)b * W + (W - 8) + s) * kvw; }
                }
#pragma unroll
                for (int bj = 0; bj < 2; ++bj) {
                    const f32x4 v0 = acc[ai][bj][m][0] * rs, v1 = acc[ai][bj][m][1] * rs;
                    u32x4 w; w.x = fk::pkbf(v0[0], v0[1]); w.y = fk::pkbf(v0[2], v0[3]); w.z = fk::pkbf(v1[0], v1[1]); w.w = fk::pkbf(v1[2], v1[3]);
                    *(u32x4*)(dst + (size_t)r * ld + cl + bj * HALF) = w;
                    if (KIND != 2) { if (o32) { *(f32x4*)(o32 + cl + bj * HALF) = v0; *(f32x4*)(o32 + cl + bj * HALF + 4) = v1; } }
                }
            }
    }
};
struct EpiRes {
    static constexpr bool PERM = true, AFTER_DRAIN = false; static constexpr int REPS = 1;
    float* X; bf16_t* XB; float* SS; float* Xo;
    __device__ __forceinline__ void operator()(const f32x4 (&acc)[2][2][4][2], const Unit& u, int wr, int wc, int fr, int fq) const {
        const int row0 = u.pm * BM + wr * 64 + fr; const int cl = u.pn * BM + wc * 32 + 8 * fq;
#ifdef RESBF16
#pragma unroll
        for (int ai = 0; ai < 2; ++ai) {
            u32x4 xin[4][2];
#pragma unroll
            for (int m = 0; m < 4; ++m)
#pragma unroll
                for (int bj = 0; bj < 2; ++bj) xin[m][bj] = *(const u32x4*)(XB + (size_t)(row0 + ai * HALF + m * 16) * 1024 + cl + bj * HALF);
#pragma unroll
            for (int m = 0; m < 4; ++m) {
                const int r = row0 + ai * HALF + m * 16; float q = 0.f;
#pragma unroll
                for (int bj = 0; bj < 2; ++bj) {
                    const u32x4 xb = xin[m][bj];
                    f32x4 x0 = {fk::bflo(xb.x), fk::bfhi(xb.x), fk::bflo(xb.y), fk::bfhi(xb.y)}, x1 = {fk::bflo(xb.z), fk::bfhi(xb.z), fk::bflo(xb.w), fk::bfhi(xb.w)};
                    x0 = x0 + acc[ai][bj][m][0]; x1 = x1 + acc[ai][bj][m][1];
                    u32x4 w; w.x = fk::pkbf(x0[0], x0[1]); w.y = fk::pkbf(x0[2], x0[3]); w.z = fk::pkbf(x1[0], x1[1]); w.w = fk::pkbf(x1[2], x1[3]);
                    *(u32x4*)(XB + (size_t)r * 1024 + cl + bj * HALF) = w;
                    const float r0 = fk::bflo(w.x), r1 = fk::bfhi(w.x), r2 = fk::bflo(w.y), r3 = fk::bfhi(w.y), r4 = fk::bflo(w.z), r5 = fk::bfhi(w.z), r6 = fk::bflo(w.w), r7 = fk::bfhi(w.w);
                    q += (r0 * r0 + r1 * r1) + (r2 * r2 + r3 * r3) + (r4 * r4 + r5 * r5) + (r6 * r6 + r7 * r7);
                }
                q += __shfl_xor(q, 16); q += __shfl_xor(q, 32);
                if (fq == 0) SS[(size_t)r * 16 + u.pn * 4 + wc] = q;
            }
        }
#else
#pragma unroll
        for (int ai = 0; ai < 2; ++ai) {
            f32x4 xin[4][2][2];
#pragma unroll
            for (int m = 0; m < 4; ++m)
#pragma unroll
                for (int bj = 0; bj < 2; ++bj) { const float* xp = X + (size_t)(row0 + ai * HALF + m * 16) * 1024 + cl + bj * HALF; xin[m][bj][0] = *(const f32x4*)xp; xin[m][bj][1] = *(const f32x4*)(xp + 4); }
#pragma unroll
            for (int m = 0; m < 4; ++m) {
                const int r = row0 + ai * HALF + m * 16; float q = 0.f;
#pragma unroll
                for (int bj = 0; bj < 2; ++bj) {
                    const f32x4 x0 = xin[m][bj][0] + acc[ai][bj][m][0], x1 = xin[m][bj][1] + acc[ai][bj][m][1];
                    { float* xo = Xo + (size_t)r * 1024 + cl + bj * HALF; *(f32x4*)xo = x0; *(f32x4*)(xo + 4) = x1; }
                    q += (x0[0] * x0[0] + x0[1] * x0[1]) + (x0[2] * x0[2] + x0[3] * x0[3]) + (x1[0] * x1[0] + x1[1] * x1[1]) + (x1[2] * x1[2] + x1[3] * x1[3]);
                    u32x4 w; w.x = fk::pkbf(x0[0], x0[1]); w.y = fk::pkbf(x0[2], x0[3]); w.z = fk::pkbf(x1[0], x1[1]); w.w = fk::pkbf(x1[2], x1[3]);
                    *(u32x4*)(XB + (size_t)r * 1024 + cl + bj * HALF) = w;
                }
                q += __shfl_xor(q, 16); q += __shfl_xor(q, 32);
                if (fq == 0) SS[(size_t)r * 16 + u.pn * 4 + wc] = q;
            }
        }
#endif
    }
};
struct EpiGlu {
    static constexpr bool PERM = true, AFTER_DRAIN = false; static constexpr int REPS = REP_GLU;
    const float* ss; bf16_t* H;
    __device__ __forceinline__ void operator()(const f32x4 (&acc)[2][2][4][2], const Unit& u, int wr, int wc, int fr, int fq) const {
        const int row0 = u.pm * BM + wr * 64 + fr; const int cl = u.pn * HALF + wc * 32 + 8 * fq;
        float rsv[2][4];
#pragma unroll
        for (int ai = 0; ai < 2; ++ai)
#pragma unroll
            for (int m = 0; m < 4; ++m) { const f32x4 v = *(const f32x4*)(ss + (size_t)(row0 + ai * HALF + m * 16) * 16 + 4 * fq); rsv[ai][m] = (v[0] + v[1]) + (v[2] + v[3]); }
#pragma unroll
        for (int ai = 0; ai < 2; ++ai)
#pragma unroll
            for (int m = 0; m < 4; ++m) { float s = rsv[ai][m]; s += __shfl_xor(s, 16); s += __shfl_xor(s, 32); rsv[ai][m] = 1.0f / sqrtf(s * (1.0f / 1024.0f) + fk::EPS); }
#pragma unroll
        for (int ai = 0; ai < 2; ++ai)
#pragma unroll
            for (int m = 0; m < 4; ++m) {
                const int r = row0 + ai * HALF + m * 16; const float rs = rsv[ai][m];
                float h[8];
#pragma unroll
                for (int n = 0; n < 2; ++n)
#pragma unroll
                    for (int e = 0; e < 4; ++e) { const float g = acc[ai][0][m][n][e] * rs, up = acc[ai][1][m][n][e] * rs;
                        const float sg = __builtin_amdgcn_rcpf(1.0f + __builtin_amdgcn_exp2f(-g * fk::LOG2E)); h[n * 4 + e] = g * sg * up; }
                u32x4 w; w.x = fk::pkbf(h[0], h[1]); w.y = fk::pkbf(h[2], h[3]); w.z = fk::pkbf(h[4], h[5]); w.w = fk::pkbf(h[6], h[7]);
                *(u32x4*)(H + (size_t)r * fk::DFF + cl) = w;
            }
    }
};
struct NoCopy { static constexpr bool ON = false; static constexpr int NP = 0; };
template <int NP_> struct CopyStreamT { static constexpr bool ON = true; static constexpr int NP = NP_; const char* src; char* dst; int& step; int nchunks; };
typedef CopyStreamT<2> CopyStream;
typedef unsigned cp_v4u __attribute__((ext_vector_type(4)));
template <class Epi, class Sched, bool ALIGN_EPI = false, bool SP2 = false, class CP = NoCopy>
__device__ __forceinline__ void gemm_phase(PG8_LAS unsigned char* lds, const Gemm g, const Sched& S, const Epi& E, const CP& cp = CP()) {
    const int tid = threadIdx.x, wid = __builtin_amdgcn_readfirstlane(tid >> 6), lane = tid & 63, wr = wid >> 2, wc = wid & 3, fr = lane & 15, fq = lane >> 4;
    const int K = g.K, nt = K / BK;
    unsigned voffA[2], voffB[2];
#pragma unroll
    for (int i = 0; i < 2; ++i) { int R, C; stage_rc(tid * 16 + i * 8192, R, C); const int Rb = Epi::PERM ? ((R & ~31) + perm32(R & 31)) : R;
        voffA[i] = (unsigned)(R * K + C) * 2u; voffB[i] = (unsigned)(Rb * K + C) * 2u; }
    const size_t kstep = (size_t)(BK * 2);
    const size_t hstep = (size_t)HALF * K * 2;
    const size_t tstep = 2 * hstep;
    const unsigned ldsw = (unsigned)wid * 1024u;
    const int aoff = lds_byte(wr * 64 + fr, fq * 8), boff = lds_byte(wc * 32 + fr, fq * 8);
#define PG8_SA(b, h) (((b) * 2 + (h)) * HTB)
#define PG8_SB(b, h) ((4 + (b) * 2 + (h)) * HTB)
#define PG8_STAGE(bufoff, gbase, voff) do { _Pragma("unroll") for (int _i = 0; _i < 2; ++_i) \
        __builtin_amdgcn_global_load_lds((const unsigned*)((const char*)(gbase) + (voff)[_i]), (PG8_LAS unsigned*)(lds + (bufoff) + ldsw + _i * 8192), 16, 0, 0); } while (0)
#define PG8_LDA(dst, b, h) do { _Pragma("unroll") for (int m = 0; m < 4; ++m) _Pragma("unroll") for (int k = 0; k < 2; ++k) dst[m][k] = *(const PG8_LAS bf16x8*)(lds + PG8_SA(b, h) + aoff + m * 2048 + k * 1024); } while (0)
#define PG8_LDB(dst, b, h) do { _Pragma("unroll") for (int n = 0; n < 2; ++n) _Pragma("unroll") for (int k = 0; k < 2; ++k) dst[n][k] = *(const PG8_LAS bf16x8*)(lds + PG8_SB(b, h) + boff + n * 2048 + k * 1024); } while (0)
#define PG8_MMA(ai, bj, At, Bt) do { __builtin_amdgcn_s_setprio(1); _Pragma("unroll") for (int m = 0; m < 4; ++m) _Pragma("unroll") for (int n = 0; n < 2; ++n) _Pragma("unroll") for (int k = 0; k < 2; ++k) \
        acc[ai][bj][m][n] = __builtin_amdgcn_mfma_f32_16x16x32_bf16(Bt[n][k], At[m][k], acc[ai][bj][m][n], 0, 0, 0); __builtin_amdgcn_s_setprio(0); } while (0)
#define PG8_WAIT_V(n) asm volatile("s_waitcnt vmcnt(" #n ")" ::: "memory")
#define PG8_WAIT_L(n) asm volatile("s_waitcnt lgkmcnt(" #n ")" ::: "memory")
#define PG8_BAR __builtin_amdgcn_s_barrier()
#define PG8_SCHED __builtin_amdgcn_sched_barrier(0)
    Unit cur, nxt; int ui = 0;
    if (!S.next(0, cur)) return;
    int cpstep = 0; unsigned cpoff = 0u; cp_v4u cpA = {0u, 0u, 0u, 0u}, cpB = {0u, 0u, 0u, 0u}, cpC = {0u, 0u, 0u, 0u}, cpD = {0u, 0u, 0u, 0u}; int cA_ = 0, cB_ = 0, cC_ = 0, cD_ = 0;
    if constexpr (CP::ON) { static_assert(SP2, "CopyStream rides the SP2 loop"); cpstep = cp.step; cpoff = (unsigned)wid * 1024u + (unsigned)lane * 16u; }
#define PG8_CPLOAD(buf, c) do { if constexpr (CP::ON) { const char* p_ = cp.src + (size_t)(c) * 8192 + cpoff; asm volatile("global_load_dwordx4 %0, %1, off nt" : "=v"(buf) : "v"(p_) : "memory"); } } while (0)
#define PG8_CPSTORE(buf, c) do { if constexpr (CP::ON) { char* p_ = cp.dst + (size_t)(c) * 8192 + cpoff; \
        if constexpr (CP::NP == 1) asm volatile("s_waitcnt vmcnt(8)\n\tglobal_store_dwordx4 %1, %0, off nt\n\ts_nop 1" : "+v"(buf) : "v"(p_) : "memory"); \
        else if constexpr (CP::NP == 2) asm volatile("s_waitcnt vmcnt(9)\n\tglobal_store_dwordx4 %1, %0, off nt\n\ts_nop 1" : "+v"(buf) : "v"(p_) : "memory"); \
        else if constexpr (CP::NP == 3) asm volatile("s_waitcnt vmcnt(10)\n\tglobal_store_dwordx4 %1, %0, off nt\n\ts_nop 1" : "+v"(buf) : "v"(p_) : "memory"); \
        else asm volatile("s_waitcnt vmcnt(11)\n\tglobal_store_dwordx4 %1, %0, off nt\n\ts_nop 1" : "+v"(buf) : "v"(p_) : "memory"); } } while (0)
#define PG8_CPBEGIN() do { if constexpr (CP::ON) { const int l_ = cp.nchunks - 1; cA_ = cpstep < l_ ? cpstep : l_; cB_ = cpstep + 1 < l_ ? cpstep + 1 : l_; cC_ = cpstep + 2 < l_ ? cpstep + 2 : l_; cD_ = cpstep + 3 < l_ ? cpstep + 3 : l_; cpstep = cpstep + CP::NP < cp.nchunks ? cpstep + CP::NP : cp.nchunks; } } while (0)
#define PG8_WAIT_VL() do { if constexpr (CP::NP == 4) { PG8_WAIT_V(12); } else if constexpr (CP::NP == 3) { PG8_WAIT_V(11); } else if constexpr (CP::NP == 2) { PG8_WAIT_V(10); } else if constexpr (CP::NP == 1) { PG8_WAIT_V(9); } else { PG8_WAIT_V(8); } } while (0)
    f32x4 acc[2][2][4][2];
#pragma unroll
    for (int a = 0; a < 2; ++a)
#pragma unroll
        for (int b = 0; b < 2; ++b)
#pragma unroll
            for (int m = 0; m < 4; ++m)
#pragma unroll
                for (int n = 0; n < 2; ++n) acc[a][b][m][n] = (f32x4){0.f, 0.f, 0.f, 0.f};
    bf16x8 At[4][2], B0[2][2], B1[2][2];
    const char* cA = (const char*)g.A + (size_t)cur.pm * tstep; const char* cB = (const char*)g.Bt + (size_t)cur.pn * tstep;
    S.a_ready(cur);
    if constexpr (SP2) {
        PG8_STAGE(PG8_SB(0, 0), cB, voffB); PG8_STAGE(PG8_SB(0, 1), cB + hstep, voffB); PG8_STAGE(PG8_SA(0, 0), cA, voffA); PG8_STAGE(PG8_SA(0, 1), cA + hstep, voffA);
        if (wr == 1) PG8_BAR;
        PG8_WAIT_V(2); PG8_BAR;
        PG8_STAGE(PG8_SB(1, 0), cB + kstep, voffB); PG8_STAGE(PG8_SA(1, 0), cA + kstep, voffA); PG8_STAGE(PG8_SB(1, 1), cB + hstep + kstep, voffB);
        PG8_WAIT_V(6); PG8_BAR;
    } else {
        PG8_STAGE(PG8_SB(0, 0), cB, voffB); PG8_STAGE(PG8_SA(0, 0), cA, voffA); PG8_STAGE(PG8_SB(0, 1), cB + hstep, voffB); PG8_STAGE(PG8_SA(0, 1), cA + hstep, voffA);
        if (wr == 1) PG8_BAR;
        PG8_WAIT_V(4); PG8_BAR;
        PG8_STAGE(PG8_SB(1, 0), cB + kstep, voffB); PG8_STAGE(PG8_SA(1, 0), cA + kstep, voffA); PG8_STAGE(PG8_SB(1, 1), cB + hstep + kstep, voffB);
        PG8_WAIT_V(6); PG8_BAR;
    }
    for (;;) {
        const bool has_next = S.next(ui + 1, nxt);
        const char* nA = has_next ? (const char*)g.A + (size_t)nxt.pm * tstep : cA; const char* nB = has_next ? (const char*)g.Bt + (size_t)nxt.pn * tstep : cB;
        for (int t = 0; t < nt; t += 2) {
            const bool last = (t == nt - 2);
            const char* a1 = cA + (size_t)(t + 1) * kstep;
            const char* a2 = last ? nA : cA + (size_t)(t + 2) * kstep; const char* b2 = last ? nB : cB + (size_t)(t + 2) * kstep;
            const char* a3 = a2 + kstep; const char* b3 = b2 + kstep;
            if (last && has_next) S.a_ready(nxt);
            if constexpr (SP2) {
            PG8_LDB(B0, 0, 0); PG8_LDB(B1, 0, 1); PG8_SCHED; PG8_LDA(At, 0, 0); PG8_STAGE(PG8_SA(1, 1), a1 + hstep, voffA); PG8_CPBEGIN(); PG8_CPLOAD(cpA, cA_); if constexpr (CP::NP >= 2) { PG8_CPLOAD(cpB, cB_); } if constexpr (CP::NP >= 3) { PG8_CPLOAD(cpC, cC_); } if constexpr (CP::NP >= 4) { PG8_CPLOAD(cpD, cD_); }
            PG8_WAIT_VL(); PG8_WAIT_L(0); PG8_BAR; PG8_MMA(0, 0, At, B0); PG8_MMA(0, 1, At, B1); PG8_BAR; PG8_SCHED;
            PG8_LDA(At, 0, 1); PG8_STAGE(PG8_SB(0, 0), b2, voffB); PG8_STAGE(PG8_SB(0, 1), b2 + hstep, voffB); PG8_STAGE(PG8_SA(0, 0), a2, voffA);
            PG8_WAIT_VL(); PG8_WAIT_L(0); PG8_BAR; PG8_MMA(1, 0, At, B0); PG8_MMA(1, 1, At, B1); PG8_BAR; PG8_SCHED;
            PG8_LDB(B0, 1, 0); PG8_LDB(B1, 1, 1); PG8_SCHED; PG8_LDA(At, 1, 0); PG8_STAGE(PG8_SA(0, 1), a2 + hstep, voffA); PG8_CPSTORE(cpA, cA_); if constexpr (CP::NP >= 2) { PG8_CPSTORE(cpB, cB_); } if constexpr (CP::NP >= 3) { PG8_CPSTORE(cpC, cC_); } if constexpr (CP::NP >= 4) { PG8_CPSTORE(cpD, cD_); }
            PG8_WAIT_VL(); PG8_WAIT_L(0); PG8_BAR; PG8_MMA(0, 0, At, B0); PG8_MMA(0, 1, At, B1); PG8_BAR; PG8_SCHED;
            PG8_LDA(At, 1, 1); PG8_STAGE(PG8_SB(1, 0), b3, voffB); PG8_STAGE(PG8_SB(1, 1), b3 + hstep, voffB); PG8_STAGE(PG8_SA(1, 0), a3, voffA);
            PG8_WAIT_VL(); PG8_WAIT_L(0); PG8_BAR; PG8_MMA(1, 0, At, B0); PG8_MMA(1, 1, At, B1); PG8_BAR; PG8_SCHED;
            } else {
            PG8_LDB(B0, 0, 0); PG8_SCHED; PG8_LDA(At, 0, 0); PG8_STAGE(PG8_SA(1, 1), a1 + hstep, voffA);
            PG8_WAIT_L(8); PG8_BAR; PG8_WAIT_L(0); PG8_MMA(0, 0, At, B0); PG8_BAR; PG8_SCHED;
            PG8_LDB(B1, 0, 1); PG8_STAGE(PG8_SB(0, 0), b2, voffB);
            PG8_BAR; PG8_WAIT_L(0); PG8_MMA(0, 1, At, B1); PG8_BAR;
            PG8_LDA(At, 0, 1); PG8_STAGE(PG8_SA(0, 0), a2, voffA);
            PG8_BAR; PG8_WAIT_L(0); PG8_MMA(1, 0, At, B0); PG8_BAR; PG8_SCHED;
            PG8_STAGE(PG8_SB(0, 1), b2 + hstep, voffB);
            PG8_WAIT_V(6); PG8_BAR; PG8_MMA(1, 1, At, B1); PG8_BAR;
            PG8_LDB(B0, 1, 0); PG8_SCHED; PG8_LDA(At, 1, 0); PG8_STAGE(PG8_SA(0, 1), a2 + hstep, voffA);
            PG8_WAIT_L(8); PG8_BAR; PG8_WAIT_L(0); PG8_MMA(0, 0, At, B0); PG8_BAR; PG8_SCHED;
            PG8_LDB(B1, 1, 1); PG8_STAGE(PG8_SB(1, 0), b3, voffB);
            PG8_BAR; PG8_WAIT_L(0); PG8_MMA(0, 1, At, B1); PG8_BAR;
            PG8_LDA(At, 1, 1); PG8_STAGE(PG8_SA(1, 0), a3, voffA);
            PG8_BAR; PG8_WAIT_L(0); PG8_MMA(1, 0, At, B0); PG8_BAR; PG8_SCHED;
            PG8_STAGE(PG8_SB(1, 1), b3 + hstep, voffB);
            PG8_WAIT_V(6); PG8_BAR; PG8_MMA(1, 1, At, B1); PG8_BAR;
            }
        }
        if constexpr (ALIGN_EPI) { if (wr == 0) PG8_BAR; }
        if constexpr (!Epi::AFTER_DRAIN) { E(acc, cur, wr, wc, fr, fq); S.done(cur); }
        if (!has_next) break;
#pragma unroll
        for (int a = 0; a < 2; ++a)
#pragma unroll
            for (int b = 0; b < 2; ++b)
#pragma unroll
                for (int m = 0; m < 4; ++m)
#pragma unroll
                    for (int n = 0; n < 2; ++n) acc[a][b][m][n] = (f32x4){0.f, 0.f, 0.f, 0.f};
        cur = nxt; cA = nA; cB = nB; ++ui;
        if constexpr (ALIGN_EPI) { if (wr == 1) PG8_BAR; }
    }
    if constexpr (CP::ON) cp.step = cpstep;
    PG8_WAIT_V(0);
    if constexpr (!ALIGN_EPI) { if (wr == 0) PG8_BAR; }
    PG8_BAR;
    if constexpr (Epi::AFTER_DRAIN) { E.fused(acc, cur, wr, wc, fr, fq, lds, wid, lane); S.done(cur); }
#undef PG8_SA
#undef PG8_SB
#undef PG8_STAGE
#undef PG8_LDA
#undef PG8_LDB
#undef PG8_MMA
#undef PG8_WAIT_V
#undef PG8_WAIT_L
#undef PG8_BAR
#undef PG8_SCHED
#undef PG8_CPLOAD
#undef PG8_CPSTORE
#undef PG8_CPBEGIN
#undef PG8_WAIT_VL
}
}
#define XB_TMO      128
#define XB_XCNT(j)  (256  + 64 * (j))
#define XB_XSUB(j)  (1280 + 64 * (j))
#define XB_XGEN(j)  (2304 + 64 * (j))
#define XB_TOP      3328
#define XB_TOPGEN   3392
#define XCD_BAR_WORDS 3456
#define XB_SPIN_CAP (1u << 18)

__device__ __forceinline__ unsigned xb_ld(unsigned* p)              { return __hip_atomic_load(p, __ATOMIC_RELAXED, __HIP_MEMORY_SCOPE_AGENT); }
__device__ __forceinline__ unsigned xb_add(unsigned* p, unsigned v) { return __hip_atomic_fetch_add(p, v, __ATOMIC_RELAXED, __HIP_MEMORY_SCOPE_AGENT); }
__device__ __forceinline__ unsigned xb_xcc_id() { return (unsigned)__builtin_amdgcn_s_getreg((3 << 11) | 20) & 0xFu; }
#define XB_SPIN(cond, bar) do { unsigned _sp = 0; while (cond) { __builtin_amdgcn_s_sleep(1); \
    if ((++_sp & 255u) == 0u) { if (xb_ld(&(bar)[XB_TMO])) break; if (_sp > XB_SPIN_CAP) { atomicAdd(&(bar)[XB_TMO], 1u); break; } } } } while (0)

struct XcdBarrier {
    unsigned* bar; unsigned x;
    volatile LAS unsigned* st;
};

__device__ __forceinline__ XcdBarrier xcd_barrier_post(unsigned* bar, volatile LAS unsigned* st) {
    XcdBarrier b; b.bar = bar; b.x = xb_xcc_id(); b.st = st;
    if (threadIdx.x == 0) (void)xb_add(&bar[XB_XCNT(b.x)], 1u);
    return b;
}
__device__ __forceinline__ void xcd_barrier_complete(unsigned* bar, unsigned x, unsigned& nloc, unsigned& nx) {
    const unsigned G = gridDim.x * gridDim.y * gridDim.z;
    unsigned sum, cnt, mine, sp = 0u;
    for (;;) {
        sum = 0u; cnt = 0u; mine = 0u;
#pragma unroll
        for (unsigned j = 0; j < 16; ++j) { const unsigned c = xb_ld(&bar[XB_XCNT(j)]); sum += c; cnt += (c > 0u) ? 1u : 0u; mine = (j == x) ? c : mine; }
        if (sum == G) break;
        __builtin_amdgcn_s_sleep(1);
        if ((++sp & 255u) == 0u) { if (xb_ld(&bar[XB_TMO])) break; if (sp > XB_SPIN_CAP) { atomicAdd(&bar[XB_TMO], 1u); break; } }
    }
    nloc = mine > 0u ? mine : 1u; nx = cnt > 0u ? cnt : 1u;
}

__device__ __forceinline__ void xcd_barrier_thread(const XcdBarrier& b) {
    {
        unsigned* bar = b.bar;
        __builtin_amdgcn_s_waitcnt(0);
        unsigned nloc = b.st[0], nx = b.st[1];
        if (nloc == 0u) { xcd_barrier_complete(bar, b.x, nloc, nx); b.st[0] = nloc; b.st[1] = nx; }
        const unsigned old = xb_add(&bar[XB_XSUB(b.x)], 1u);
        const unsigned gen = old / nloc;
        if (old + 1u == (gen + 1u) * nloc) {
            __builtin_amdgcn_fence(__ATOMIC_RELEASE, "agent");
            asm volatile("s_waitcnt vmcnt(0)" ::: "memory");
            const unsigned og = xb_add(&bar[XB_TOP], 1u);
            const unsigned tg = og / nx;
            if (og + 1u == (tg + 1u) * nx) xb_add(&bar[XB_TOPGEN], 1u);
            else XB_SPIN(xb_ld(&bar[XB_TOPGEN]) == tg, bar);
            __builtin_amdgcn_fence(__ATOMIC_ACQUIRE, "agent");
            xb_add(&bar[XB_XGEN(b.x)], 1u);
            asm volatile("s_waitcnt vmcnt(0)" ::: "memory");
        } else {
            XB_SPIN(xb_ld(&bar[XB_XGEN(b.x)]) == gen, bar);
            __builtin_amdgcn_fence(__ATOMIC_ACQUIRE, "agent");
            asm volatile("s_waitcnt vmcnt(0)" ::: "memory");
        }
    }
}
__device__ __forceinline__ void xcd_barrier(const XcdBarrier& b) {
    asm volatile("s_waitcnt vmcnt(0)" ::: "memory");
    __syncthreads();
    if (threadIdx.x == 0) xcd_barrier_thread(b);
    __syncthreads();
}
namespace fk {
struct Frame {
    LAS unsigned char* lds; volatile LAS unsigned* MISC; unsigned* ctl;
    int wave, vcu, G;
    int fuse;
    int cps;
    __device__ __forceinline__ int lane() const { int l; asm volatile("v_mbcnt_lo_u32_b32 %0, -1, 0\n\tv_mbcnt_hi_u32_b32 %0, -1, %0" : "=v"(l)); return l; }
    __device__ __forceinline__ int tid() const { return wave * 64 + lane(); }
    const float *xp, *xs, *cak, *cav, *cbk, *cbv, *g_attn, *g_ffn, *w_qkv_a, *sinks_a, *w_o_a, *g_kv, *w_kv_s, *w_q_b, *w_o_b, *w_gu, *w_dn, *g_final;
    float* out;
    bf16 *WqkvA, *WoA, *Wb2, *Wb3, *WoB, *Wgu, *Wd;
    float* X; bf16* XB; float* SS;
    bf16 *Q, *KA, *VA, *KB, *VB, *ATT, *OG, *H, *CBK, *CBV; float* LSE;
};
__device__ __forceinline__ void transpose_item(const float* W, int ldw, int K, const float* gain, bf16* WT, int n0dst, int csrc, int k0, LAS float* scr, int lane) {
    f32x4 v[16];
#pragma unroll
    for (int i = 0; i < 16; ++i) { const int kk = 2 * i + (lane >> 5); v[i] = *(const f32x4*)(W + (size_t)(k0 + kk) * ldw + csrc + 4 * (lane & 31)); }
#pragma unroll
    for (int i = 0; i < 16; ++i) { const int kk = 2 * i + (lane >> 5); f32x4 x = v[i]; if (gain) { const float g = gain[k0 + kk]; x = x * g; } *(LAS f32x4*)(scr + kk * 128 + 4 * (lane & 31)) = x; }
    asm volatile("s_waitcnt lgkmcnt(0)" ::: "memory");
    const int kc = lane & 3;
#pragma unroll
    for (int j = 0; j < 8; ++j) { const int n = (lane >> 2) + 16 * j; const LAS float* s = scr + (8 * kc) * 128 + n;
        v4u o; o.x = pkbf(s[0 * 128], s[1 * 128]); o.y = pkbf(s[2 * 128], s[3 * 128]); o.z = pkbf(s[4 * 128], s[5 * 128]); o.w = pkbf(s[6 * 128], s[7 * 128]);
        *(v4u*)(WT + (size_t)(n0dst + n) * K + k0 + 8 * kc) = o; }
    asm volatile("s_waitcnt lgkmcnt(0)" ::: "memory");
}
template <bool GU> __device__ __forceinline__ void transpose_matrix(const float* W, int K, int N, const float* gain, bf16* WT, int rowoff, LAS float* scr, int lane, int item) {
    const int nblk = N / 128, kb = item / nblk, nb = item % nblk; const int n0 = nb * 128; int csrc = n0;
    if (GU) { const int pn = n0 >> 8, j = n0 & 255; csrc = (j < 128) ? (128 * pn) : (DFF + 128 * pn); }
    transpose_item(W, N, K, gain, WT, rowoff + n0, csrc, kb * 32, scr, lane);
}
constexpr int CV_QKV = (1024 / 32) * (1536 / 128), CV_SQ = (1024 / 32) * (1024 / 128), CV_OB = (512 / 32) * (1024 / 128), CV_GU = (1024 / 32) * (NGU / 128), CV_DN = (DFF / 32) * (1024 / 128);
constexpr int CV_A = CV_QKV + CV_SQ + CV_GU + CV_DN, CV_B0 = CV_QKV + CV_SQ + CV_OB + CV_GU + CV_DN, CV_B1 = CV_QKV + CV_OB + CV_GU + CV_DN, CV_ALL = 2 * CV_A + CV_B0 + CV_B1;
static_assert(CV_ALL == 11008, "conversion item count");
constexpr int CONV_P0 = 1200;
constexpr int CONV_WIN[17] = {1200, 3200, 3200, 3900, 3900, 5900, 5900, 6600, 6600, 8300, 8300, 9000, 9000, 10400, 10400, 11008, 11008};
__device__ __forceinline__ void conv_item(Frame& F, LAS float* scr, int lane, int it) {
    int r = it;
    if (r < 2 * CV_A) { const int l = r / CV_A; r -= l * CV_A;
        if (r < CV_QKV) { transpose_matrix<false>(F.w_qkv_a + (size_t)l * 1024 * 1536, 1024, 1536, F.g_attn + l * 1024, F.WqkvA + (size_t)l * 1536 * 1024, 0, scr, lane, r); return; } r -= CV_QKV;
        if (r < CV_SQ) { transpose_matrix<false>(F.w_o_a + (size_t)l * 1024 * 1024, 1024, 1024, nullptr, F.WoA + (size_t)l * 1024 * 1024, 0, scr, lane, r); return; } r -= CV_SQ;
        if (r < CV_GU) { transpose_matrix<true>(F.w_gu + (size_t)l * 1024 * NGU, 1024, NGU, F.g_ffn + l * 1024, F.Wgu + (size_t)l * NGU * 1024, 0, scr, lane, r); return; } r -= CV_GU;
        transpose_matrix<false>(F.w_dn + (size_t)l * DFF * 1024, DFF, 1024, nullptr, F.Wd + (size_t)l * 1024 * DFF, 0, scr, lane, r); return; }
    r -= 2 * CV_A;
    if (r < CV_B0) {
        if (r < CV_QKV) { transpose_matrix<false>(F.w_q_b, 1024, 1536, F.g_attn + 2 * 1024, F.Wb2, 0, scr, lane, r); return; } r -= CV_QKV;
        if (r < CV_SQ) { transpose_matrix<false>(F.w_kv_s, 1024, 1024, F.g_kv, F.Wb2, 1536, scr, lane, r); return; } r -= CV_SQ;
        if (r < CV_OB) { transpose_matrix<false>(F.w_o_b, 512, 1024, nullptr, F.WoB, 0, scr, lane, r); return; } r -= CV_OB;
        if (r < CV_GU) { transpose_matrix<true>(F.w_gu + (size_t)2 * 1024 * NGU, 1024, NGU, F.g_ffn + 2 * 1024, F.Wgu + (size_t)2 * NGU * 1024, 0, scr, lane, r); return; } r -= CV_GU;
        transpose_matrix<false>(F.w_dn + (size_t)2 * DFF * 1024, DFF, 1024, nullptr, F.Wd + (size_t)2 * 1024 * DFF, 0, scr, lane, r); return; }
    r -= CV_B0;
    if (r < CV_QKV) { transpose_matrix<false>(F.w_q_b + (size_t)1024 * 1536, 1024, 1536, F.g_attn + 3 * 1024, F.Wb3, 0, scr, lane, r); return; } r -= CV_QKV;
    if (r < CV_OB) { transpose_matrix<false>(F.w_o_b + (size_t)512 * 1024, 512, 1024, nullptr, F.WoB + (size_t)1024 * 512, 0, scr, lane, r); return; } r -= CV_OB;
    if (r < CV_GU) { transpose_matrix<true>(F.w_gu + (size_t)3 * 1024 * NGU, 1024, NGU, F.g_ffn + 3 * 1024, F.Wgu + (size_t)3 * NGU * 1024, 0, scr, lane, r); return; } r -= CV_GU;
    transpose_matrix<false>(F.w_dn + (size_t)3 * DFF * 1024, DFF, 1024, nullptr, F.Wd + (size_t)3 * 1024 * DFF, 0, scr, lane, r);
}
__device__ __forceinline__ void conv_items(Frame& F, int lo, int hi, int j, int n, int w0 = 0, int nw = NWAVES) {
    LAS float* scr = (LAS float*)(F.lds + F.wave * 16384); const int lane = F.lane();
    for (int it = lo + j * nw + (F.wave - w0); it < hi; it += n * nw) conv_item(F, scr, lane, it);
}
#ifndef P0_XW
#define P0_XW 6
#endif
__device__ __forceinline__ void p0_weights(Frame& F) { if (F.wave >= P0_XW) conv_items(F, 0, CONV_P0, F.vcu, F.G, P0_XW, NWAVES - P0_XW); }
template <int WIN> __device__ __forceinline__ void conv_window(Frame& F, int nwg) {
    const int rem = nwg % F.G; if (rem == 0) return; const int c = (int)blockIdx.x; if (c < rem) return;
    if (CONV_WIN[WIN] < CONV_WIN[WIN + 1]) conv_items(F, CONV_WIN[WIN], CONV_WIN[WIN + 1], c - rem, F.G - rem);
}
__device__ __forceinline__ void p0_x(Frame& F) {
    if (F.wave >= P0_XW) return;
    const int lane = F.lane(); const int gw = F.vcu * P0_XW + F.wave, NGW = F.G * P0_XW;
    for (int m0 = gw * 2; m0 < M; m0 += NGW * 2) {
        f32x4 v[2][4]; float s[2];
#pragma unroll
        for (int q = 0; q < 2; ++q) { const int m = m0 + q; const float* src = (m < MP) ? F.xp + (size_t)m * D : F.xs + (size_t)(m - MP) * D; const f32x4* xr = (const f32x4*)src + lane;
#pragma unroll
            for (int j = 0; j < 4; ++j) v[q][j] = xr[64 * j]; }
#ifdef RESBF16
#pragma unroll
        for (int q = 0; q < 2; ++q) { float a = 0.f; const int m = m0 + q; v2u* bo = (v2u*)(F.XB + (size_t)m * D) + lane;
#pragma unroll
            for (int j = 0; j < 4; ++j) { v2u w; w.x = pkbf(v[q][j].x, v[q][j].y); w.y = pkbf(v[q][j].z, v[q][j].w); bo[64 * j] = w;
                const float r0 = bflo(w.x), r1 = bfhi(w.x), r2 = bflo(w.y), r3 = bfhi(w.y); a += (r0 * r0 + r1 * r1) + (r2 * r2 + r3 * r3); }
            s[q] = wave_sum(a); if (lane < 16) F.SS[(size_t)m * 16 + lane] = (lane == 0) ? s[q] : 0.f; }
#else
#pragma unroll
        for (int q = 0; q < 2; ++q) { float a = 0.f;
#pragma unroll
            for (int j = 0; j < 4; ++j) a += (v[q][j].x * v[q][j].x + v[q][j].y * v[q][j].y) + (v[q][j].z * v[q][j].z + v[q][j].w * v[q][j].w);
            s[q] = wave_sum(a); }
#pragma unroll
        for (int q = 0; q < 2; ++q) { const int m = m0 + q; f32x4* xo = (f32x4*)(F.X + (size_t)m * D) + lane; v2u* bo = (v2u*)(F.XB + (size_t)m * D) + lane;
#pragma unroll
            for (int j = 0; j < 4; ++j) { xo[64 * j] = v[q][j]; v2u w; w.x = pkbf(v[q][j].x, v[q][j].y); w.y = pkbf(v[q][j].z, v[q][j].w); bo[64 * j] = w; }
            if (lane < 16) F.SS[(size_t)m * 16 + lane] = (lane == 0) ? s[q] : 0.f; }
#endif
    }
}
constexpr int BG_ROWS = 2 * NBS * 2040;
constexpr int BG_NWIN = 16;
constexpr int BG_W[BG_NWIN + 1] = {124, 0, 48, 0, 124, 0, 48, 0, 105, 0, 48, 0, 124, 0, 48, 0, 4100};
constexpr int bg_wsum(int n) { int s = 0; for (int i = 0; i < n; ++i) s += BG_W[i]; return s; }
constexpr int bg_row0(int w) { return (int)((long long)BG_ROWS * bg_wsum(w) / bg_wsum(BG_NWIN + 1)); }
__device__ __forceinline__ void bg_copy_rows(Frame& F, int r0, int r1, int j, int n) {
    const int lane = F.lane(); const int nwv = n * NWAVES;
    for (int r = r0 + (j * NWAVES + F.wave) * 4; r < r1; r += nwv * 4) {
        f32x4 a[4], c[4]; float* dst[4];
#pragma unroll
        for (int q = 0; q < 4; ++q) { const int rid = (r + q < r1) ? (r + q) : (r1 - 1); const int kv = rid / (NBS * 2040), rem = rid - kv * (NBS * 2040), b = rem / 2040, i = rem - b * 2040;
            const float* src = (kv ? F.cbv : F.cbk) + ((size_t)b * 2048 + i + 8) * 512; dst[q] = F.out + (kv ? O9 : O8) + ((size_t)b * 2048 + i) * 512;
            a[q] = ((const f32x4*)src)[lane]; c[q] = ((const f32x4*)src)[lane + 64]; }
#pragma unroll
        for (int q = 0; q < 4; ++q) { ((f32x4*)dst[q])[lane] = a[q]; ((f32x4*)dst[q])[lane + 64] = c[q]; }
    }
}
template <int WIN> __device__ __forceinline__ void bg_window(Frame& F, int nwg) {
    const int rem = nwg % F.G; if (rem == 0) return; const int c = (int)blockIdx.x; if (c < rem) return;
#ifndef REP_BG
#define REP_BG 1
#endif
    for (int rep = 0; rep < REP_BG; ++rep) bg_copy_rows(F, bg_row0(WIN), bg_row0(WIN + 1), c - rem, F.G - rem);
}
constexpr int CP_NCHUNKS = 510;
__device__ __forceinline__ const char* cp_src(Frame& F) { const int c = (int)blockIdx.x, kv = (c >> 7) & 1, b = c & 127; return (const char*)((kv ? F.cbv : F.cbk) + ((size_t)b * 2048 + 8) * 512); }
__device__ __forceinline__ char* cp_dst(Frame& F) { const int c = (int)blockIdx.x, kv = (c >> 7) & 1, b = c & 127; return (char*)(F.out + (kv ? O9 : O8) + (size_t)b * 2048 * 512); }
__device__ __forceinline__ void cp_finish(Frame& F) {
    const int lane = F.lane(); const unsigned off = (unsigned)F.wave * 1024u + (unsigned)lane * 16u; const char* s = cp_src(F); char* d = cp_dst(F);
    for (int c = F.cps; c < CP_NCHUNKS; c += 4) { v4u v[4];
#pragma unroll
        for (int q = 0; q < 4; ++q) { const int cc = (c + q < CP_NCHUNKS) ? c + q : CP_NCHUNKS - 1; v[q] = *(const v4u*)(s + (size_t)cc * 8192 + off); }
#pragma unroll
        for (int q = 0; q < 4; ++q) { const int cc = (c + q < CP_NCHUNKS) ? c + q : CP_NCHUNKS - 1; *(v4u*)(d + (size_t)cc * 8192 + off) = v[q]; } }
    F.cps = CP_NCHUNKS;
}
#define MFMA32(a, b, c) __builtin_amdgcn_mfma_f32_32x32x16_bf16((a), (b), (c), 0, 0, 0)
__device__ __forceinline__ int crow(int reg, int h) { return (reg & 3) + 8 * (reg >> 2) + 4 * h; }
struct BandArgs {
    const bf16* Qp; int ldq;
    const bf16* Kp; const bf16* Vp; int ldkv;
    int rowbase; int rstride;
    int i0;
    bf16* Op; int ldo;
    float* lsep; int ldl;
    float slope2; float sink2;
};
template <int MODE> struct BandRegs { static constexpr int QB = (MODE == 0) ? 64 : 256, NK = QB + 128, NIT = NK * 8 / NTHREADS; v4u k[NIT], v[NIT]; };
template <int MODE> __device__ __forceinline__ void band_fetch(BandRegs<MODE>& R, const BandArgs& a, int tid) {
    constexpr int NIT = BandRegs<MODE>::NIT;
#pragma unroll
    for (int it = 0; it < NIT; ++it) {
        const int c = it * NTHREADS + tid, kk = c >> 3, ch = c & 7; const int i = a.i0 - 128 + kk;
        R.k[it] = (v4u){0u, 0u, 0u, 0u}; R.v[it] = (v4u){0u, 0u, 0u, 0u};
        if (i >= 0) { const size_t row = (size_t)(a.rowbase + i * a.rstride); R.k[it] = *(const v4u*)(a.Kp + row * a.ldkv + ch * 8); R.v[it] = *(const v4u*)(a.Vp + row * a.ldkv + ch * 8); }
    }
}
template <int MODE> __device__ __forceinline__ void band_put(LAS unsigned char* lds, const BandRegs<MODE>& R, int tid) {
    constexpr int NK = BandRegs<MODE>::NK, NIT = BandRegs<MODE>::NIT, VSTR = 2 * NK + 8;
    LAS unsigned char* Kl = lds; LAS unsigned char* Vt = lds + NK * 144;
#pragma unroll
    for (int it = 0; it < NIT; ++it) {
        const int c = it * NTHREADS + tid, kk = c >> 3, ch = c & 7; const v4u kq = R.k[it], vq = R.v[it];
        *(LAS v4u*)(Kl + kk * 144 + ch * 16) = kq;
        LAS unsigned char* vt = Vt + (ch * 8) * VSTR + kk * 2;
        *(LAS unsigned short*)(vt) = (unsigned short)(vq.x & 0xffffu); *(LAS unsigned short*)(vt + 1 * VSTR) = (unsigned short)(vq.x >> 16);
        *(LAS unsigned short*)(vt + 2 * VSTR) = (unsigned short)(vq.y & 0xffffu); *(LAS unsigned short*)(vt + 3 * VSTR) = (unsigned short)(vq.y >> 16);
        *(LAS unsigned short*)(vt + 4 * VSTR) = (unsigned short)(vq.z & 0xffffu); *(LAS unsigned short*)(vt + 5 * VSTR) = (unsigned short)(vq.z >> 16);
        *(LAS unsigned short*)(vt + 6 * VSTR) = (unsigned short)(vq.w & 0xffffu); *(LAS unsigned short*)(vt + 7 * VSTR) = (unsigned short)(vq.w >> 16);
    }
}
template <int NK, int MAXD, bool SINK>
__device__ __forceinline__ void band_compute(LAS unsigned char* Kl, LAS unsigned char* Vt, int kk0, const bf16x8 (&qf)[4], int distbase, int keyidx0, float slope2, float sink2, int lane, f32x16 (&o)[2], float& m_out, float& l_out) {
    constexpr int VSTR = 2 * NK + 8; const int rl = lane & 31, h = lane >> 5;
    f32x16 S[5];
#pragma unroll
    for (int kt = 0; kt < 5; ++kt) {
        f32x16 accs = {0.f, 0.f, 0.f, 0.f, 0.f, 0.f, 0.f, 0.f, 0.f, 0.f, 0.f, 0.f, 0.f, 0.f, 0.f, 0.f};
#pragma unroll
        for (int d0 = 0; d0 < 4; ++d0) { const bf16x8 kf = *(const LAS bf16x8*)(Kl + (kk0 + 32 * kt + rl) * 144 + (16 * d0 + 8 * h) * 2); accs = MFMA32(kf, qf[d0], accs); }
        S[kt] = accs;
    }
    float mx = -INFINITY;
    const int d0i = distbase + rl - 4 * h, qi = distbase + rl + keyidx0; const unsigned lim = (unsigned)(qi < MAXD ? qi : MAXD); const float nsl = -slope2;
#pragma unroll
    for (int kt = 0; kt < 5; ++kt)
#pragma unroll
        for (int rg = 0; rg < 16; ++rg) { const int dist = d0i - (32 * kt + (rg & 3) + 8 * (rg >> 2)); const bool ok = (unsigned)dist <= lim;
            const float s = ok ? __builtin_fmaf(nsl, (float)dist, S[kt][rg]) : -INFINITY; S[kt][rg] = s; mx = fmaxf(mx, s); }
    mx = fmaxf(mx, __shfl_xor(mx, 32)); if (SINK) mx = fmaxf(mx, sink2);
    float l = 0.f;
#pragma unroll
    for (int kt = 0; kt < 5; ++kt)
#pragma unroll
        for (int rg = 0; rg < 16; ++rg) { const float p = __builtin_amdgcn_exp2f(S[kt][rg] - mx); S[kt][rg] = p; l += p; }
    l += __shfl_xor(l, 32); if (SINK) l += __builtin_amdgcn_exp2f(sink2 - mx);
    o[0] = (f32x16){0.f, 0.f, 0.f, 0.f, 0.f, 0.f, 0.f, 0.f, 0.f, 0.f, 0.f, 0.f, 0.f, 0.f, 0.f, 0.f}; o[1] = o[0];
#pragma unroll
    for (int kt = 0; kt < 5; ++kt)
#pragma unroll
        for (int s2 = 0; s2 < 2; ++s2) {
            v4u pw; pw.x = pkbf(S[kt][8 * s2 + 0], S[kt][8 * s2 + 1]); pw.y = pkbf(S[kt][8 * s2 + 2], S[kt][8 * s2 + 3]); pw.z = pkbf(S[kt][8 * s2 + 4], S[kt][8 * s2 + 5]); pw.w = pkbf(S[kt][8 * s2 + 6], S[kt][8 * s2 + 7]);
            const bf16x8 xs = __builtin_bit_cast(bf16x8, pw);
#pragma unroll
            for (int dh = 0; dh < 2; ++dh) {
                const LAS unsigned char* vp = Vt + (32 * dh + rl) * VSTR + (kk0 + 32 * kt + 16 * s2 + 4 * h) * 2;
                const s16x4 lo = *(const LAS s16x4*)vp, hi = *(const LAS s16x4*)(vp + 16);
                const bf16x8 va = __builtin_shufflevector(lo, hi, 0, 1, 2, 3, 4, 5, 6, 7);
                o[dh] = MFMA32(va, xs, o[dh]);
            }
        }
    m_out = mx; l_out = l;
}
__device__ __forceinline__ void band_store(bf16* orow, const f32x16 (&o)[2], float inv, int h) {
#pragma unroll
    for (int dh = 0; dh < 2; ++dh)
#pragma unroll
        for (int g4 = 0; g4 < 4; ++g4) { v2u w; w.x = pkbf(o[dh][4 * g4 + 0] * inv, o[dh][4 * g4 + 1] * inv); w.y = pkbf(o[dh][4 * g4 + 2] * inv, o[dh][4 * g4 + 3] * inv);
            *(v2u*)(orow + 32 * dh + 8 * g4 + 4 * h) = w; }
}
__device__ __forceinline__ void band_store_lds(LAS unsigned char* ost, const f32x16 (&o)[2], float inv, int lane, bf16* Op, size_t row0, int rstride, int ldo) {
    const int rl = lane & 31, h = lane >> 5;
#pragma unroll
    for (int p = 0; p < 2; ++p) {
        if ((rl >> 4) == p) {
#pragma unroll
            for (int dh = 0; dh < 2; ++dh)
#pragma unroll
                for (int g4 = 0; g4 < 4; ++g4) { v2u w; w.x = pkbf(o[dh][4 * g4 + 0] * inv, o[dh][4 * g4 + 1] * inv); w.y = pkbf(o[dh][4 * g4 + 2] * inv, o[dh][4 * g4 + 3] * inv);
                    *(LAS v2u*)(ost + (rl & 15) * 144 + (32 * dh + 8 * g4 + 4 * h) * 2) = w; }
        }
        asm volatile("s_waitcnt lgkmcnt(0)" ::: "memory");
#pragma unroll
        for (int j = 0; j < 2; ++j) { const int idx = lane + 64 * j, row = idx >> 3, c8 = idx & 7; const v4u v = *(const LAS v4u*)(ost + row * 144 + c8 * 16);
            *(v4u*)(Op + (row0 + (size_t)(16 * p + row) * rstride) * ldo + c8 * 8) = v; }
        asm volatile("s_waitcnt lgkmcnt(0)" ::: "memory");
    }
}
template <int MODE> __device__ __forceinline__ void band_unit(LAS unsigned char* lds, const BandArgs& a, int sb, int lane, int wave) {
    constexpr int QB = (MODE == 0) ? 64 : 256, NK = QB + 128, VSTR = 2 * NK + 8, OST = NK * 144 + 64 * VSTR;
    LAS unsigned char* Kl = lds; LAS unsigned char* Vt = lds + NK * 144;
    const int rl = lane & 31, h = lane >> 5;
    const int iq = a.i0 + 32 * sb + rl; const size_t qrow = (size_t)(a.rowbase + iq * a.rstride);
    bf16x8 qf[4];
#pragma unroll
    for (int d0 = 0; d0 < 4; ++d0) qf[d0] = *(const bf16x8*)(a.Qp + qrow * a.ldq + 16 * d0 + 8 * h);
    f32x16 o[2]; float m, l;
    band_compute<NK, (MODE == 0) ? 127 : 128, MODE == 0>(Kl, Vt, 32 * sb, qf, 128, a.i0 - 128 + 32 * sb, a.slope2, a.sink2, lane, o, m, l);
    const float inv = 1.0f / l;
    band_store_lds(lds + OST + wave * 2304, o, inv, lane, a.Op, (size_t)(a.rowbase + (a.i0 + 32 * sb) * a.rstride), a.rstride, a.ldo);
    if (MODE == 1) { if (h == 0) a.lsep[qrow * a.ldl] = m + __builtin_amdgcn_logf(l); }
}
}
namespace fk {
__device__ __forceinline__ void sample_a_unit(Frame& F, int l, int b, int kvh) {
    constexpr int NK = 160, VSTR = 2 * NK + 8; const int lane = F.lane(), tid = F.wave * 64 + lane;
    LAS unsigned char* Kl = F.lds; LAS unsigned char* Vt = F.lds + NK * 144;
    const float* ck = F.cak + (((size_t)l * NBS + b) * 128) * 256 + kvh * 64; const float* cv = F.cav + (((size_t)l * NBS + b) * 128) * 256 + kvh * 64;
    float* ok = F.out + O6 + (((size_t)l * NBS + b) * 128) * 256 + kvh * 64; float* ov = F.out + O7 + (((size_t)l * NBS + b) * 128) * 256 + kvh * 64;
#pragma unroll
    for (int c0 = 0; c0 < 2048; c0 += NTHREADS) {
        const int c = c0 + tid, kk = c >> 4, ch = c & 15;
        const f32x4 kq = *(const f32x4*)(ck + (size_t)kk * 256 + ch * 4), vq = *(const f32x4*)(cv + (size_t)kk * 256 + ch * 4);
        if (kk >= 8) { *(f32x4*)(ok + (size_t)(kk - 8) * 256 + ch * 4) = kq; *(f32x4*)(ov + (size_t)(kk - 8) * 256 + ch * 4) = vq; }
        v2u kw; kw.x = pkbf(kq.x, kq.y); kw.y = pkbf(kq.z, kq.w);
        *(LAS v2u*)(Kl + kk * 144 + ch * 8) = kw;
        const unsigned v01 = pkbf(vq.x, vq.y), v23 = pkbf(vq.z, vq.w);
        LAS unsigned char* vt = Vt + (ch * 4) * VSTR + kk * 2;
        *(LAS unsigned short*)(vt) = (unsigned short)(v01 & 0xffffu); *(LAS unsigned short*)(vt + VSTR) = (unsigned short)(v01 >> 16);
        *(LAS unsigned short*)(vt + 2 * VSTR) = (unsigned short)(v23 & 0xffffu); *(LAS unsigned short*)(vt + 3 * VSTR) = (unsigned short)(v23 >> 16);
    }
    if (tid < 256) {
        const int kk = 128 + (tid >> 3), ch = tid & 7; v4u kq = {0u, 0u, 0u, 0u}, vq = {0u, 0u, 0u, 0u};
        if (kk < 136) { const size_t row = (size_t)(MP + b * 8 + (kk - 128)); kq = *(const v4u*)(F.KA + row * 256 + kvh * 64 + ch * 8); vq = *(const v4u*)(F.VA + row * 256 + kvh * 64 + ch * 8); }
        *(LAS v4u*)(Kl + kk * 144 + ch * 16) = kq;
        LAS unsigned char* vt = Vt + (ch * 8) * VSTR + kk * 2;
        *(LAS unsigned short*)(vt) = (unsigned short)(vq.x & 0xffffu); *(LAS unsigned short*)(vt + 1 * VSTR) = (unsigned short)(vq.x >> 16);
        *(LAS unsigned short*)(vt + 2 * VSTR) = (unsigned short)(vq.y & 0xffffu); *(LAS unsigned short*)(vt + 3 * VSTR) = (unsigned short)(vq.y >> 16);
        *(LAS unsigned short*)(vt + 4 * VSTR) = (unsigned short)(vq.z & 0xffffu); *(LAS unsigned short*)(vt + 5 * VSTR) = (unsigned short)(vq.z >> 16);
        *(LAS unsigned short*)(vt + 6 * VSTR) = (unsigned short)(vq.w & 0xffffu); *(LAS unsigned short*)(vt + 7 * VSTR) = (unsigned short)(vq.w >> 16);
    }
    __syncthreads();
    if (F.wave == 0) {
        const int rl = lane & 31, h = lane >> 5, g = rl >> 3, s = rl & 7, head = kvh * 4 + g;
        const size_t qrow = (size_t)(MP + b * 8 + s);
        bf16x8 qf[4];
#pragma unroll
        for (int d0 = 0; d0 < 4; ++d0) qf[d0] = *(const bf16x8*)(F.Q + qrow * 1024 + head * 64 + 16 * d0 + 8 * h);
        const float slope2 = slope_of(head, 16) * LOG2E, sink2 = F.sinks_a[l * 16 + head] * LOG2E;
        f32x16 o[2]; float m, lsum;
        band_compute<NK, 127, true>(Kl, Vt, 0, qf, 128 + s - rl, 0, slope2, sink2, lane, o, m, lsum);
        band_store(F.ATT + qrow * 1024 + head * 64, o, 1.0f / lsum, h);
    }
    __syncthreads();
}
struct SbTile { f32x4 k[8]; float v[32]; };
__device__ __forceinline__ int sb_idx(int t, int ioff) { return (t < 24) ? (16 * (4 * t + (ioff >> 3)) + (ioff & 7)) : (32 * t + ioff + 768); }
__device__ __forceinline__ const float* sb_rowptr(const float* cache, const float* outc, int b, int idx, int col) {
    const int ic = idx > 2055 ? 2055 : idx;
    return (ic < 2048) ? cache + ((size_t)b * 2048 + ic) * 512 + col : outc + ((size_t)b * 2048 + (ic - 8)) * 512 + col;
}
__device__ __forceinline__ void sb_load(SbTile& T, const float* ck, const float* cv, const float* ok, const float* ov, int b, int slot, int t, int rl, int h) {
    const float* kp = sb_rowptr(ck, ok, b, sb_idx(t, rl), slot * 64 + 8 * h);
#pragma unroll
    for (int d0 = 0; d0 < 4; ++d0) { T.k[2 * d0] = *(const f32x4*)(kp + 16 * d0); T.k[2 * d0 + 1] = *(const f32x4*)(kp + 16 * d0 + 4); }
#pragma unroll
    for (int s2 = 0; s2 < 2; ++s2)
#pragma unroll
        for (int jj = 0; jj < 2; ++jj)
#pragma unroll
            for (int e = 0; e < 4; ++e) { const float* vp = sb_rowptr(cv, ov, b, sb_idx(t, 16 * s2 + 8 * jj + 4 * h + e), slot * 64 + rl);
                T.v[(s2 * 2 + 0) * 8 + jj * 4 + e] = vp[0]; T.v[(s2 * 2 + 1) * 8 + jj * 4 + e] = vp[32]; }
}
__device__ __forceinline__ void sb_compute(const SbTile& T, int t, const bf16x8 (&qf)[4], int tq, int rmask, int wmax, float slope2, bool colok, int h, f32x16 (&o)[2], float& m, float& l) {
    f32x16 S = {0.f, 0.f, 0.f, 0.f, 0.f, 0.f, 0.f, 0.f, 0.f, 0.f, 0.f, 0.f, 0.f, 0.f, 0.f, 0.f};
#pragma unroll
    for (int d0 = 0; d0 < 4; ++d0) { const f32x4 a = T.k[2 * d0], c = T.k[2 * d0 + 1]; v4u w; w.x = pkbf(a.x, a.y); w.y = pkbf(a.z, a.w); w.z = pkbf(c.x, c.y); w.w = pkbf(c.z, c.w);
        S = MFMA32(__builtin_bit_cast(bf16x8, w), qf[d0], S); }
    float tm = -INFINITY;
#pragma unroll
    for (int rg = 0; rg < 16; ++rg) { const int idx = sb_idx(t, 8 * (rg >> 2) + 4 * h + (rg & 3)); const int dist = tq - idx;
        const bool ok = colok && (dist >= 0) && ((dist & rmask) == 0) && (dist <= wmax);
        const float sc = ok ? (S[rg] - slope2 * (float)dist) : -INFINITY; S[rg] = sc; tm = fmaxf(tm, sc); }
    tm = fmaxf(tm, __shfl_xor(tm, 32));
    const float mn = fmaxf(m, tm), alpha = __builtin_amdgcn_exp2f(m - mn); m = mn;
    float ls = 0.f;
#pragma unroll
    for (int rg = 0; rg < 16; ++rg) { const float p = __builtin_amdgcn_exp2f(S[rg] - mn); S[rg] = p; ls += p; }
    l = l * alpha + ls;
#pragma unroll
    for (int dh = 0; dh < 2; ++dh)
#pragma unroll
        for (int rg = 0; rg < 16; ++rg) o[dh][rg] *= alpha;
#pragma unroll
    for (int s2 = 0; s2 < 2; ++s2) {
        v4u pw; pw.x = pkbf(S[8 * s2 + 0], S[8 * s2 + 1]); pw.y = pkbf(S[8 * s2 + 2], S[8 * s2 + 3]); pw.z = pkbf(S[8 * s2 + 4], S[8 * s2 + 5]); pw.w = pkbf(S[8 * s2 + 6], S[8 * s2 + 7]);
        const bf16x8 xs = __builtin_bit_cast(bf16x8, pw);
#pragma unroll
        for (int dh = 0; dh < 2; ++dh) { const float* vv = &T.v[(s2 * 2 + dh) * 8];
            v4u vw; vw.x = pkbf(vv[0], vv[1]); vw.y = pkbf(vv[2], vv[3]); vw.z = pkbf(vv[4], vv[5]); vw.w = pkbf(vv[6], vv[7]);
            o[dh] = MFMA32(__builtin_bit_cast(bf16x8, vw), xs, o[dh]); }
    }
}
#ifndef SBFORCE0
#define SBFORCE0 0
#endif
struct SbPacked { v4u d[4]; v2u sc; };
__device__ __forceinline__ unsigned q8_pack4(float a, float b, float c, float d, float s) {
    unsigned u = 0u;
    u = __builtin_amdgcn_cvt_pk_u8_f32(__builtin_rintf(__builtin_fmaf(a, s, 128.0f)), 0, u); u = __builtin_amdgcn_cvt_pk_u8_f32(__builtin_rintf(__builtin_fmaf(b, s, 128.0f)), 1, u);
    u = __builtin_amdgcn_cvt_pk_u8_f32(__builtin_rintf(__builtin_fmaf(c, s, 128.0f)), 2, u); u = __builtin_amdgcn_cvt_pk_u8_f32(__builtin_rintf(__builtin_fmaf(d, s, 128.0f)), 3, u);
    return u;
}
__device__ __forceinline__ void q8_unpack4(unsigned w, float s, float& a, float& b, float& c, float& d) {
    a = ((float)(w & 255u) - 128.0f) * s; b = ((float)((w >> 8) & 255u) - 128.0f) * s; c = ((float)((w >> 16) & 255u) - 128.0f) * s; d = ((float)(w >> 24) - 128.0f) * s;
}
__device__ __forceinline__ void sb_encode_store(const SbTile& T, unsigned char* q8, unsigned char* q8s, size_t idx) {
    float km = 0.f, vm = 0.f;
#pragma unroll
    for (int i = 0; i < 8; ++i) km = fmaxf(fmaxf(km, fmaxf(fabsf(T.k[i][0]), fabsf(T.k[i][1]))), fmaxf(fabsf(T.k[i][2]), fabsf(T.k[i][3])));
#pragma unroll
    for (int i = 0; i < 32; ++i) vm = fmaxf(vm, fabsf(T.v[i]));
    const float ks = km > 0.f ? 127.0f / km : 0.f, vs = vm > 0.f ? 127.0f / vm : 0.f;
    v4u* dst = (v4u*)(q8 + idx * 64);
    { v4u d; d.x = q8_pack4(T.k[0][0], T.k[0][1], T.k[0][2], T.k[0][3], ks); d.y = q8_pack4(T.k[1][0], T.k[1][1], T.k[1][2], T.k[1][3], ks); d.z = q8_pack4(T.k[2][0], T.k[2][1], T.k[2][2], T.k[2][3], ks); d.w = q8_pack4(T.k[3][0], T.k[3][1], T.k[3][2], T.k[3][3], ks); dst[0] = d; }
    asm volatile("" ::: "memory");
    { v4u d; d.x = q8_pack4(T.k[4][0], T.k[4][1], T.k[4][2], T.k[4][3], ks); d.y = q8_pack4(T.k[5][0], T.k[5][1], T.k[5][2], T.k[5][3], ks); d.z = q8_pack4(T.k[6][0], T.k[6][1], T.k[6][2], T.k[6][3], ks); d.w = q8_pack4(T.k[7][0], T.k[7][1], T.k[7][2], T.k[7][3], ks); dst[1] = d; }
    asm volatile("" ::: "memory");
    { v4u d; d.x = q8_pack4(T.v[0], T.v[1], T.v[2], T.v[3], vs); d.y = q8_pack4(T.v[4], T.v[5], T.v[6], T.v[7], vs); d.z = q8_pack4(T.v[8], T.v[9], T.v[10], T.v[11], vs); d.w = q8_pack4(T.v[12], T.v[13], T.v[14], T.v[15], vs); dst[2] = d; }
    asm volatile("" ::: "memory");
    { v4u d; d.x = q8_pack4(T.v[16], T.v[17], T.v[18], T.v[19], vs); d.y = q8_pack4(T.v[20], T.v[21], T.v[22], T.v[23], vs); d.z = q8_pack4(T.v[24], T.v[25], T.v[26], T.v[27], vs); d.w = q8_pack4(T.v[28], T.v[29], T.v[30], T.v[31], vs); dst[3] = d; }
    v2u sc; sc.x = __float_as_uint(km * (1.0f / 127.0f)); sc.y = __float_as_uint(vm * (1.0f / 127.0f));
    *(v2u*)(q8s + idx * 8) = sc;
}
__device__ __forceinline__ void sb_load_packed(SbPacked& P, const unsigned char* q8, const unsigned char* q8s, size_t idx) {
    const v4u* src = (const v4u*)(q8 + idx * 64);
#pragma unroll
    for (int i = 0; i < 4; ++i) P.d[i] = src[i];
    P.sc = *(const v2u*)(q8s + idx * 8);
}
__device__ __forceinline__ void sb_decode(SbTile& T, const SbPacked& P) {
    const float ks = __uint_as_float(P.sc.x), vs = __uint_as_float(P.sc.y);
#pragma unroll
    for (int i = 0; i < 8; ++i) { float a, b, c, d; q8_unpack4(P.d[i >> 2][i & 3], ks, a, b, c, d); T.k[i] = (f32x4){a, b, c, d}; }
#pragma unroll
    for (int i = 0; i < 8; ++i) { float a, b, c, d; q8_unpack4(P.d[2 + (i >> 2)][i & 3], vs, a, b, c, d); T.v[4 * i] = a; T.v[4 * i + 1] = b; T.v[4 * i + 2] = c; T.v[4 * i + 3] = d; }
}
struct SbBf { v4u k[4], v[4]; };
__device__ __forceinline__ void sb_to_bf(const SbTile& T, SbBf& B, float& km, float& vm) {
    km = 0.f; vm = 0.f;
#pragma unroll
    for (int d0 = 0; d0 < 4; ++d0) { const f32x4 a = T.k[2 * d0], c = T.k[2 * d0 + 1]; v4u w; w.x = pkbf(a.x, a.y); w.y = pkbf(a.z, a.w); w.z = pkbf(c.x, c.y); w.w = pkbf(c.z, c.w); B.k[d0] = w;
        km = fmaxf(km, fmaxf(fmaxf(fmaxf(fabsf(a.x), fabsf(a.y)), fmaxf(fabsf(a.z), fabsf(a.w))), fmaxf(fmaxf(fabsf(c.x), fabsf(c.y)), fmaxf(fabsf(c.z), fabsf(c.w))))); }
#pragma unroll
    for (int i = 0; i < 4; ++i) { const float* vv = &T.v[i * 8]; v4u w; w.x = pkbf(vv[0], vv[1]); w.y = pkbf(vv[2], vv[3]); w.z = pkbf(vv[4], vv[5]); w.w = pkbf(vv[6], vv[7]); B.v[i] = w;
        vm = fmaxf(vm, fmaxf(fmaxf(fmaxf(fabsf(vv[0]), fabsf(vv[1])), fmaxf(fabsf(vv[2]), fabsf(vv[3]))), fmaxf(fmaxf(fabsf(vv[4]), fabsf(vv[5])), fmaxf(fabsf(vv[6]), fabsf(vv[7]))))); }
}
__device__ __forceinline__ unsigned q8_pack_pair(unsigned w0, unsigned w1, float s) {
    return q8_pack4(bflo(w0), bfhi(w0), bflo(w1), bfhi(w1), s);
}
__device__ __forceinline__ void sb_encode_store_bf(const SbBf& B, float km, float vm, unsigned char* q8, unsigned char* q8s, size_t idx) {
    const float ks = km > 0.f ? 127.0f / km : 0.f, vs = vm > 0.f ? 127.0f / vm : 0.f;
    v4u* dst = (v4u*)(q8 + idx * 64);
    { v4u d; d.x = q8_pack_pair(B.k[0].x, B.k[0].y, ks); d.y = q8_pack_pair(B.k[0].z, B.k[0].w, ks); d.z = q8_pack_pair(B.k[1].x, B.k[1].y, ks); d.w = q8_pack_pair(B.k[1].z, B.k[1].w, ks); dst[0] = d; }
    { v4u d; d.x = q8_pack_pair(B.k[2].x, B.k[2].y, ks); d.y = q8_pack_pair(B.k[2].z, B.k[2].w, ks); d.z = q8_pack_pair(B.k[3].x, B.k[3].y, ks); d.w = q8_pack_pair(B.k[3].z, B.k[3].w, ks); dst[1] = d; }
    { v4u d; d.x = q8_pack_pair(B.v[0].x, B.v[0].y, vs); d.y = q8_pack_pair(B.v[0].z, B.v[0].w, vs); d.z = q8_pack_pair(B.v[1].x, B.v[1].y, vs); d.w = q8_pack_pair(B.v[1].z, B.v[1].w, vs); dst[2] = d; }
    { v4u d; d.x = q8_pack_pair(B.v[2].x, B.v[2].y, vs); d.y = q8_pack_pair(B.v[2].z, B.v[2].w, vs); d.z = q8_pack_pair(B.v[3].x, B.v[3].y, vs); d.w = q8_pack_pair(B.v[3].z, B.v[3].w, vs); dst[3] = d; }
    v2u sc; sc.x = __float_as_uint(km * (1.0f / 127.0f)); sc.y = __float_as_uint(vm * (1.0f / 127.0f));
    *(v2u*)(q8s + idx * 8) = sc;
}
__device__ __forceinline__ void sb_compute_bf(const SbBf& B, int t, const bf16x8 (&qf)[4], int tq, int rmask, int wmax, float slope2, bool colok, int h, f32x16 (&o)[2], float& m, float& l) {
    f32x16 S = {0.f, 0.f, 0.f, 0.f, 0.f, 0.f, 0.f, 0.f, 0.f, 0.f, 0.f, 0.f, 0.f, 0.f, 0.f, 0.f};
#pragma unroll
    for (int d0 = 0; d0 < 4; ++d0) S = MFMA32(__builtin_bit_cast(bf16x8, B.k[d0]), qf[d0], S);
    float tm = -INFINITY;
#pragma unroll
    for (int rg = 0; rg < 16; ++rg) { const int idx = sb_idx(t, 8 * (rg >> 2) + 4 * h + (rg & 3)); const int dist = tq - idx;
        const bool ok = colok && (dist >= 0) && ((dist & rmask) == 0) && (dist <= wmax);
        const float sc = ok ? (S[rg] - slope2 * (float)dist) : -INFINITY; S[rg] = sc; tm = fmaxf(tm, sc); }
    tm = fmaxf(tm, __shfl_xor(tm, 32));
    const float mn = fmaxf(m, tm), alpha = __builtin_amdgcn_exp2f(m - mn); m = mn;
    float ls = 0.f;
#pragma unroll
    for (int rg = 0; rg < 16; ++rg) { const float p = __builtin_amdgcn_exp2f(S[rg] - mn); S[rg] = p; ls += p; }
    l = l * alpha + ls;
#pragma unroll
    for (int dh = 0; dh < 2; ++dh)
#pragma unroll
        for (int rg = 0; rg < 16; ++rg) o[dh][rg] *= alpha;
#pragma unroll
    for (int s2 = 0; s2 < 2; ++s2) {
        v4u pw; pw.x = pkbf(S[8 * s2 + 0], S[8 * s2 + 1]); pw.y = pkbf(S[8 * s2 + 2], S[8 * s2 + 3]); pw.z = pkbf(S[8 * s2 + 4], S[8 * s2 + 5]); pw.w = pkbf(S[8 * s2 + 6], S[8 * s2 + 7]);
        const bf16x8 xs = __builtin_bit_cast(bf16x8, pw);
#pragma unroll
        for (int dh = 0; dh < 2; ++dh) o[dh] = MFMA32(__builtin_bit_cast(bf16x8, B.v[s2 * 2 + dh]), xs, o[dh]);
    }
}
template <int MODE>
__device__ __forceinline__ void sample_b_task(Frame& F, int b, int slot) {
    const int lane = F.lane(), rl = lane & 31, h = lane >> 5, g = rl >> 3, s = rl & 7, gq = g > 2 ? 2 : g;
    const bool colok = g < 3; const int r = (gq == 0) ? 1 : (gq == 1) ? 4 : 16; const int rmask = r - 1, wmax = 128 * r, tq = 2048 + s;
    const float slope2 = slope_of(gq * 8 + slot, 24) * LOG2E;
    const size_t qrow = (size_t)(MP + b * 8 + s);
    bf16x8 qf[4];
#pragma unroll
    for (int d0 = 0; d0 < 4; ++d0) qf[d0] = *(const bf16x8*)(F.Q + qrow * 1536 + gq * 512 + slot * 64 + 16 * d0 + 8 * h);
    const float* ok = F.out + O8; const float* ov = F.out + O9;
    f32x16 o[2]; o[0] = (f32x16){0.f, 0.f, 0.f, 0.f, 0.f, 0.f, 0.f, 0.f, 0.f, 0.f, 0.f, 0.f, 0.f, 0.f, 0.f, 0.f}; o[1] = o[0];
    float m = -1e30f, l = 0.f;
    unsigned char* q8 = (unsigned char*)F.CBK; unsigned char* q8s = (unsigned char*)F.CBV; const size_t tbase = ((size_t)(b * 8 + slot) * 41) * 64 + lane;
    if (MODE == 0) {
        SbTile TB; SbBf B; float km, vm;
        sb_load(TB, F.cbk, F.cbv, ok, ov, b, slot, 0, rl, h);
        for (int t = 0; t < 41; ++t) {
            sb_to_bf(TB, B, km, vm);
            if (t + 1 < 41) sb_load(TB, F.cbk, F.cbv, ok, ov, b, slot, t + 1, rl, h);
            sb_encode_store_bf(B, km, vm, q8, q8s, tbase + (size_t)t * 64);
            sb_compute_bf(B, t, qf, tq, rmask, wmax, slope2, colok, h, o, m, l);
        }
    } else {
        SbPacked P0, P1, P2, P3; SbTile T;
        sb_load_packed(P0, q8, q8s, tbase); sb_load_packed(P1, q8, q8s, tbase + 64); sb_load_packed(P2, q8, q8s, tbase + 128); sb_load_packed(P3, q8, q8s, tbase + 192);
        for (int t = 0; t < 41; t += 4) {
            sb_decode(T, P0); if (t + 4 < 41) sb_load_packed(P0, q8, q8s, tbase + (size_t)(t + 4) * 64); sb_compute(T, t, qf, tq, rmask, wmax, slope2, colok, h, o, m, l);
            if (t + 1 < 41) { sb_decode(T, P1); if (t + 5 < 41) sb_load_packed(P1, q8, q8s, tbase + (size_t)(t + 5) * 64); sb_compute(T, t + 1, qf, tq, rmask, wmax, slope2, colok, h, o, m, l); }
            if (t + 2 < 41) { sb_decode(T, P2); if (t + 6 < 41) sb_load_packed(P2, q8, q8s, tbase + (size_t)(t + 6) * 64); sb_compute(T, t + 2, qf, tq, rmask, wmax, slope2, colok, h, o, m, l); }
            if (t + 3 < 41) { sb_decode(T, P3); if (t + 7 < 41) sb_load_packed(P3, q8, q8s, tbase + (size_t)(t + 7) * 64); sb_compute(T, t + 3, qf, tq, rmask, wmax, slope2, colok, h, o, m, l); }
        }
    }
    l += __shfl_xor(l, 32);
    const float lse2 = colok ? (m + __builtin_amdgcn_logf(l)) : -1e30f, inv = 1.0f / l;
    const float l0 = __shfl(lse2, s + 32 * h), l1 = __shfl(lse2, 8 + s + 32 * h), l2 = __shfl(lse2, 16 + s + 32 * h);
    const float mx = fmaxf(fmaxf(l0, l1), l2); const float w0 = __builtin_amdgcn_exp2f(l0 - mx), w1 = __builtin_amdgcn_exp2f(l1 - mx), w2 = __builtin_amdgcn_exp2f(l2 - mx); const float iw = 1.0f / (w0 + w1 + w2);
    f32x16 c[2];
#pragma unroll
    for (int dh = 0; dh < 2; ++dh)
#pragma unroll
        for (int rg = 0; rg < 16; ++rg) { const float v = o[dh][rg] * inv; const float a0 = __shfl(v, s + 32 * h), a1 = __shfl(v, 8 + s + 32 * h), a2 = __shfl(v, 16 + s + 32 * h); c[dh][rg] = (w0 * a0 + w1 * a1 + w2 * a2) * iw; }
    if (rl < 8) band_store(F.ATT + qrow * 512 + slot * 64, c, 1.0f, h);
}
template <int UNR> __device__ __forceinline__ void combine_rows(Frame& F, size_t first, size_t nth) {
    const size_t total = (size_t)MP * 64;
    for (size_t it0 = first; it0 < total; it0 += nth * UNR) {
        float l0[UNR], l1[UNR], l2[UNR]; v4u a[UNR], b[UNR], c[UNR];
#pragma unroll
        for (int q = 0; q < UNR; ++q) { const size_t it = it0 + nth * q; const size_t row = it >> 6; const int c8 = (int)(it & 63), slot = c8 >> 3;
            l0[q] = F.LSE[(size_t)0 * M * 8 + row * 8 + slot]; l1[q] = F.LSE[(size_t)1 * M * 8 + row * 8 + slot]; l2[q] = F.LSE[(size_t)2 * M * 8 + row * 8 + slot];
            a[q] = *(const v4u*)(F.OG + ((size_t)0 * M + row) * 512 + c8 * 8); b[q] = *(const v4u*)(F.OG + ((size_t)1 * M + row) * 512 + c8 * 8); c[q] = *(const v4u*)(F.OG + ((size_t)2 * M + row) * 512 + c8 * 8); }
#pragma unroll
        for (int q = 0; q < UNR; ++q) { const size_t it = it0 + nth * q; const size_t row = it >> 6; const int c8 = (int)(it & 63);
            const float mx = fmaxf(fmaxf(l0[q], l1[q]), l2[q]); float w0 = __builtin_amdgcn_exp2f(l0[q] - mx), w1 = __builtin_amdgcn_exp2f(l1[q] - mx), w2 = __builtin_amdgcn_exp2f(l2[q] - mx);
            const float id = 1.0f / (w0 + w1 + w2); w0 *= id; w1 *= id; w2 *= id;
            v4u o;
            o.x = pkbf(w0 * bflo(a[q].x) + w1 * bflo(b[q].x) + w2 * bflo(c[q].x), w0 * bfhi(a[q].x) + w1 * bfhi(b[q].x) + w2 * bfhi(c[q].x));
            o.y = pkbf(w0 * bflo(a[q].y) + w1 * bflo(b[q].y) + w2 * bflo(c[q].y), w0 * bfhi(a[q].y) + w1 * bfhi(b[q].y) + w2 * bfhi(c[q].y));
            o.z = pkbf(w0 * bflo(a[q].z) + w1 * bflo(b[q].z) + w2 * bflo(c[q].z), w0 * bfhi(a[q].z) + w1 * bfhi(b[q].z) + w2 * bfhi(c[q].z));
            o.w = pkbf(w0 * bflo(a[q].w) + w1 * bflo(b[q].w) + w2 * bflo(c[q].w), w0 * bfhi(a[q].w) + w1 * bfhi(b[q].w) + w2 * bfhi(c[q].w));
            *(v4u*)(F.ATT + row * 512 + c8 * 8) = o; }
    }
}
__device__ __forceinline__ void combine_b(Frame& F) { combine_rows<1>(F, (size_t)F.vcu * NTHREADS + F.tid(), (size_t)F.G * NTHREADS); }
__device__ __forceinline__ void final_norm(Frame& F) {
    const int lane = F.lane(); const int gw = F.vcu * NWAVES + F.wave, NGW = F.G * NWAVES;
    const f32x4* gg = (const f32x4*)F.g_final + lane; f32x4 g[4];
#pragma unroll
    for (int j = 0; j < 4; ++j) g[j] = gg[64 * j];
    for (int m0 = gw * 2; m0 < M; m0 += NGW * 2) {
        f32x4 v[2][4]; float rs[2];
#pragma unroll
        for (int q = 0; q < 2; ++q) {
#ifdef RESBF16
            const v2u* xr = (const v2u*)(F.XB + (size_t)(m0 + q) * D) + lane;
#pragma unroll
            for (int j = 0; j < 4; ++j) { const v2u w = xr[64 * j]; v[q][j] = (f32x4){bflo(w.x), bfhi(w.x), bflo(w.y), bfhi(w.y)}; }
#else
            const f32x4* xr = (const f32x4*)(F.X + (size_t)(m0 + q) * D) + lane;
#pragma unroll
            for (int j = 0; j < 4; ++j) v[q][j] = xr[64 * j];
#endif
            rs[q] = rstd_row(F.SS, m0 + q); }
#pragma unroll
        for (int q = 0; q < 2; ++q) { f32x4* yo = (f32x4*)(F.out + (size_t)(m0 + q) * D) + lane;
#pragma unroll
            for (int j = 0; j < 4; ++j) { f32x4 o; o.x = v[q][j].x * rs[q] * g[j].x; o.y = v[q][j].y * rs[q] * g[j].y; o.z = v[q][j].z * rs[q] * g[j].z; o.w = v[q][j].w * rs[q] * g[j].w; yo[64 * j] = o; } }
    }
}
__device__ __forceinline__ void attn_a_phase(Frame& F, int l) {
#ifndef REP_ATTA
#define REP_ATTA 1
#endif
#ifndef REP_ATTBP
#define REP_ATTBP 1
#endif
#ifndef REP_ATTBS
#define REP_ATTBS 1
#endif
    for (int rep = 0; rep < REP_ATTA; ++rep) {
        BandRegs<0> R; BandArgs a, an;
        auto mk = [&](int u, BandArgs& x) { const int qblk = u & 127, kvh = (u >> 7) & 3, b = u >> 9; const int g = F.wave >> 1, head = kvh * 4 + g;
            x.Qp = F.Q + head * 64; x.ldq = 1024; x.Kp = F.KA + kvh * 64; x.Vp = F.VA + kvh * 64; x.ldkv = 256; x.rowbase = b * TP; x.rstride = 1; x.i0 = qblk * 64;
            x.Op = F.ATT + head * 64; x.ldo = 1024; x.lsep = nullptr; x.ldl = 0; x.slope2 = slope_of(head, 16) * LOG2E; x.sink2 = F.sinks_a[l * 16 + head] * LOG2E; };
        int u = F.vcu;
        if (u < NBP * 4 * 128) { const int tid0 = F.tid(); mk(u, a); band_fetch<0>(R, a, tid0); }
        for (; u < NBP * 4 * 128; u += F.G) {
            const int lane = F.lane(), tid = F.wave * 64 + lane;
            band_put<0>(F.lds, R, tid);
            __syncthreads();
            const bool more = (u + F.G < NBP * 4 * 128);
            if (more) { mk(u + F.G, an); band_fetch<0>(R, an, tid); }
            band_unit<0>(F.lds, a, F.wave & 1, lane, F.wave);
            __syncthreads();
            if (more) a = an;
        }
    }
    for (int rep = 0; rep < REP_ATTA; ++rep)
    for (int u = F.vcu; u < NBS * 4; u += F.G) sample_a_unit(F, l, u >> 2, u & 3);
}
__device__ __forceinline__ void attn_b_phase(Frame& F, int half) {
    for (int rep = 0; rep < REP_ATTBP; ++rep) {
        BandRegs<1> R; BandArgs a, an;
        auto mk = [&](int u, BandArgs& x) { const int grp = u >> 9, v = u & 511; const int r = (grp == 0) ? 1 : (grp == 1) ? 4 : 16; const int L = TP / r, nqb = L / 256;
            const int slot = v & 7, w = v >> 3; const int qblk = w % nqb, br = w / nqb, res = br % r, b = br / r;
            x.Qp = F.Q + grp * 512 + slot * 64; x.ldq = 1536; x.Kp = F.KB + slot * 64; x.Vp = F.VB + slot * 64; x.ldkv = 512; x.rowbase = b * TP + res; x.rstride = r; x.i0 = qblk * 256;
            x.Op = F.OG + (size_t)grp * M * 512 + slot * 64; x.ldo = 512; x.lsep = F.LSE + (size_t)grp * M * 8 + slot; x.ldl = 8; x.slope2 = slope_of(grp * 8 + slot, 24) * (float)r * LOG2E; x.sink2 = 0.f; };
        int u = F.vcu;
        if (u < 3 * 512) { const int tid0 = F.tid(); mk(u, a); band_fetch<1>(R, a, tid0); }
        for (; u < 3 * 512; u += F.G) {
            const int lane = F.lane(), tid = F.wave * 64 + lane;
            band_put<1>(F.lds, R, tid);
            __syncthreads();
            const bool more = (u + F.G < 3 * 512);
            if (more) { mk(u + F.G, an); band_fetch<1>(R, an, tid); }
            band_unit<1>(F.lds, a, F.wave, lane, F.wave);
            __syncthreads();
            if (more) a = an;
        }
    }
    if (F.fuse) { asm volatile("s_waitcnt vmcnt(0)" ::: "memory"); __syncthreads(); }
    if (F.wave < 4) {
    for (int rep = 0; rep < REP_ATTBS; ++rep)
    for (int t = F.vcu * 4 + F.wave; t < NBS * 8; t += F.G * 4) { if (half == 0 || SBFORCE0) sample_b_task<0>(F, t >> 3, t & 7); else sample_b_task<1>(F, t >> 3, t & 7); }
    } else if (F.fuse) {
        const int lane = F.lane(); const unsigned want = (unsigned)half + 1u;
        if (F.wave == 4 && lane == 0) { XcdBarrier b2; b2.bar = F.ctl + CW_BAR2; b2.x = xb_xcc_id(); b2.st = F.MISC + 8; xcd_barrier_thread(b2); F.MISC[12] = want; }
        while (F.MISC[12] != want) __builtin_amdgcn_s_sleep(2);
        combine_rows<4>(F, (size_t)F.vcu * 256 + (size_t)((F.wave - 4) * 64 + lane), (size_t)F.G * 256);
    }
}
}
namespace fk {
typedef float f32x4m __attribute__((ext_vector_type(4)));
#define MFMA16(a, b, c) __builtin_amdgcn_mfma_f32_16x16x32_bf16((a), (b), (c), 0, 0, 0)
constexpr int MINI_KC = 256, MINI_RS = 528;
constexpr int MINI_BUF = 2 * 64 * MINI_RS;
struct MiniRegs { v4u a[4], b[4]; };
__device__ __forceinline__ void mini_fetch(MiniRegs& R, const bf16* A, const bf16* Bt, int K, int row0, int col0, int kc, int tid) {
#pragma unroll
    for (int it = 0; it < 4; ++it) { const int idx = it * NTHREADS + tid, r = idx >> 5, ch = idx & 31;
        R.a[it] = *(const v4u*)(A + (size_t)(row0 + r) * K + kc + ch * 8); R.b[it] = *(const v4u*)(Bt + (size_t)(col0 + r) * K + kc + ch * 8); }
}
__device__ __forceinline__ void mini_put(LAS unsigned char* lds, const MiniRegs& R, int tid) {
#pragma unroll
    for (int it = 0; it < 4; ++it) { const int idx = it * NTHREADS + tid, r = idx >> 5, ch = idx & 31;
        *(LAS v4u*)(lds + r * MINI_RS + ch * 16) = R.a[it]; *(LAS v4u*)(lds + 64 * MINI_RS + r * MINI_RS + ch * 16) = R.b[it]; }
}
__device__ __forceinline__ void mini_gemm(Frame& F, const bf16* A, const bf16* Bt, int K, float* Xo, bf16* XBo, float* SSo) {
    const int lane = F.lane(), tid = F.wave * 64 + lane; const int tile = F.vcu; if (tile >= 256) return;
    const int xq = tile >> 5, jq = tile & 31;
    const int tr = 4 * (xq >> 1) + (jq >> 3), tc = 8 * (xq & 1) + (jq & 7); const int row0 = MP + 64 * tr, col0 = 64 * tc;
    const int nch = K / MINI_KC;
    const int lr = lane & 15, lq = lane >> 4;
    f32x4m acc[4][4];
#pragma unroll
    for (int i = 0; i < 4; ++i)
#pragma unroll
        for (int j = 0; j < 4; ++j) acc[i][j] = (f32x4m){0.f, 0.f, 0.f, 0.f};
    MiniRegs R0, R1;
    mini_fetch(R0, A, Bt, K, row0, col0, 0, tid);
    if (nch > 1) mini_fetch(R1, A, Bt, K, row0, col0, MINI_KC, tid);
    for (int c = 0; c < nch; c += 2) {
        mini_put(F.lds, R0, tid);
        __syncthreads();
        if (c + 2 < nch) mini_fetch(R0, A, Bt, K, row0, col0, (c + 2) * MINI_KC, tid);
        { bf16x8 af[4], bf[4];
#pragma unroll
          for (int i = 0; i < 4; ++i) { af[i] = *(const LAS bf16x8*)(F.lds + (16 * i + lr) * MINI_RS + 64 * F.wave + 16 * lq); bf[i] = *(const LAS bf16x8*)(F.lds + 64 * MINI_RS + (16 * i + lr) * MINI_RS + 64 * F.wave + 16 * lq); }
#pragma unroll
          for (int i = 0; i < 4; ++i)
#pragma unroll
              for (int j = 0; j < 4; ++j) acc[i][j] = MFMA16(af[i], bf[j], acc[i][j]); }
        __syncthreads();
        if (c + 1 < nch) {
            mini_put(F.lds, R1, tid);
            __syncthreads();
            if (c + 3 < nch) mini_fetch(R1, A, Bt, K, row0, col0, (c + 3) * MINI_KC, tid);
            { bf16x8 af[4], bf[4];
#pragma unroll
              for (int i = 0; i < 4; ++i) { af[i] = *(const LAS bf16x8*)(F.lds + (16 * i + lr) * MINI_RS + 64 * F.wave + 16 * lq); bf[i] = *(const LAS bf16x8*)(F.lds + 64 * MINI_RS + (16 * i + lr) * MINI_RS + 64 * F.wave + 16 * lq); }
#pragma unroll
              for (int i = 0; i < 4; ++i)
#pragma unroll
                  for (int j = 0; j < 4; ++j) acc[i][j] = MFMA16(af[i], bf[j], acc[i][j]); }
            __syncthreads();
        }
    }
    LAS float* part = (LAS float*)(F.lds) + F.wave * 4096;
#pragma unroll
    for (int i = 0; i < 4; ++i)
#pragma unroll
        for (int j = 0; j < 4; ++j)
#pragma unroll
            for (int rg = 0; rg < 4; ++rg) part[(16 * i + 4 * lq + rg) * 64 + 16 * j + lr] = acc[i][j][rg];
    __syncthreads();
    const int rr = 8 * F.wave + (lane >> 3), cc = 8 * (lane & 7);
    f32x4m s0 = {0.f, 0.f, 0.f, 0.f}, s1 = s0;
#pragma unroll
    for (int w = 0; w < 8; ++w) { const LAS float* p = (const LAS float*)(F.lds) + w * 4096 + rr * 64 + cc; s0 = s0 + *(const LAS f32x4m*)p; s1 = s1 + *(const LAS f32x4m*)(p + 4); }
    const int r = row0 + rr;
#ifdef RESBF16
    const v4u xb = *(const v4u*)(F.XB + (size_t)r * 1024 + col0 + cc);
    f32x4m x0 = {bflo(xb.x), bfhi(xb.x), bflo(xb.y), bfhi(xb.y)}, x1 = {bflo(xb.z), bfhi(xb.z), bflo(xb.w), bfhi(xb.w)}; x0 = x0 + s0; x1 = x1 + s1;
    v4u wv; wv.x = pkbf(x0[0], x0[1]); wv.y = pkbf(x0[2], x0[3]); wv.z = pkbf(x1[0], x1[1]); wv.w = pkbf(x1[2], x1[3]);
    *(v4u*)(XBo + (size_t)r * 1024 + col0 + cc) = wv;
    x0 = (f32x4m){bflo(wv.x), bfhi(wv.x), bflo(wv.y), bfhi(wv.y)}; x1 = (f32x4m){bflo(wv.z), bfhi(wv.z), bflo(wv.w), bfhi(wv.w)};
#else
    float* xp = F.X + (size_t)r * 1024 + col0 + cc;
    f32x4m x0 = *(const f32x4m*)xp, x1 = *(const f32x4m*)(xp + 4); x0 = x0 + s0; x1 = x1 + s1;
    { float* xo = Xo + (size_t)r * 1024 + col0 + cc; *(f32x4m*)xo = x0; *(f32x4m*)(xo + 4) = x1; }
    v4u wv; wv.x = pkbf(x0[0], x0[1]); wv.y = pkbf(x0[2], x0[3]); wv.z = pkbf(x1[0], x1[1]); wv.w = pkbf(x1[2], x1[3]);
    *(v4u*)(XBo + (size_t)r * 1024 + col0 + cc) = wv;
#endif
    float q = (x0[0] * x0[0] + x0[1] * x0[1]) + (x0[2] * x0[2] + x0[3] * x0[3]) + (x1[0] * x1[0] + x1[1] * x1[1]) + (x1[2] * x1[2] + x1[3] * x1[3]);
    q += __shfl_xor(q, 1); q += __shfl_xor(q, 2); q += __shfl_xor(q, 4);
    if ((lane & 7) == 0) SSo[(size_t)r * 16 + tc] = q;
    __syncthreads();
}
}
namespace fk {
constexpr int NPHASE = 24;
struct Args { const float* in[18]; float* out; unsigned char* ws; int ph_lo, ph_hi; };
__global__ void __launch_bounds__(NTHREADS, 2) yoco_fwd(Args args) {
    extern __shared__ __attribute__((aligned(16))) unsigned char lds[];
    Frame F;
    F.lds = (LAS unsigned char*)lds; F.MISC = (volatile LAS unsigned*)(F.lds + MISC_OFF);
    F.wave = __builtin_amdgcn_readfirstlane((int)threadIdx.x >> 6); F.cps = 0;
    F.G = gridDim.x; { const int bx = blockIdx.x; F.vcu = (F.G % 8 == 0) ? (bx % 8) * (F.G / 8) + bx / 8 : bx; }
    unsigned char* ws = args.ws; F.ctl = (unsigned*)(ws + WS_CTL);
    F.xp = args.in[0]; F.xs = args.in[1]; F.cak = args.in[2]; F.cav = args.in[3]; F.cbk = args.in[4]; F.cbv = args.in[5]; F.g_attn = args.in[6]; F.g_ffn = args.in[7]; F.w_qkv_a = args.in[8];
    F.sinks_a = args.in[9]; F.w_o_a = args.in[10]; F.g_kv = args.in[11]; F.w_kv_s = args.in[12]; F.w_q_b = args.in[13]; F.w_o_b = args.in[14]; F.w_gu = args.in[15]; F.w_dn = args.in[16]; F.g_final = args.in[17];
    F.out = args.out;
    F.WqkvA = (bf16*)(ws + WS_WQKVA); F.WoA = (bf16*)(ws + WS_WOA); F.Wb2 = (bf16*)(ws + WS_WB2); F.Wb3 = (bf16*)(ws + WS_WB3); F.WoB = (bf16*)(ws + WS_WOB); F.Wgu = (bf16*)(ws + WS_WGU); F.Wd = (bf16*)(ws + WS_WD);
    F.X = (float*)(ws + WS_X); F.XB = (bf16*)(ws + WS_XB); F.SS = (float*)(ws + WS_SS);
    F.Q = (bf16*)(ws + WS_Q); F.KA = (bf16*)(ws + WS_KA); F.VA = (bf16*)(ws + WS_VA); F.KB = (bf16*)(ws + WS_KB); F.VB = (bf16*)(ws + WS_VB); F.ATT = (bf16*)(ws + WS_ATT);
    F.OG = (bf16*)(ws + WS_OG); F.LSE = (float*)(ws + WS_LSE); F.H = (bf16*)(ws + WS_H); F.CBK = (bf16*)(ws + WS_CBK); F.CBV = (bf16*)(ws + WS_CBV);
    for (int u = threadIdx.x; u < (LDS_BYTES - RING_BYTES) / 4; u += NTHREADS) ((LAS unsigned*)(F.lds + RING_BYTES))[u] = 0u;
    __syncthreads();
    const int lo = args.ph_lo, hi = args.ph_hi;
    XcdBarrier bar; bar.bar = (unsigned*)(F.ctl + CW_BAR); bar.x = 0; bar.st = nullptr;
    if (hi - lo > 1) bar = xcd_barrier_post((unsigned*)(F.ctl + CW_BAR), F.MISC + 8);
    F.fuse = (hi - lo > 1) ? 1 : 0;
#ifdef NO_ATTN_A
#define ATTN_A(F, l)
#else
#define ATTN_A(F, l) attn_a_phase(F, l)
#endif
#ifdef NO_ATTN_B
#define ATTN_B(F, half)
#else
#define ATTN_B(F, half) attn_b_phase(F, half)
#endif
#ifdef STREAM_FAKE
#define CS_DECL int fake_ = 0; CSTYPE CS{cp_src(F), cp_dst(F), fake_, 1}
#else
#ifndef CSTYPE
#define CSTYPE pg8::CopyStreamT<2>
#endif
#define CS_DECL CSTYPE CS{cp_src(F), cp_dst(F), F.cps, CP_NCHUNKS}
#endif
#ifndef PG8_ALIGN
#define PG8_ALIGN true
#endif
#ifndef REP_MINI
#define REP_MINI 0
#endif
#ifndef REP_RES
#define REP_RES 0
#endif
#define DRY_RES(Aptr, Bptr, Kk) do { for (int rep_ = 0; rep_ < REP_RES; ++rep_) { pg8::Gemm g{(const pg8::bf16_t*)(Aptr), (const pg8::bf16_t*)(Bptr), M, 1024, (Kk)}; pg8::StaticOrder S; S.init(M, 1024, F.G, (int)blockIdx.x); \
        pg8::EpiRes E{F.X, (pg8::bf16_t*)(ws + WS_CBK + 128 * MiB), (float*)(ws + WS_CBK + 200 * MiB), (float*)(ws + WS_CBK)}; pg8::gemm_phase<pg8::EpiRes, pg8::StaticOrder, true, true>(F.lds, g, S, E); } } while (0)
#define IN(k) (lo <= (k) && (k) < hi)
#ifndef REP_BAR
#define REP_BAR 1
#endif
#ifndef TMUL
#define TMUL 1
#endif
#ifdef TSEL
#define STAMP(k) do { if (blockIdx.x == 0 && threadIdx.x == 0) { ((unsigned long long*)(F.ctl + 8192))[(k)] = __builtin_amdgcn_s_memrealtime(); } } while (0)
#else
#define STAMP(k) do { } while (0)
#endif
#if REP_BAR == 2
#define SEAM(k) do { if (IN(k) && IN((k) + 1)) { xcd_barrier(bar); xcd_barrier(bar); } } while (0)
#else
#define SEAM(k) do { if (IN(k) && IN((k) + 1)) xcd_barrier(bar); STAMP((k) + 1); } while (0)
#endif
#define GEMM_PHASE(WIN, EpiT, Aptr, Bptr, Nn, Kk, ...) do { pg8::Gemm g{(const pg8::bf16_t*)(Aptr), (const pg8::bf16_t*)(Bptr), M, (Nn), (Kk)}; pg8::StaticOrder S; S.init(M, (Nn), F.G, (int)blockIdx.x); \
        EpiT E{__VA_ARGS__}; CS_DECL; for (int rep_ = 0; rep_ < (EpiT::REPS); ++rep_) pg8::gemm_phase<EpiT, pg8::StaticOrder, PG8_ALIGN, true, CSTYPE>(F.lds, g, S, E, CS); } while (0)

    #ifndef REP_P0W
#define REP_P0W 1
#endif
    STAMP(0);
#define GEMM_PHASE_NC(WIN, EpiT, Aptr, Bptr, Nn, Kk, ...) do { pg8::Gemm g{(const pg8::bf16_t*)(Aptr), (const pg8::bf16_t*)(Bptr), M, (Nn), (Kk)}; pg8::StaticOrder S; S.init(M, (Nn), F.G, (int)blockIdx.x); \
        EpiT E{__VA_ARGS__}; for (int rep_ = 0; rep_ < (EpiT::REPS); ++rep_) pg8::gemm_phase<EpiT, pg8::StaticOrder, PG8_ALIGN, true>(F.lds, g, S, E); conv_window<WIN>(F, (M / 256) * ((Nn) / 256)); } while (0)
#ifndef CSTYPE_RES
#define CSTYPE_RES pg8::CopyStreamT<2>
#endif
#ifndef CSTYPE_GU
#define CSTYPE_GU pg8::CopyStreamT<2>
#endif
#ifdef GU_NOCOPY
#define GEMM_PHASE_GU GEMM_PHASE_NC
#else
#define GEMM_PHASE_GU(WIN, EpiT, Aptr, Bptr, Nn, Kk, ...) do { pg8::Gemm g{(const pg8::bf16_t*)(Aptr), (const pg8::bf16_t*)(Bptr), M, (Nn), (Kk)}; pg8::StaticOrder S; S.init(M, (Nn), F.G, (int)blockIdx.x); \
        EpiT E{__VA_ARGS__}; CSTYPE_GU CS{cp_src(F), cp_dst(F), F.cps, CP_NCHUNKS}; for (int rep_ = 0; rep_ < (EpiT::REPS); ++rep_) pg8::gemm_phase<EpiT, pg8::StaticOrder, PG8_ALIGN, true, CSTYPE_GU>(F.lds, g, S, E, CS); conv_window<WIN>(F, (M / 256) * ((Nn) / 256)); } while (0)
#endif
#define RES_PHASE(WIN, Aptr, Bptr, Kk) do { { pg8::Gemm g{(const pg8::bf16_t*)(Aptr), (const pg8::bf16_t*)(Bptr), MP, 1024, (Kk)}; pg8::StaticOrder S; S.init(MP, 1024, F.G, (int)blockIdx.x); \
        pg8::EpiRes E{F.X, F.XB, F.SS, F.X}; CSTYPE_RES CS{cp_src(F), cp_dst(F), F.cps, CP_NCHUNKS}; pg8::gemm_phase<pg8::EpiRes, pg8::StaticOrder, true, true, CSTYPE_RES>(F.lds, g, S, E, CS); } for (int rm_ = 0; rm_ < REP_MINI; ++rm_) mini_gemm(F, (Aptr), (Bptr), (Kk), (float*)(ws + WS_CBK), (bf16*)(ws + WS_CBK + 128 * MiB), (float*)(ws + WS_CBK + 200 * MiB)); mini_gemm(F, (Aptr), (Bptr), (Kk), F.X, F.XB, F.SS); } while (0)
    if (IN(0)) { for (int rep = 0; rep < REP_P0W; ++rep) p0_weights(F); STAMP(30); p0_x(F); STAMP(31);
#ifdef STREAM_FAKE
        bg_copy_rows(F, 0, BG_ROWS, F.vcu, F.G);
#endif
    } SEAM(0);
#define A_LAYER(l) do { const int pb = 1 + 5 * (l); \
    if (IN(pb)) GEMM_PHASE_NC(4 * (l) + 0, pg8::EpiProj<0>, F.XB, F.WqkvA + (size_t)(l) * 1536 * 1024, 1536, 1024, F.SS, F.Q, F.KA, F.VA, F.out + O2 + (size_t)(l) * 2 * 128 * 256, F.out + O3 + (size_t)(l) * 2 * 128 * 256, F.out + O6 + (size_t)(l) * 128 * 128 * 256, F.out + O7 + (size_t)(l) * 128 * 128 * 256); \
    SEAM(pb); \
    if (IN(pb + 1)) { ATTN_A(F, (l)); } SEAM(pb + 1); \
    if (IN(pb + 2)) DRY_RES(F.ATT, F.WoA + (size_t)(l) * 1024 * 1024, 1024); if (IN(pb + 2)) RES_PHASE(4 * (l) + 1, F.ATT, F.WoA + (size_t)(l) * 1024 * 1024, 1024); SEAM(pb + 2); \
    if (IN(pb + 3)) GEMM_PHASE_GU(4 * (l) + 2, pg8::EpiGlu, F.XB, F.Wgu + (size_t)(l) * NGU * 1024, NGU, 1024, F.SS, F.H); SEAM(pb + 3); \
    if (IN(pb + 4)) DRY_RES(F.H, F.Wd + (size_t)(l) * 1024 * DFF, DFF); if (IN(pb + 4)) RES_PHASE(4 * (l) + 3, F.H, F.Wd + (size_t)(l) * 1024 * DFF, DFF); SEAM(pb + 4); } while (0)
    A_LAYER(0);
    A_LAYER(1);
    if (IN(11)) GEMM_PHASE_NC(8, pg8::EpiProj<1>, F.XB, F.Wb2, 2560, 1024, F.SS, F.Q, F.KB, F.VB, F.out + O4, F.out + O5, F.out + O8, F.out + O9); SEAM(11);
    if (IN(12)) { ATTN_B(F, 0); } SEAM(12);
    if (!F.fuse) { if (IN(13)) combine_b(F); SEAM(13); } else STAMP(14);
    if (IN(14)) RES_PHASE(9, F.ATT, F.WoB, 512); SEAM(14);
    if (IN(15)) GEMM_PHASE_GU(10, pg8::EpiGlu, F.XB, F.Wgu + (size_t)2 * NGU * 1024, NGU, 1024, F.SS, F.H); SEAM(15);
    if (IN(16)) RES_PHASE(11, F.H, F.Wd + (size_t)2 * 1024 * DFF, DFF); SEAM(16);
    if (IN(17)) GEMM_PHASE_NC(12, pg8::EpiProj<2>, F.XB, F.Wb3, 1536, 1024, F.SS, F.Q, nullptr, nullptr, nullptr, nullptr, nullptr, nullptr); SEAM(17);
    if (IN(18)) { ATTN_B(F, 1); } SEAM(18);
    if (!F.fuse) { if (IN(19)) combine_b(F); SEAM(19); } else STAMP(20);
    if (IN(20)) RES_PHASE(13, F.ATT, F.WoB + (size_t)1024 * 512, 512); SEAM(20);
    if (IN(21)) GEMM_PHASE_GU(14, pg8::EpiGlu, F.XB, F.Wgu + (size_t)3 * NGU * 1024, NGU, 1024, F.SS, F.H); SEAM(21);
    if (IN(22)) RES_PHASE(15, F.H, F.Wd + (size_t)3 * 1024 * DFF, DFF); SEAM(22);
#ifdef STREAM_FAKE
    if (IN(23)) final_norm(F);
#else
    if (IN(23)) { cp_finish(F); final_norm(F); }
#endif
#ifdef TSEL
    asm volatile("s_waitcnt vmcnt(0)" ::: "memory"); __syncthreads();
    if (blockIdx.x == 0 && threadIdx.x == 0) {
        STAMP(24); asm volatile("s_waitcnt vmcnt(0)" ::: "memory");
        const volatile unsigned long long* ts = (const volatile unsigned long long*)(F.ctl + 8192);
        constexpr unsigned long long CATS = 0x4376154321543210ull;
        constexpr unsigned CATS2 = 0x75437615u;
        unsigned long long tsel = 0;
#pragma unroll
        for (int k = 0; k < 24; ++k) { const int c = (k < 16) ? (int)((CATS >> (4 * k)) & 15ull) : (int)((CATS2 >> (4 * (k - 16))) & 15u); if (c == (TSEL)) tsel += ts[k + 1] - ts[k]; }
        if ((TSEL) >= 100) tsel = ts[(TSEL) - 100 + 1] - ts[(TSEL) - 100];
        if ((TSEL) == 11) tsel = ts[24] - ts[23]; if ((TSEL) == 12) tsel = (ts[14] - ts[13]) + (ts[20] - ts[19]); if ((TSEL) == 8) tsel = ts[30] - ts[0]; if ((TSEL) == 9) tsel = ts[31] - ts[30]; if ((TSEL) == 10) tsel = ts[1] - ts[31];
        const unsigned long long t0 = __builtin_amdgcn_s_memrealtime(); while (__builtin_amdgcn_s_memrealtime() - t0 < (TMUL) * tsel) __builtin_amdgcn_s_sleep(8);
    }
#endif
#undef IN
#undef SEAM
#undef GEMM_PHASE
#undef A_LAYER
}
static int g_grid = 0;
static bool setup() {
    if (g_grid) return g_grid > 0;
    int dev = 0, cus = 0;
    if (hipGetDevice(&dev) != hipSuccess || hipDeviceGetAttribute(&cus, hipDeviceAttributeMultiprocessorCount, dev) != hipSuccess) { g_grid = -1; return false; }
    if (hipFuncSetAttribute((const void*)yoco_fwd, hipFuncAttributeMaxDynamicSharedMemorySize, LDS_BYTES) != hipSuccess) { fprintf(stderr, "hipFuncSetAttribute failed\n"); g_grid = -1; return false; }
    int per_cu = 0; (void)hipOccupancyMaxActiveBlocksPerMultiprocessor(&per_cu, (const void*)yoco_fwd, NTHREADS, LDS_BYTES); (void)hipGetLastError();
    if (per_cu < 1) fprintf(stderr, "occupancy query says %d blocks/CU\n", per_cu);
    if (cus < 256) { fprintf(stderr, "this kernel is built for the 256 CUs of an MI355X (found %d): nothing launched\n", cus); g_grid = -1; return false; }
    g_grid = 256;
    return true;
}
static void launch(void* const* d_in, float* out, void* ws, int lo, int hi, hipStream_t st) {
    Args a{}; for (int i = 0; i < 18; ++i) a.in[i] = (const float*)d_in[i]; a.out = out; a.ws = (unsigned char*)ws; a.ph_lo = lo; a.ph_hi = hi;
    hipLaunchKernelGGL(yoco_fwd, dim3(g_grid), dim3(NTHREADS), LDS_BYTES, st, a);
}
}
extern "C" void kernel_launch(void* const* d_in, const int* in_sizes, int n_in, void* d_out, int out_size, void* d_ws, size_t ws_size, hipStream_t stream) {
    if (!fk::setup()) return;
    if (ws_size < fk::WS_END) { fprintf(stderr, "ws too small\n"); return; }
    (void)hipMemsetAsync((char*)d_ws + fk::WS_CTL, 0, fk::CTL_ZERO_BYTES, stream);
    fk::launch(d_in, (float*)d_out, d_ws, 0, fk::NPHASE, stream);
}
```
